# Optimizing an MI355X kernel written in HIP

```python
import math
import jax
import jax.numpy as jnp
from jax import lax
import numpy as np

D_MODEL = 1024
BATCH = 2
SEQ = 16384
DEPTH = 2

GRID_W = 64
CTX_LEN = 256
HEAD_DIM = 64
NA_HEADS = 8
NA_WIN_ROWS = 8
NA_WIN_COLS = 16
MLA_HEADS = 8
MLA_Q_RANK = 256
MLA_KV_RANK = 128
MLA_NOPE = 64
MLA_ROPE = 32
MLA_V = 64
DIFF_HEADS = 4
DIFF_D = 64
DIFF_V = 2 * DIFF_D
A_W = NA_HEADS * HEAD_DIM
B_W = MLA_HEADS * MLA_V
C_QK = DIFF_HEADS * 2 * DIFF_D
C_W = DIFF_HEADS * DIFF_V
IN_SPLITS = (A_W, A_W, A_W, MLA_Q_RANK, MLA_KV_RANK, MLA_ROPE, C_QK, C_QK, C_W)
IN_DIM = sum(IN_SPLITS)
N_BRANCH = 3
N_EXPERTS = 16
EC_CAPACITY_FACTOR = 2
EXPERT_FF = 2816
QUERY_BLOCK = 128
ROPE_BASE = 10000.0
DEEPNORM_ALPHA = (2 * DEPTH) ** 0.25
DEEPNORM_BETA = (8 * DEPTH) ** -0.25
EPS = 1e-6

kernel_name = 'hybrid_natten_mla_diff_ecmoe_dit'


def layer_norm(x, g=None, b=None):
    xf = x.astype(jnp.float32)
    mu = jnp.mean(xf, axis=-1, keepdims=True)
    var = jnp.mean(jnp.square(xf - mu), axis=-1, keepdims=True)
    y = (xf - mu) * lax.rsqrt(var + EPS)
    if g is not None:
        y = y * g.astype(jnp.float32) + b.astype(jnp.float32)
    return y.astype(x.dtype)


def rms_norm(x, g):
    xf = x.astype(jnp.float32)
    y = xf * lax.rsqrt(jnp.mean(jnp.square(xf), axis=-1, keepdims=True) + EPS)
    return (y * g.astype(jnp.float32)).astype(x.dtype)


def modulate(x, shift, scale):
    return layer_norm(x) * (1 + scale) + shift


def to_heads(t, n_heads):
    return t.reshape(t.shape[0], t.shape[1], n_heads, -1)


def split_in(z):
    offs = np.cumsum(IN_SPLITS)[:-1].tolist()
    return jnp.split(z, offs, axis=-1)


def axial_angles(n_tokens, rot_dim):
    t = jnp.arange(n_tokens, dtype=jnp.int32)
    row = (t // GRID_W).astype(jnp.float32)
    col = (t % GRID_W).astype(jnp.float32)
    m = rot_dim // 2
    inv = ROPE_BASE ** (-jnp.arange(0, m, 2, dtype=jnp.float32) / m)
    return row[:, None] * inv, col[:, None] * inv


def rope_1d(x, ang):
    cos = jnp.cos(ang)[None, :, None, :].astype(x.dtype)
    sin = jnp.sin(ang)[None, :, None, :].astype(x.dtype)
    x1, x2 = jnp.split(x, 2, axis=-1)
    return jnp.concatenate([x1 * cos - x2 * sin, x1 * sin + x2 * cos], axis=-1)


def rope_2d(x, ang_row, ang_col):
    m = x.shape[-1] // 2
    return jnp.concatenate([rope_1d(x[..., :m], ang_row), rope_1d(x[..., m:], ang_col)], axis=-1)


def softmax_attend(q, k, v, scale):
    s = jnp.einsum('bqhd,bkhd->bhqk', q, k) * scale
    p = jax.nn.softmax(s.astype(jnp.float32), axis=-1).astype(v.dtype)
    return jnp.einsum('bhqk,bkhd->bqhd', p, v)


def diff_attend(q1, q2, k1, k2, v, lam, scale):
    p1 = jax.nn.softmax((jnp.einsum('bqhd,bkhd->bhqk', q1, k1) * scale).astype(jnp.float32), axis=-1)
    p2 = jax.nn.softmax((jnp.einsum('bqhd,bkhd->bhqk', q2, k2) * scale).astype(jnp.float32), axis=-1)
    a = (p1 - lam * p2).astype(v.dtype)
    return jnp.einsum('bhqk,bkhd->bqhd', a, v)


def sweep_query_blocks(fn, *qs):
    b, n = qs[0].shape[:2]
    nb = n // QUERY_BLOCK
    blocks = tuple(jnp.moveaxis(q.reshape(b, nb, QUERY_BLOCK, *q.shape[2:]), 1, 0) for q in qs)
    out = lax.map(lambda args: fn(*args), blocks)
    return jnp.moveaxis(out, 0, 1).reshape(b, n, *out.shape[3:])


def neighborhood_attend(q, k, v, k_ctx, v_ctx, rpb):
    b, n, h, d = q.shape
    rows = n // GRID_W
    kr = min(NA_WIN_ROWS, rows)
    kc = NA_WIN_COLS
    scale = d ** -0.5
    kg = k.reshape(b, rows, GRID_W, h, d)
    vg = v.reshape(b, rows, GRID_W, h, d)
    r_idx = jnp.arange(rows, dtype=jnp.int32)
    r_start = jnp.clip(r_idx - kr // 2, 0, rows - kr)
    c_idx = jnp.arange(GRID_W, dtype=jnp.int32)
    c_start = jnp.clip(c_idx - kc // 2, 0, GRID_W - kc)
    key_cols = c_start[:, None] + jnp.arange(kc, dtype=jnp.int32)[None, :]
    col_off = key_cols - c_idx[:, None] + (NA_WIN_COLS - 1)
    q_rows = jnp.moveaxis(q.reshape(b, rows, GRID_W, h, d), 1, 0)

    def one_row(args):
        qr, r, rs = args
        kw = lax.dynamic_slice_in_dim(kg, rs, kr, axis=1)[:, :, key_cols]
        vw = lax.dynamic_slice_in_dim(vg, rs, kr, axis=1)[:, :, key_cols]
        row_off = rs + jnp.arange(kr, dtype=jnp.int32) - r + (NA_WIN_ROWS - 1)
        bias = rpb[:, row_off][:, :, col_off]
        s_win = jnp.einsum('bchd,brckhd->bhcrk', qr, kw) * scale + jnp.transpose(bias, (0, 2, 1, 3))[None].astype(qr.dtype)
        s_ctx = jnp.einsum('bchd,blhd->bhcl', qr, k_ctx) * scale
        s = jnp.concatenate([s_win.reshape(b, h, GRID_W, kr * kc), s_ctx], axis=-1)
        p = jax.nn.softmax(s.astype(jnp.float32), axis=-1).astype(v.dtype)
        p_win = p[..., :kr * kc].reshape(b, h, GRID_W, kr, kc)
        p_ctx = p[..., kr * kc:]
        return (jnp.einsum('bhcrk,brckhd->bchd', p_win, vw)
                + jnp.einsum('bhcl,blhd->bchd', p_ctx, v_ctx))

    out = lax.map(one_row, (q_rows, r_idx, r_start))
    return jnp.moveaxis(out, 0, 1).reshape(b, n, h, d)


def mla_heads(cq, ckv, k_rope, g_q, g_kv, w_uq, w_ukv):
    q = to_heads(rms_norm(cq, g_q) @ w_uq, MLA_HEADS)
    kv = to_heads(rms_norm(ckv, g_kv) @ w_ukv, MLA_HEADS)
    return (q[..., :MLA_NOPE], q[..., MLA_NOPE:], kv[..., :MLA_NOPE], k_rope[:, :, None, :],
            kv[..., MLA_NOPE:])


def mla_qk(q_nope, q_rope, k_nope, k_rope):
    q = jnp.concatenate([q_nope, q_rope], axis=-1)
    k = jnp.concatenate([k_nope, jnp.broadcast_to(k_rope, k_nope.shape[:3] + (MLA_ROPE,))], axis=-1)
    return q, k


def diff_qk(t):
    t = t.reshape(t.shape[0], t.shape[1], DIFF_HEADS, 2, DIFF_D)
    return t[..., 0, :], t[..., 1, :]


def gated_merge(h, ya, yb, yc, w_br_a, w_br_b, w_br_c, w_gate, b_gate, w_out):
    ga, gb, gc = jnp.split(jax.nn.sigmoid(h @ w_gate + b_gate), N_BRANCH, axis=-1)
    flat = lambda y: y.reshape(y.shape[0], y.shape[1], -1)
    m = ga * (flat(ya) @ w_br_a) + gb * (flat(yb) @ w_br_b) + gc * (flat(yc) @ w_br_c)
    return m @ w_out


def token_mixer(h, hc, lam_init, w_in, rpb, g_q, g_kv, w_uq, w_ukv, lq1, lk1, lq2, lk2, g_sub,
                w_br_a, w_br_b, w_br_c, w_gate, b_gate, w_out, with_ctx_out):
    n = h.shape[1]
    z = split_in(h @ w_in)
    zc = split_in(hc @ w_in)
    ang_b = axial_angles(n, MLA_ROPE)
    ang_c = axial_angles(n, DIFF_D)

    qa, ka, va = (to_heads(t, NA_HEADS) for t in z[0:3])
    qa_c, ka_c, va_c = (to_heads(t, NA_HEADS) for t in zc[0:3])
    ya = neighborhood_attend(qa, ka, va, ka_c, va_c, rpb)

    qn, qr, kn, krp, vb = mla_heads(z[3], z[4], z[5], g_q, g_kv, w_uq, w_ukv)
    qb, kb = mla_qk(qn, rope_2d(qr, *ang_b), kn, rope_2d(krp, *ang_b))
    qn_c, qr_c, kn_c, krp_c, vb_c = mla_heads(zc[3], zc[4], zc[5], g_q, g_kv, w_uq, w_ukv)
    qb_c, kb_c = mla_qk(qn_c, qr_c, kn_c, krp_c)
    kb_all = jnp.concatenate([kb_c, kb], axis=1)
    vb_all = jnp.concatenate([vb_c, vb], axis=1)
    scale_b = (MLA_NOPE + MLA_ROPE) ** -0.5
    yb = sweep_query_blocks(lambda q: softmax_attend(q, kb_all, vb_all, scale_b), qb)

    lam = (jnp.exp(jnp.sum(lq1.astype(jnp.float32) * lk1.astype(jnp.float32)))
           - jnp.exp(jnp.sum(lq2.astype(jnp.float32) * lk2.astype(jnp.float32))) + lam_init)
    q1, q2 = diff_qk(z[6])
    k1, k2 = diff_qk(z[7])
    q1, q2, k1, k2 = (rope_2d(t, *ang_c) for t in (q1, q2, k1, k2))
    vc = to_heads(z[8], DIFF_HEADS)
    q1_c, q2_c = diff_qk(zc[6])
    k1_c, k2_c = diff_qk(zc[7])
    vc_c = to_heads(zc[8], DIFF_HEADS)
    k1_all = jnp.concatenate([k1_c, k1], axis=1)
    k2_all = jnp.concatenate([k2_c, k2], axis=1)
    vc_all = jnp.concatenate([vc_c, vc], axis=1)
    scale_c = DIFF_D ** -0.5
    yc = sweep_query_blocks(lambda a, bq: diff_attend(a, bq, k1_all, k2_all, vc_all, lam, scale_c), q1, q2)
    yc = rms_norm(yc, g_sub) * (1 - lam_init)

    y = gated_merge(h, ya, yb, yc, w_br_a, w_br_b, w_br_c, w_gate, b_gate, w_out)
    if not with_ctx_out:
        return y, None
    ya_c = softmax_attend(qa_c, ka_c, va_c, HEAD_DIM ** -0.5)
    yb_c = softmax_attend(qb_c, kb_c, vb_c, scale_b)
    yc_c = rms_norm(diff_attend(q1_c, q2_c, k1_c, k2_c, vc_c, lam, scale_c), g_sub) * (1 - lam_init)
    y_c = gated_merge(hc, ya_c, yb_c, yc_c, w_br_a, w_br_b, w_br_c, w_gate, b_gate, w_out)
    return y, y_c


def expert_choice_ffn(h, w_router, w_g, w_u, w_d):
    b, t, _ = h.shape
    cap = max(1, EC_CAPACITY_FACTOR * t // N_EXPERTS)
    aff = jax.nn.softmax((h @ w_router).astype(jnp.float32), axis=-1)
    gate_w, idx = lax.top_k(jnp.swapaxes(aff, 1, 2), cap)
    bidx = jnp.arange(b, dtype=jnp.int32)[:, None, None]
    x_sel = jnp.moveaxis(h[bidx, idx], 1, 0)

    def expert(args):
        xe, wg, wu, wd = args
        return (jax.nn.silu(xe @ wg) * (xe @ wu)) @ wd

    y = jnp.moveaxis(lax.map(expert, (x_sel, w_g, w_u, w_d)), 0, 1)
    y = y * gate_w[..., None].astype(y.dtype)
    return jnp.zeros_like(h).at[bidx, idx].add(y)


def setup_inputs(seed: int = 0) -> dict:
    key = jax.random.key(seed)
    ks = jax.random.split(key, 31)
    L, D, E, F = DEPTH, D_MODEL, N_EXPERTS, EXPERT_FF

    def nrm(i, shape, s):
        return jax.random.normal(ks[i], shape, jnp.float32) * s

    return {
        'x': nrm(0, (BATCH, SEQ, D), 1.0),
        'c': nrm(1, (BATCH, D), 1.0),
        'ctx': nrm(2, (BATCH, CTX_LEN, D), 1.0),
        'c_ctx': nrm(3, (D,), 1.0),
        'w_ada': nrm(4, (L, D, 6 * D), 0.5 * D ** -0.5),
        'b_ada': nrm(5, (L, 6 * D), 0.02),
        'w_in': nrm(6, (L, D, IN_DIM), D ** -0.5),
        'na_rpb': nrm(7, (L, NA_HEADS, 2 * NA_WIN_ROWS - 1, 2 * NA_WIN_COLS - 1), 0.1),
        'mla_g_q': 1.0 + nrm(8, (L, MLA_Q_RANK), 0.02),
        'mla_g_kv': 1.0 + nrm(9, (L, MLA_KV_RANK), 0.02),
        'mla_w_uq': nrm(10, (L, MLA_Q_RANK, MLA_HEADS * (MLA_NOPE + MLA_ROPE)), MLA_Q_RANK ** -0.5),
        'mla_w_ukv': nrm(11, (L, MLA_KV_RANK, MLA_HEADS * (MLA_NOPE + MLA_V)), MLA_KV_RANK ** -0.5),
        'diff_lq1': nrm(12, (L, DIFF_D), 0.1),
        'diff_lk1': nrm(13, (L, DIFF_D), 0.1),
        'diff_lq2': nrm(14, (L, DIFF_D), 0.1),
        'diff_lk2': nrm(15, (L, DIFF_D), 0.1),
        'diff_g_sub': 1.0 + nrm(16, (L, DIFF_V), 0.02),
        'w_br_a': nrm(17, (L, A_W, D), DEEPNORM_BETA * A_W ** -0.5),
        'w_br_b': nrm(18, (L, B_W, D), DEEPNORM_BETA * B_W ** -0.5),
        'w_br_c': nrm(19, (L, C_W, D), DEEPNORM_BETA * C_W ** -0.5),
        'w_gate': nrm(20, (L, D, N_BRANCH * D), D ** -0.5),
        'b_gate': nrm(21, (L, N_BRANCH * D), 0.02),
        'w_out': nrm(22, (L, D, D), DEEPNORM_BETA * D ** -0.5),
        'ln1_g': 1.0 + nrm(23, (L, D), 0.02),
        'ln1_b': nrm(24, (L, D), 0.02),
        'w_router': nrm(25, (L, D, E), D ** -0.5),
        'w_exp_gate': nrm(26, (L, E, D, F), D ** -0.5),
        'w_exp_up': nrm(27, (L, E, D, F), D ** -0.5),
        'w_exp_down': nrm(28, (L, E, F, D), DEEPNORM_BETA * F ** -0.5),
        'ln2_g': 1.0 + nrm(29, (L, D), 0.02),
        'ln2_b': nrm(30, (L, D), 0.02),
    }


def reference(x, c, ctx, c_ctx, w_ada, b_ada, w_in, na_rpb, mla_g_q, mla_g_kv, mla_w_uq, mla_w_ukv,
              diff_lq1, diff_lk1, diff_lq2, diff_lk2, diff_g_sub, w_br_a, w_br_b, w_br_c,
              w_gate, b_gate, w_out, ln1_g, ln1_b, w_router, w_exp_gate, w_exp_up, w_exp_down,
              ln2_g, ln2_b):
    for l in range(DEPTH):
        last = l == DEPTH - 1
        lam_init = 0.8 - 0.6 * math.exp(-0.3 * l)
        mod = jax.nn.silu(c) @ w_ada[l] + b_ada[l]
        mod_c = jax.nn.silu(c_ctx) @ w_ada[l] + b_ada[l]
        sh1, sc1, g1, sh2, sc2, g2 = jnp.split(mod[:, None, :], 6, axis=-1)
        csh1, csc1, cg1, csh2, csc2, cg2 = jnp.split(mod_c, 6, axis=-1)

        h = modulate(x, sh1, sc1)
        hc = modulate(ctx, csh1, csc1)
        y, y_c = token_mixer(h, hc, lam_init, w_in[l], na_rpb[l], mla_g_q[l], mla_g_kv[l],
                             mla_w_uq[l], mla_w_ukv[l], diff_lq1[l], diff_lk1[l], diff_lq2[l],
                             diff_lk2[l], diff_g_sub[l], w_br_a[l], w_br_b[l], w_br_c[l],
                             w_gate[l], b_gate[l], w_out[l], not last)
        x = layer_norm(DEEPNORM_ALPHA * x + g1 * y, ln1_g[l], ln1_b[l])

        h2 = modulate(x, sh2, sc2)
        f = expert_choice_ffn(h2, w_router[l], w_exp_gate[l], w_exp_up[l], w_exp_down[l])
        x = layer_norm(DEEPNORM_ALPHA * x + g2 * f, ln2_g[l], ln2_b[l])

        if not last:
            ctx = layer_norm(DEEPNORM_ALPHA * ctx + cg1 * y_c, ln1_g[l], ln1_b[l])
            hc2 = modulate(ctx, csh2, csc2)
            f_c = expert_choice_ffn(hc2, w_router[l], w_exp_gate[l], w_exp_up[l], w_exp_down[l])
            ctx = layer_norm(DEEPNORM_ALPHA * ctx + cg2 * f_c, ln2_g[l], ln2_b[l])
    return x
```

```cpp
#include <hip/hip_runtime.h>
#include <stdint.h>
#include <stdio.h>
#include <string.h>

typedef unsigned short bf16;
typedef short bf16x8 __attribute__((ext_vector_type(8)));
typedef float f32x2 __attribute__((ext_vector_type(2)));
typedef float f32x4 __attribute__((ext_vector_type(4)));
typedef float f32x16 __attribute__((ext_vector_type(16)));
typedef unsigned u32x2 __attribute__((ext_vector_type(2)));
typedef unsigned u32x4 __attribute__((ext_vector_type(4)));
typedef __bf16 bf16x2_t __attribute__((ext_vector_type(2)));
#define DI __device__ __forceinline__
#define MFMA32(a, b, c) __builtin_amdgcn_mfma_f32_32x32x16_bf16((a), (b), (c), 0, 0, 0)

constexpr int D = 1024, NB = 2, SEQ = 16384, CTX = 256, TPB = SEQ + CTX  , MROWS = NB * TPB  ;
constexpr int GRID_W = 64, KGPB = TPB / 32  , NKG = MROWS / 32  ;
constexpr int IN_DIM = 3488, ZLD = 3584;
constexpr int ZO_AQ = 0, ZO_AK = 512, ZO_AV = 1024, ZO_CQ = 1536, ZO_CKV = 1792, ZO_KR = 1920, ZO_DQ = 1952, ZO_DK = 2464, ZO_DV = 2976;
constexpr int NE = 16, FF = 2816, CAP_L = 2048, CAP_C = 32, NSLOT_L = NE * NB * CAP_L  , NSLOT = NSLOT_L + NE * NB * CAP_C  ;
constexpr float LOG2E = 1.4426950408889634f;
constexpr float ALPHA = 1.4142135623730951f;
constexpr float EPS = 1e-6f;
constexpr int NWG_THREADS = 512;

constexpr size_t al256(size_t x) { return (x + 255) & ~(size_t)255; }
constexpr size_t WS_CTL = 0;
constexpr size_t WS_KMAX = 16384;
constexpr size_t WS_MOD = 65536;
constexpr size_t WS_ROPE = WS_MOD + al256(2 * 3 * 6144 * 4);
constexpr size_t ROPE_MROW = 0, ROPE_MCOL = 256 * 16, ROPE_DROW = ROPE_MCOL + 64 * 16, ROPE_DCOL = ROPE_DROW + 256 * 32, ROPE_FLOATS = ROPE_DCOL + 64 * 32;
constexpr size_t WS_LAM = WS_ROPE + al256(ROPE_FLOATS * 4);
constexpr size_t WS_BIAS = WS_LAM + 256;
constexpr size_t BIAS_TILE = 64 * 16;
constexpr size_t WS_BT_IN = WS_BIAS + al256((size_t)2 * 8 * 15 * 4 * BIAS_TILE * 4);
constexpr size_t WS_BT_GATE = WS_BT_IN + (size_t)2 * ZLD * 1024 * 2;
constexpr size_t WS_BT_BR = WS_BT_GATE + (size_t)2 * 3072 * 1024 * 2;
constexpr size_t WS_BT_OUT = WS_BT_BR + (size_t)2 * 3 * 1024 * 512 * 2;
constexpr size_t WS_BT_UQ = WS_BT_OUT + (size_t)2 * 1024 * 1024 * 2;
constexpr size_t WS_BT_UKV = WS_BT_UQ + (size_t)2 * 768 * 256 * 2;
constexpr size_t WS_BT_M1 = WS_BT_UKV + (size_t)2 * 1024 * 256 * 2;
constexpr size_t WS_BT_M2 = WS_BT_M1 + (size_t)2 * NE * 5632 * 1024;
constexpr size_t WS_X = WS_BT_M2 + (size_t)2 * NE * 1024 * FF;
constexpr size_t WS_H = WS_X + (size_t)MROWS * D * 4;
constexpr size_t WS_INVRMS = WS_H + (size_t)MROWS * D * 2;
constexpr size_t WS_KROPE = WS_INVRMS + al256((size_t)MROWS * 2 * 4);
constexpr size_t WS_AFF = WS_KROPE + (size_t)MROWS * 32 * 4;
constexpr size_t WS_SELROW = WS_AFF + (size_t)(2 * 16 * 16384 + 2 * 16 * 256) * 4;
constexpr size_t WS_SELW = WS_SELROW + (size_t)NSLOT * 4;
constexpr size_t WS_SLOTOF = WS_SELW + (size_t)NSLOT * 4;
constexpr size_t WS_QN = WS_SLOTOF + (size_t)MROWS * 16 * 4;
constexpr size_t WS_R1 = WS_QN + (size_t)2 * MROWS * 8 * 4;
constexpr size_t SZ512 = (size_t)MROWS * 512 * 2, SZ768 = (size_t)MROWS * 768 * 2, SZ1024 = (size_t)MROWS * 1024 * 2;
constexpr size_t R_Z = WS_R1;
constexpr size_t R_QNA = R_Z + (size_t)MROWS * ZLD * 2, R_KFNA = R_QNA + SZ512, R_VFNA = R_KFNA + SZ512, R_QD = R_VFNA + SZ512, R_KFD = R_QD + SZ512, R_VFD = R_KFD + SZ512;
constexpr size_t R_QRAW = R_VFD + SZ512, R_KVRAW = R_QRAW + SZ768, R_END = R_KVRAW + SZ1024;
constexpr size_t R_QMLA = WS_R1, R_KFMLA = R_QMLA + SZ768, R_VFMLA = R_KFMLA + SZ768, R_OD = R_VFMLA + SZ512;
static_assert(R_OD + SZ1024 <= R_QNA, "alias map");
constexpr size_t R_G = R_END;
constexpr size_t R_M32 = R_QNA, R_M = R_M32 + (size_t)MROWS * D * 4;
static_assert(R_M + SZ1024 <= R_QRAW, "alias map");
constexpr size_t R_YA = R_QRAW, R_YB = R_YA + SZ512, R_YC = R_YB + SZ512;
static_assert(R_YC + SZ512 <= R_END, "alias map");
constexpr size_t R_XSEL = WS_R1, R_ACT = R_XSEL + (size_t)NSLOT * D * 2;
static_assert(R_ACT + (size_t)NSLOT * FF * 2 <= R_END, "alias map");
constexpr size_t WS_TOTAL = R_G + (size_t)MROWS * 3072 * 2;

struct Params { const float* in[31]; float* out; unsigned char* ws; };

DI float bf2f(bf16 v) { return __uint_as_float((unsigned)v << 16); }
DI unsigned pk2(float a, float b) { f32x2 v = {a, b}; bf16x2_t r = __builtin_convertvector(v, bf16x2_t); return __builtin_bit_cast(unsigned, r); }
DI bf16 f2bf(float a) { return (bf16)(pk2(a, 0.f) & 0xffffu); }
DI float lo_f(unsigned u) { return __uint_as_float(u << 16); }
DI float hi_f(unsigned u) { return __uint_as_float(u & 0xffff0000u); }
DI float wave_sum(float v) {
#pragma unroll
    for (int o = 32; o >= 1; o >>= 1) v += __shfl_xor(v, o);
    return v;
}
DI float wave_max(float v) {
#pragma unroll
    for (int o = 32; o >= 1; o >>= 1) v = fmaxf(v, __shfl_xor(v, o));
    return v;
}
DI int ltid() { int t = threadIdx.x; asm volatile("" : "+v"(t)); return t; }
DI unsigned char* lws(const Params& p) {
    const unsigned long long w = (unsigned long long)p.ws; unsigned lo, hi;
    asm volatile("v_mov_b32 %0, %2\n\tv_mov_b32 %1, %3" : "=v"(lo), "=v"(hi) : "s"((unsigned)w), "s"((unsigned)(w >> 32)));
    lo = __builtin_amdgcn_readfirstlane(lo); hi = __builtin_amdgcn_readfirstlane(hi);
    typedef __attribute__((address_space(1))) unsigned char* gptr_t;
    return (unsigned char*)(gptr_t)(((unsigned long long)hi << 32) | lo);
}
DI int gwave(int tid) { return blockIdx.x * 8 + (tid >> 6); }
DI int nwaves() { return gridDim.x * 8; }
DI float sigmoidf_(float x) { return __builtin_amdgcn_rcpf(1.f + __builtin_amdgcn_exp2f(-x * LOG2E)); }

DI bf16x8 scale8(bf16x8 v, float s) {
    u32x4 u = __builtin_bit_cast(u32x4, v), o;
#pragma unroll
    for (int i = 0; i < 4; ++i) o[i] = pk2(lo_f(u[i]) * s, hi_f(u[i]) * s);
    return __builtin_bit_cast(bf16x8, o);
}
DI void unpack8(bf16x8 v, float (&f)[8]) { const u32x4 u = __builtin_bit_cast(u32x4, v);
#pragma unroll
    for (int i = 0; i < 4; ++i) { f[2 * i] = lo_f(u[i]); f[2 * i + 1] = hi_f(u[i]); } }
DI bf16x8 pack8(const float (&f)[8]) { u32x4 o;
#pragma unroll
    for (int i = 0; i < 4; ++i) o[i] = pk2(f[2 * i], f[2 * i + 1]);
    return __builtin_bit_cast(bf16x8, o); }
DI float sumsq8(const float (&f)[8]) { float s = 0.f;
#pragma unroll
    for (int i = 0; i < 8; ++i) s += f[i] * f[i];
    return s; }
DI float sumsq8p(bf16x8 v) { float f[8]; unpack8(v, f); return sumsq8(f); }


typedef int i32x8 __attribute__((ext_vector_type(8)));
DI unsigned pk4_fp8(float a, float b, float c, float d) { int w = __float_as_int(a); w = __builtin_amdgcn_cvt_pk_fp8_f32(a, b, w, false); w = __builtin_amdgcn_cvt_pk_fp8_f32(c, d, w, true); return (unsigned)w; }
DI unsigned pk4_bf8(float a, float b, float c, float d) { int w = __float_as_int(a); w = __builtin_amdgcn_cvt_pk_bf8_f32(a, b, w, false); w = __builtin_amdgcn_cvt_pk_bf8_f32(c, d, w, true); return (unsigned)w; }
DI u32x4 pk16_fp8(const float* f) { u32x4 o;
#pragma unroll
    for (int i = 0; i < 4; ++i) o[i] = pk4_fp8(f[4 * i], f[4 * i + 1], f[4 * i + 2], f[4 * i + 3]);
    return o; }
DI i32x8 cat8(bf16x8 a, bf16x8 b) { const u32x4 x = __builtin_bit_cast(u32x4, a), y = __builtin_bit_cast(u32x4, b); return (i32x8){(int)x[0], (int)x[1], (int)x[2], (int)x[3], (int)y[0], (int)y[1], (int)y[2], (int)y[3]}; }
#define MFMA8(a, b, c, fa, fb) __builtin_amdgcn_mfma_scale_f32_32x32x64_f8f6f4((a), (b), (c), (fa), (fb), 0, 0x7f7f7f7f, 0, 0x7f7f7f7f)
DI int kappa(int h, int j) { return (j >> 4) * 32 + (j & 3) + 8 * ((j & 15) >> 2) + 4 * h; }
constexpr bool FP8_INPROJ = true, FP8_GATE = true;
constexpr float WD_SCALE = 32.f;
constexpr float W1_SCALE = 32.f, W2_SCALE = 64.f, ACT_SCALE = 4.f;
constexpr float SQC_D = 2.f * 0.42466090014400953f;
constexpr float SQC_M = 2.f * 0.38372760731440503f;

DI int mod_row_of(int row) { const int b = row / TPB, t = row - b * TPB; return t < CTX ? 2 : b; }
DI const float* x_src_row(const float* xin, const float* cin, const float* xbuf, int layer, int row) {
    if (layer > 0) return xbuf + (size_t)row * D;
    const int b = row / TPB, t = row - b * TPB;
    return t < CTX ? cin + ((size_t)b * CTX + t) * D : xin + ((size_t)b * SEQ + (t - CTX)) * D;
}

struct CvtJob { const float* src; bf16* dst; const float* scale; int K, N, ld_dst, nmul, nadd, fp8  ; float wscale; };
DI bool get_job(const Params& p, unsigned char* ws_, int j, CvtJob& J) {
    const int l = j / 56, r = j % 56;
    if (l >= 2) return false;
    J.scale = nullptr; J.nmul = 1; J.nadd = 0; J.fp8 = 0; J.wscale = 1.f;
    if (r == 0) { J.src = p.in[6] + (size_t)l * 1024 * IN_DIM; J.K = 1024; J.N = IN_DIM;
        if (FP8_INPROJ) { J.dst = (bf16*)(ws_ + WS_BT_IN + (size_t)l * ZLD * 1024); J.ld_dst = 1024; J.fp8 = 3; J.wscale = WD_SCALE; }
        else { J.dst = (bf16*)(ws_ + WS_BT_IN) + (size_t)l * ZLD * 1024; J.ld_dst = 1024; } }
    else if (r == 1) { J.src = p.in[20] + (size_t)l * 1024 * 3072; J.K = 1024; J.N = 3072;
        if (FP8_GATE) { J.dst = (bf16*)(ws_ + WS_BT_GATE + (size_t)l * 3072 * 1024); J.ld_dst = 1024; J.fp8 = 3; J.wscale = WD_SCALE; }
        else { J.dst = (bf16*)(ws_ + WS_BT_GATE) + (size_t)l * 3072 * 1024; J.ld_dst = 1024; } }
    else if (r <= 4) { J.src = p.in[17 + (r - 2)] + (size_t)l * 512 * 1024; J.dst = (bf16*)(ws_ + WS_BT_BR) + (size_t)l * 1024 * 1536 + (r - 2) * 512; J.K = 512; J.N = 1024; J.ld_dst = 1536; }
    else if (r == 5) { J.src = p.in[22] + (size_t)l * 1024 * 1024; J.dst = (bf16*)(ws_ + WS_BT_OUT) + (size_t)l * 1024 * 1024; J.K = 1024; J.N = 1024; J.ld_dst = 1024; }
    else if (r == 6) { J.src = p.in[10] + (size_t)l * 256 * 768; J.dst = (bf16*)(ws_ + WS_BT_UQ) + (size_t)l * 768 * 256; J.K = 256; J.N = 768; J.ld_dst = 256; J.scale = p.in[8] + l * 256; }
    else if (r == 7) { J.src = p.in[11] + (size_t)l * 128 * 1024; J.dst = (bf16*)(ws_ + WS_BT_UKV) + (size_t)l * 1024 * 256; J.K = 128; J.N = 1024; J.ld_dst = 256; J.scale = p.in[9] + l * 128; }
    else {
        const int q = r - 8, e = q / 3, w = q % 3;
        unsigned char* m1 = ws_ + WS_BT_M1 + ((size_t)l * NE + e) * 5632 * 1024; unsigned char* m2 = ws_ + WS_BT_M2 + ((size_t)l * NE + e) * 1024 * FF;
        if (w == 0) { J.src = p.in[26] + ((size_t)l * NE + e) * 1024 * FF; J.dst = (bf16*)m1; J.K = 1024; J.N = FF; J.ld_dst = 1024; J.fp8 = 1; J.wscale = W1_SCALE; }
        else if (w == 1) { J.src = p.in[27] + ((size_t)l * NE + e) * 1024 * FF; J.dst = (bf16*)m1; J.K = 1024; J.N = FF; J.ld_dst = 1024; J.fp8 = 2; J.wscale = W1_SCALE; }
        else { J.src = p.in[28] + ((size_t)l * NE + e) * FF * 1024; J.dst = (bf16*)m2; J.K = FF; J.N = 1024; J.ld_dst = FF; J.fp8 = 3; J.wscale = W2_SCALE; }
    }
    return true;
}
DI void cvt_tile(const CvtJob& J, int t, int tn, float* lw, int lane) {
    const int k0 = (t / tn) * 64, n0 = (t % tn) * 64;
    const int r4 = lane >> 4, c4 = (lane & 15) * 4;
    f32x4 v[16];
    const bool full = n0 + 64 <= J.N;
#pragma unroll
    for (int i = 0; i < 16; ++i) {
        const float* sp = J.src + (size_t)(k0 + i * 4 + r4) * J.N + n0 + c4;
        if (full || n0 + c4 + 3 < J.N) v[i] = *(const f32x4*)sp; else v[i] = (f32x4){0.f, 0.f, 0.f, 0.f};
    }
    if (J.scale) {
#pragma unroll
        for (int i = 0; i < 16; ++i) v[i] *= J.scale[k0 + i * 4 + r4];
    }
#pragma unroll
    for (int i = 0; i < 16; ++i) { float* d = lw + (i * 4 + r4) * 65 + c4; d[0] = v[i][0]; d[1] = v[i][1]; d[2] = v[i][2]; d[3] = v[i][3]; }
    asm volatile("s_waitcnt lgkmcnt(0)" ::: "memory");
    const int g = lane & 7, ns = lane >> 3;
#pragma unroll
    for (int nb = 0; nb < 8; ++nb) {
        const int nn = nb * 8 + ns;
        float f[8];
#pragma unroll
        for (int q = 0; q < 8; ++q) f[q] = lw[(g * 8 + q) * 65 + nn];
        if (n0 + nn < J.N) {
            if (J.fp8 == 0) *(bf16x8*)(J.dst + (size_t)((n0 + nn) * J.nmul + J.nadd) * J.ld_dst + k0 + g * 8) = pack8(f);
            else {
                const int nsrc = n0 + nn, nrow = J.fp8 == 3 ? nsrc : (nsrc >> 4) * 32 + (J.fp8 == 2 ? 16 : 0) + (nsrc & 15);
                u32x2 o; o.x = pk4_fp8(f[0] * J.wscale, f[1] * J.wscale, f[2] * J.wscale, f[3] * J.wscale); o.y = pk4_fp8(f[4] * J.wscale, f[5] * J.wscale, f[6] * J.wscale, f[7] * J.wscale);
                *(u32x2*)((unsigned char*)J.dst + (size_t)nrow * J.ld_dst + k0 + g * 8) = o;
            }
        }
    }
    asm volatile("s_waitcnt lgkmcnt(0)" ::: "memory");
}
constexpr int MOE_TILES = 48 * 704;
DI void cvt_moe_tile(const Params& p, unsigned char* ws_, int layer, int G, float* lds, int tid) {
    if (G < MOE_TILES) { CvtJob J; get_job(p, ws_, layer * 56 + 8 + G / 704, J); cvt_tile(J, G % 704, (J.N + 63) / 64, lds + (tid >> 6) * (64 * 65), tid & 63); }
}
DI void phase_cvt(const Params& p, float* lds  , int j0, int j1, int wv0, int wvn, bool fills) {
    unsigned char* const ws_ = lws(p);
    const int tid = ltid();
    if (fills) for (int l = 0; l < 2; ++l) {
        bf16* bi = FP8_INPROJ ? (bf16*)(ws_ + WS_BT_IN + (size_t)l * ZLD * 1024 + (size_t)IN_DIM * 1024) : (bf16*)(ws_ + WS_BT_IN) + (size_t)l * ZLD * 1024 + (size_t)IN_DIM * 1024;
        for (int i = blockIdx.x * NWG_THREADS + tid; i < (ZLD - IN_DIM) * (FP8_INPROJ ? 512 : 1024); i += gridDim.x * NWG_THREADS) bi[i] = 0;
        bf16* bk = (bf16*)(ws_ + WS_BT_UKV) + (size_t)l * 1024 * 256;
        for (int i = blockIdx.x * NWG_THREADS + tid; i < 1024 * 128; i += gridDim.x * NWG_THREADS) bk[(size_t)(i >> 7) * 256 + 128 + (i & 127)] = 0;
    }
    const int lane = tid & 63;
    float* lw = lds + (tid >> 6) * (64 * 65);
    int gbase = 0;
    for (int j = j0; j < j1; ++j) {
        CvtJob J; get_job(p, ws_, j, J);
        const int tk = J.K / 64, tn = (J.N + 63) / 64, nt = tk * tn;
        int t0 = (wv0 + (tid >> 6) - gbase) % wvn; if (t0 < 0) t0 += wvn;
        gbase = (gbase + nt) % wvn;
        for (int t = t0; t < nt; t += wvn) cvt_tile(J, t, tn, lw, lane);
    }
    __syncthreads();
}

DI void phase_mod(const Params& p, float* lds) {
    unsigned char* const ws_ = lws(p);
    const int tid = ltid();
    float* sc = lds; float* red = lds + 3 * 1024;
    for (int i = tid; i < 3 * 1024; i += NWG_THREADS) { const int r = i >> 10, k = i & 1023; const float c = r < 2 ? p.in[1][r * 1024 + k] : p.in[3][k]; sc[i] = c * sigmoidf_(c); }
    __syncthreads();
    const int kg = tid >> 6, cl = tid & 63;
    for (int it = blockIdx.x; it < 2 * 96; it += gridDim.x) {
        const int l = it / 96, j = (it % 96) * 64 + cl;
        const float* w = p.in[4] + (size_t)l * 1024 * 6144;
        float a0 = 0.f, a1 = 0.f, a2 = 0.f;
        for (int k = kg * 128; k < kg * 128 + 128; ++k) { const float wv = w[(size_t)k * 6144 + j]; a0 += sc[k] * wv; a1 += sc[1024 + k] * wv; a2 += sc[2048 + k] * wv; }
        red[(kg * 3 + 0) * 64 + cl] = a0; red[(kg * 3 + 1) * 64 + cl] = a1; red[(kg * 3 + 2) * 64 + cl] = a2;
        __syncthreads();
        if (tid < 192) {
            const int r = tid >> 6; float s = p.in[5][l * 6144 + j];
            for (int g = 0; g < 8; ++g) s += red[(g * 3 + r) * 64 + cl];
            ((float*)(ws_ + WS_MOD))[((size_t)l * 3 + r) * 6144 + j] = s;
        }
        __syncthreads();
    }
}
DI void sincos_d(double a, float& c, float& s) {
    const double TWO_PI = 6.283185307179586476925;
    a -= TWO_PI * rint(a / TWO_PI);
    const double a2 = a * a; double ts = a, tc = 1.0, ss = a, cs = 1.0;
    for (int i = 1; i <= 15; ++i) { tc *= -a2 / ((2 * i - 1) * (2 * i)); cs += tc; ts *= -a2 / ((2 * i) * (2 * i + 1)); ss += ts; }
    c = (float)cs; s = (float)ss;
}
DI void phase_tables(const Params& p) {
    unsigned char* const ws_ = lws(p);
    const int tid = ltid();
    const int gt = blockIdx.x * NWG_THREADS + tid, ng = gridDim.x * NWG_THREADS;
    float* rope = (float*)(ws_ + WS_ROPE);
    for (int i = gt; i < 256 * 8 + 64 * 8 + 256 * 16 + 64 * 16; i += ng) {
        int pos, f, nf; float* dst;
        if (i < 2048) { pos = i / 8; f = i % 8; nf = 8; dst = rope + ROPE_MROW + i * 2; }
        else if (i < 2560) { const int q = i - 2048; pos = q / 8; f = q % 8; nf = 8; dst = rope + ROPE_MCOL + q * 2; }
        else if (i < 2560 + 4096) { const int q = i - 2560; pos = q / 16; f = q % 16; nf = 16; dst = rope + ROPE_DROW + q * 2; }
        else { const int q = i - 6656; pos = q / 16; f = q % 16; nf = 16; dst = rope + ROPE_DCOL + q * 2; }
        const float inv = powf(10000.0f, -(float)f / (float)nf);
        const float ang = (float)pos * inv;
        float c, s; sincos_d((double)ang, c, s); dst[0] = c; dst[1] = s;
    }
    float* lam = (float*)(ws_ + WS_LAM);
    if (gt < 2) {
        const int l = gt; float s1 = 0.f, s2 = 0.f;
        for (int i = 0; i < 64; ++i) { s1 += p.in[12][l * 64 + i] * p.in[13][l * 64 + i]; s2 += p.in[14][l * 64 + i] * p.in[15][l * 64 + i]; }
        const float li = l == 0 ? 0.2f : (float)(0.8 - 0.6 * 0.74081822068171786607);
        lam[l] = expf(s1) - expf(s2) + li; lam[2 + l] = li;
    }
    if (gt >= 64 && gt < 64 + 16) {
        const int q = gt - 64; const float* r = p.in[7] + (size_t)q * 15 * 31; float m = r[0];
        for (int i = 1; i < 15 * 31; ++i) m = fmaxf(m, r[i]);
        lam[4 + q] = m * LOG2E;
    }
    float* bias = (float*)(ws_ + WS_BIAS);
    for (int i = gt; i < 2 * 8 * 15 * 4 * 1024; i += ng) {
        const int reg = i & 15, lane = (i >> 4) & 63, cg = (i >> 10) & 1, qh = (i >> 11) & 1; const int q = i >> 12; const int ro = q % 15, lh = q / 15;
        const int n = lane & 31, hh = lane >> 5, kcl = (reg & 3) + 8 * (reg >> 2) + 4 * hh;
        const int c = qh * 32 + n, kc = cg * 32 + kcl;
        int cs = c - 8; cs = cs < 0 ? 0 : (cs > 48 ? 48 : cs);
        float v = -1e30f;
        if (kc >= cs && kc < cs + 16) v = p.in[7][((size_t)lh * 15 + ro) * 31 + (kc - c + 15)] * LOG2E;
        bias[i] = v;
    }
}

DI void ln_stats16(const f32x4 (&v)[4], float& mu, float& rstd) {
    float s = 0.f;
#pragma unroll
    for (int i = 0; i < 4; ++i) s += (v[i][0] + v[i][1]) + (v[i][2] + v[i][3]);
    mu = wave_sum(s) * (1.f / 1024.f);
    float q = 0.f;
#pragma unroll
    for (int i = 0; i < 4; ++i) { const f32x4 d = v[i] - mu; q += (d[0] * d[0] + d[1] * d[1]) + (d[2] * d[2] + d[3] * d[3]); }
    rstd = rsqrtf(wave_sum(q) * (1.f / 1024.f) + EPS);
}
DI void phase_lnmod1(const Params& p, int layer) {
    unsigned char* const ws_ = lws(p);
    const int tid = ltid();
    const int lane = tid & 63;
    const float* mod = (const float*)(ws_ + WS_MOD) + (size_t)layer * 3 * 6144;
    bf16* H = (bf16*)(ws_ + WS_H);
    for (int row = gwave(tid); row < MROWS; row += nwaves()) {
        const float* xr = x_src_row(p.in[0], p.in[2], (const float*)(ws_ + WS_X), layer, row);
        f32x4 v[4];
#pragma unroll
        for (int i = 0; i < 4; ++i) v[i] = *(const f32x4*)(xr + i * 256 + lane * 4);
        float mu, rstd; ln_stats16(v, mu, rstd);
        const float* mr = mod + (size_t)mod_row_of(row) * 6144;
#pragma unroll
        for (int i = 0; i < 4; ++i) {
            const int c = i * 256 + lane * 4;
            const f32x4 sh = *(const f32x4*)(mr + c), sc = *(const f32x4*)(mr + 1024 + c);
            const f32x4 y = (v[i] - mu) * rstd * (sc + 1.f) + sh;
            if (FP8_INPROJ && FP8_GATE) *(unsigned*)((unsigned char*)H + (size_t)row * D + c) = pk4_fp8(y[0], y[1], y[2], y[3]);
            else { u32x2 o; o.x = pk2(y[0], y[1]); o.y = pk2(y[2], y[3]); *(u32x2*)(H + (size_t)row * D + c) = o; }
        }
    }
}

struct RowMapId { DI int operator()(int tm) const { return tm * 32; } };
struct RowMapCtx { DI int operator()(int tm) const { return (tm >> 3) * TPB + (tm & 7) * 32; } };
struct RowMapOff { int off; DI int operator()(int tm) const { return off + tm * 32; } };
template <class Epi, class BSel, class RowMap = RowMapId, bool FP8 = false>
DI void sgemm_phase(const bf16* A, int lda, const bf16* Bt, int ldb, int M, int N, int K, const Epi& E, const BSel& bsel, const RowMap& rmap = RowMap(), const int* gidx = nullptr) {
    const int tid = ltid();
    const int lane = tid & 63, r = lane & 31, h = lane >> 5;
    const int tnn = N / 32, nt = (M / 32) * tnn, nch = K / 64;
    for (int t = gwave(tid); t < nt; t += nwaves()) {
        const int tm = t / tnn, tn = t % tnn;
        const int row0 = rmap(tm);
        const bf16* Ab = A + (size_t)(gidx ? gidx[row0 + r] : row0 + r) * lda + 32 * h;
        const bf16* Bb = Bt + bsel(row0) + (size_t)(tn * 32 + r) * ldb + 32 * h;
        f32x16 acc;
#pragma unroll
        for (int q = 0; q < 16; ++q) acc[q] = 0.f;
        i32x8 a[4][2], b[4][2];
#define SG_LD8(dst_, ptr_) do { const u32x4 x_ = *(const u32x4*)(ptr_), y_ = *(const u32x4*)((ptr_) + 8); \
            dst_ = (i32x8){(int)x_[0], (int)x_[1], (int)x_[2], (int)x_[3], (int)y_[0], (int)y_[1], (int)y_[2], (int)y_[3]}; } while (0)
#define SG_LO(v_) __builtin_bit_cast(bf16x8, __builtin_shufflevector(v_, v_, 0, 1, 2, 3))
#define SG_HI(v_) __builtin_bit_cast(bf16x8, __builtin_shufflevector(v_, v_, 4, 5, 6, 7))
#define SG_LOAD(slot_, ch_) do { const int c_ = (ch_) < nch ? (ch_) : nch - 1; _Pragma("unroll") for (int s_ = 0; s_ < 2; ++s_) { \
            SG_LD8(a[slot_][s_], Ab + c_ * 64 + s_ * 16); SG_LD8(b[slot_][s_], Bb + c_ * 64 + s_ * 16); } } while (0)
#define SG_MMA(slot_) do { _Pragma("unroll") for (int s_ = 0; s_ < 2; ++s_) { if constexpr (FP8) acc = MFMA8(b[slot_][s_], a[slot_][s_], acc, 0, 0); \
            else { acc = MFMA32(SG_LO(b[slot_][s_]), SG_LO(a[slot_][s_]), acc); acc = MFMA32(SG_HI(b[slot_][s_]), SG_HI(a[slot_][s_]), acc); } } } while (0)
        SG_LOAD(0, 0); SG_LOAD(1, 1); SG_LOAD(2, 2); SG_LOAD(3, 3);
#pragma unroll 1
        for (int c = 0; c < nch; c += 4) {
            SG_MMA(0); SG_LOAD(0, c + 4);
            if (c + 1 < nch) { SG_MMA(1); SG_LOAD(1, c + 5); }
            if (c + 2 < nch) { SG_MMA(2); SG_LOAD(2, c + 6); }
            if (c + 3 < nch) { SG_MMA(3); SG_LOAD(3, c + 7); }
        }
#undef SG_LOAD
#undef SG_MMA
#undef SG_LD8
#undef SG_LO
#undef SG_HI
        if constexpr (Epi::PAIR) {
#pragma unroll
            for (int g = 0; g < 2; ++g) {
                const f32x4 v0 = {acc[4 * g], acc[4 * g + 1], acc[4 * g + 2], acc[4 * g + 3]};
                const f32x4 v1 = {acc[4 * g + 8], acc[4 * g + 9], acc[4 * g + 10], acc[4 * g + 11]};
                E.store_pair(row0 + r, tn * 16 + 8 * g + 4 * h, v0, v1);
            }
        } else {
#pragma unroll
            for (int g = 0; g < 4; ++g) {
                const f32x4 v = {acc[4 * g], acc[4 * g + 1], acc[4 * g + 2], acc[4 * g + 3]};
                E.store4(row0 + r, tn * 32 + 8 * g + 4 * h, v);
            }
        }
    }
}
struct BSelNone { DI size_t operator()(int) const { return 0; } };
struct BSelMoe { size_t estride; DI size_t operator()(int s) const { const int e = s < NSLOT_L ? s / (NB * CAP_L) : (s - NSLOT_L) / (NB * CAP_C); return (size_t)e * estride; } };

struct EpiStoreBf16 { static constexpr bool PAIR = false, BATCH = false; bf16* C; int ldc; float sc; DI void store4(int r, int c, f32x4 v) const { v *= sc; u32x2 o; o.x = pk2(v[0], v[1]); o.y = pk2(v[2], v[3]); *(u32x2*)(C + (size_t)r * ldc + c) = o; } };
struct EpiGate { static constexpr bool PAIR = false, BATCH = true; bf16* G; const float* bias; float sc;
    struct Pre { f32x4 b; };
    DI Pre load(int, int c) const { Pre p; p.b = *(const f32x4*)(bias + c); return p; }
    DI void apply(int r, int c, f32x4 v, const Pre& p) const { v = v * sc + p.b; u32x2 o; o.x = pk2(sigmoidf_(v[0]), sigmoidf_(v[1])); o.y = pk2(sigmoidf_(v[2]), sigmoidf_(v[3])); *(u32x2*)(G + (size_t)r * 3072 + c) = o; }
    DI void store4(int r, int c, f32x4 v) const { apply(r, c, v, load(r, c)); } };
template <int I> struct EpiMerge { static constexpr bool PAIR = false, BATCH = true; const bf16* G; bf16* Mp  ; bf16* Mb;
    struct Pre { u32x2 g; u32x2 m; };
    DI Pre load(int r, int c) const { Pre p; p.g = *(const u32x2*)(G + (size_t)r * 3072 + I * 1024 + c); if (I > 0) p.m = *(const u32x2*)(Mp + (size_t)r * D + c); else p.m = (u32x2){0u, 0u}; return p; }
    DI void apply(int r, int c, f32x4 v, const Pre& p) const {
        f32x4 m = {lo_f(p.g.x) * v[0], hi_f(p.g.x) * v[1], lo_f(p.g.y) * v[2], hi_f(p.g.y) * v[3]};
        if (I > 0) m += (f32x4){lo_f(p.m.x), hi_f(p.m.x), lo_f(p.m.y), hi_f(p.m.y)};
        u32x2 o; o.x = pk2(m[0], m[1]); o.y = pk2(m[2], m[3]);
        *(u32x2*)((I < 2 ? Mp : Mb) + (size_t)r * D + c) = o; }
    DI void store4(int r, int c, f32x4 v) const { apply(r, c, v, load(r, c)); } };
struct EpiOut { static constexpr bool PAIR = false, BATCH = true; const float* xin; const float* cin; int layer; const float* mod; float* X;
    struct Pre { f32x4 g1, xo; };
    DI Pre load(int r, int c) const { Pre p; p.g1 = *(const f32x4*)(mod + (size_t)mod_row_of(r) * 6144 + 2048 + c); p.xo = *(const f32x4*)(x_src_row(xin, cin, X, layer, r) + c); return p; }
    DI void apply(int r, int c, f32x4 v, const Pre& p) const { *(f32x4*)(X + (size_t)r * D + c) = p.xo * ALPHA + p.g1 * v; }
    DI void store4(int r, int c, f32x4 v) const { apply(r, c, v, load(r, c)); } };
struct EpiAct { static constexpr bool PAIR = true; unsigned char* Act;
    DI void store_pair(int r, int c, f32x4 g, f32x4 u) const {
        float a[4];
#pragma unroll
        for (int i = 0; i < 4; ++i) { const float gg = g[i] * (1.f / W1_SCALE), uu = u[i] * (1.f / W1_SCALE); a[i] = fminf(fmaxf(gg * sigmoidf_(gg) * uu * ACT_SCALE, -440.f), 440.f); }
        *(unsigned*)(Act + (size_t)r * FF + c) = pk4_fp8(a[0], a[1], a[2], a[3]); } };
struct EpiDown { static constexpr bool PAIR = false, BATCH = true; bf16* Y; const float* w;
    struct Pre { float g; };
    DI Pre load(int r, int) const { Pre p; p.g = w[r]; return p; }
    DI void apply(int r, int c, f32x4 v, const Pre& p) const { const float g = p.g * (1.f / (W2_SCALE * ACT_SCALE)); u32x2 o; o.x = pk2(v[0] * g, v[1] * g); o.y = pk2(v[2] * g, v[3] * g); *(u32x2*)(Y + (size_t)r * D + c) = o; }
    DI void store4(int r, int c, f32x4 v) const { apply(r, c, v, load(r, c)); } };

DI void kmax_update(unsigned* slot, float n2half, int tid) {
    float n2 = n2half + __shfl_xor(n2half, 32, tid);
    n2 = wave_max(n2);
    if ((tid & 63) == 0) atomicMax(slot, __float_as_uint(n2));
}
DI void phase_prep1(const Params& p, int layer) {
    unsigned char* const ws_ = lws(p);
    const int tid = ltid();
    const int lane = tid & 63, n = lane & 31, hh = lane >> 5;
    const bf16* Z = (const bf16*)(ws_ + R_Z);
    unsigned* kmax = (unsigned*)(ws_ + WS_KMAX) + layer * 48;
    const float* rope = (const float*)(ws_ + WS_ROPE);
    for (int it = gwave(tid); it < NKG * 19; it += nwaves()) {
        const int kg = it / 19, sub = it - kg * 19, part = sub < 8 ? 0 : (sub < 16 ? 1 : (sub < 18 ? 2 : 3));
        const int b = kg / KGPB, kgl = kg - b * KGPB;
        const int row = kg * 32 + n, t = kgl * 32 + n;
        const bool lat = t >= CTX; const int tl = t - CTX, gr = tl >> 6, gc = tl & 63;
        const bf16* zr = Z + (size_t)row * ZLD;
        if (part == 0) {
            const int h = sub;
            bf16* Q = (bf16*)(ws_ + R_QNA) + (size_t)row * 512 + h * 64 + hh * 32;
            const float qs = 0.125f * LOG2E;
            bf16x8 qv[4], kv[4], vv[4];
#pragma unroll
            for (int i = 0; i < 4; ++i) qv[i] = *(const bf16x8*)(zr + ZO_AQ + h * 64 + hh * 32 + i * 8);
#pragma unroll
            for (int ks = 0; ks < 4; ++ks) kv[ks] = *(const bf16x8*)(zr + ZO_AK + h * 64 + ks * 16 + 8 * hh);
#pragma unroll
            for (int s = 0; s < 2; ++s)
#pragma unroll
                for (int dvt = 0; dvt < 2; ++dvt) {
#pragma unroll
                    for (int j = 0; j < 8; ++j) { const int key = 16 * s + 8 * (j >> 2) + 4 * hh + (j & 3); vv[s * 2 + dvt][j] = (short)Z[(size_t)(kg * 32 + key) * ZLD + ZO_AV + h * 64 + dvt * 32 + n]; }
                }
#pragma unroll
            for (int i = 0; i < 4; ++i) *(bf16x8*)(Q + i * 8) = scale8(qv[i], qs);
            {
                bf16* Kf = (bf16*)(ws_ + R_KFNA) + ((size_t)(b * 8 + h) * KGPB + kgl) * 2048 + lane * 8;
                float n2 = 0.f;
#pragma unroll
                for (int ks = 0; ks < 4; ++ks) { n2 += sumsq8p(kv[ks]); *(bf16x8*)(Kf + ks * 512) = kv[ks]; }
                kmax_update(kmax + 0 * 16 + b * 8 + h, n2, tid);
                bf16* Vf = (bf16*)(ws_ + R_VFNA) + ((size_t)(b * 8 + h) * KGPB + kgl) * 2048 + lane * 8;
#pragma unroll
                for (int q = 0; q < 4; ++q) *(bf16x8*)(Vf + q * 512) = vv[q];
            }
        } else if (part == 1) {
            const float* rt = hh == 0 ? rope + ROPE_DROW + (size_t)gr * 32 : rope + ROPE_DCOL + (size_t)gc * 32;
            float* qn = (float*)(ws_ + WS_QN);
            { const int qk = (sub - 8) >> 2, sp = ((sub - 8) & 3) * 2;
                bf16x8 raw[2][4];
#pragma unroll
                for (int u = 0; u < 2; ++u)
#pragma unroll
                    for (int i = 0; i < 4; ++i) raw[u][i] = *(const bf16x8*)(zr + (qk ? ZO_DK : ZO_DQ) + (sp + u) * 64 + 32 * hh + i * 8);
                float rc[16], rs[16];
                if (lat) {
#pragma unroll
                    for (int i = 0; i < 16; ++i) { rc[i] = rt[i * 2]; rs[i] = rt[i * 2 + 1]; }
                }
#pragma unroll
                for (int u = 0; u < 2; ++u) { const int s = sp + u;
                    float f[32];
#pragma unroll
                    for (int i = 0; i < 4; ++i) { float t8[8]; unpack8(raw[u][i], t8);
#pragma unroll
                        for (int j = 0; j < 8; ++j) f[i * 8 + j] = t8[j]; }
                    if (lat) {
#pragma unroll
                        for (int i = 0; i < 16; ++i) { const float c = rc[i], sn = rs[i], a = f[i], bb = f[16 + i]; f[i] = a * c - bb * sn; f[16 + i] = a * sn + bb * c; }
                    }
                    float n2 = 0.f;
#pragma unroll
                    for (int i = 0; i < 32; ++i) { f[i] *= SQC_D; n2 += f[i] * f[i]; }
                    const u32x4 p0 = pk16_fp8(f), p1 = pk16_fp8(f + 16);
                    if (qk == 0) {
                        unsigned char* Q = ws_ + R_QD + (size_t)row * 512 + s * 64 + 32 * hh;
                        *(u32x4*)Q = p0; *(u32x4*)(Q + 16) = p1;
                        const float nt = n2 + __shfl_xor(n2, 32);
                        if (hh == 0) qn[(size_t)row * 8 + s] = sqrtf(nt);
                    } else {
                        unsigned char* Kf = ws_ + R_KFD + ((size_t)(b * 8 + s) * KGPB + kgl) * 2048 + lane * 16;
                        *(u32x4*)Kf = p0; *(u32x4*)(Kf + 1024) = p1;
                        kmax_update(kmax + 1 * 16 + b * 8 + s, n2, tid);
                    }
                } }
        } else if (part == 2) {
            const int kg2 = kg >> 1, kg2l = kgl >> 1;
            { const int hq = sub - 16;
                const int h4 = (kg & 1) * 2 + hq;
                unsigned char* Vf = ws_ + R_VFD + ((size_t)(b * 4 + h4) * (KGPB / 2) + kg2l) * 8192 + lane * 16;
#pragma unroll 1
                for (int dvt = 0; dvt < 4; ++dvt) {
                    float f[32];
#pragma unroll
                    for (int j = 0; j < 32; ++j) f[j] = bf2f(Z[(size_t)(kg2 * 64 + kappa(hh, j)) * ZLD + ZO_DV + h4 * 128 + dvt * 32 + n]);
                    *(u32x4*)(Vf + dvt * 2048) = pk16_fp8(f); *(u32x4*)(Vf + dvt * 2048 + 1024) = pk16_fp8(f + 16);
                }
            }
        } else {
            float sq = 0.f, sk = 0.f;
#pragma unroll
            for (int i = 0; i < 16; ++i) sq += sumsq8p(*(const bf16x8*)(zr + ZO_CQ + hh * 128 + i * 8));
#pragma unroll
            for (int i = 0; i < 8; ++i) sk += sumsq8p(*(const bf16x8*)(zr + ZO_CKV + hh * 64 + i * 8));
            sq += __shfl_xor(sq, 32); sk += __shfl_xor(sk, 32);
            float* ir = (float*)(ws_ + WS_INVRMS) + (size_t)row * 2;
            if (hh == 0) { ir[0] = rsqrtf(sq * (1.f / 256.f) + EPS); ir[1] = rsqrtf(sk * (1.f / 128.f) + EPS); }
            float x1[8], x2[8];
            unpack8(*(const bf16x8*)(zr + ZO_KR + hh * 16), x1); unpack8(*(const bf16x8*)(zr + ZO_KR + hh * 16 + 8), x2);
            if (lat) {
                const float* tb = hh == 0 ? rope + ROPE_MROW + (size_t)gr * 16 : rope + ROPE_MCOL + (size_t)gc * 16;
#pragma unroll
                for (int j = 0; j < 8; ++j) { const float c = tb[j * 2], s = tb[j * 2 + 1], a = x1[j], bb = x2[j]; x1[j] = a * c - bb * s; x2[j] = a * s + bb * c; }
            }
            float* kr = (float*)(ws_ + WS_KROPE) + (size_t)row * 32 + hh * 16;
#pragma unroll
            for (int j = 0; j < 8; ++j) { kr[j] = x1[j]; kr[8 + j] = x2[j]; }
        }
    }
}

DI void phase_prep2(const Params& p, int layer) {
    unsigned char* const ws_ = lws(p);
    const int tid = ltid();
    const int lane = tid & 63, n = lane & 31, hh = lane >> 5;
    const bf16* QR = (const bf16*)(ws_ + R_QRAW); const bf16* KV = (const bf16*)(ws_ + R_KVRAW);
    const float* IR = (const float*)(ws_ + WS_INVRMS); const float* KR = (const float*)(ws_ + WS_KROPE);
    unsigned* kmax = (unsigned*)(ws_ + WS_KMAX) + layer * 48 + 2 * 16;
    const float* rope = (const float*)(ws_ + WS_ROPE);
    for (int it = gwave(tid); it < NKG * 16; it += nwaves()) {
        const int kg = it >> 4, sub = it & 15, part = sub < 4 ? 0 : (sub < 12 ? 1 : 2);
        const int b = kg / KGPB, kgl = kg - b * KGPB;
        const int row = kg * 32 + n, t = kgl * 32 + n;
        const bool lat = t >= CTX; const int tl = t - CTX, gr = tl >> 6, gc = tl & 63;
        if (part == 0) {
            const float qs = IR[(size_t)row * 2] * SQC_M;
            const float* rr = rope + ROPE_MROW + (size_t)gr * 16; const float* rc = rope + ROPE_MCOL + (size_t)gc * 16;
            float* qn = (float*)(ws_ + WS_QN) + (size_t)MROWS * 8;
            { const int hq = sub;
                const int h = hh * 4 + hq;
                const bf16* src = QR + (size_t)row * 768 + h * 96; unsigned char* dst = ws_ + R_QMLA + (size_t)row * 1024 + h * 128;
                float f[96];
#pragma unroll
                for (int i = 0; i < 12; ++i) { float t8[8]; unpack8(*(const bf16x8*)(src + i * 8), t8);
#pragma unroll
                    for (int j = 0; j < 8; ++j) f[i * 8 + j] = t8[j]; }
                if (lat) {
#pragma unroll
                    for (int j = 0; j < 8; ++j) {
                        const float c0 = rr[j * 2], s0 = rr[j * 2 + 1], c1 = rc[j * 2], s1 = rc[j * 2 + 1];
                        const float a = f[64 + j], bb = f[72 + j], c = f[80 + j], d = f[88 + j];
                        f[64 + j] = a * c0 - bb * s0; f[72 + j] = a * s0 + bb * c0; f[80 + j] = c * c1 - d * s1; f[88 + j] = c * s1 + d * c1;
                    }
                }
                float n2 = 0.f;
#pragma unroll
                for (int i = 0; i < 96; ++i) { f[i] *= qs; n2 += f[i] * f[i]; }
#pragma unroll
                for (int i = 0; i < 6; ++i) *(u32x4*)(dst + i * 16) = pk16_fp8(f + i * 16);
                *(u32x4*)(dst + 96) = (u32x4){0u, 0u, 0u, 0u}; *(u32x4*)(dst + 112) = (u32x4){0u, 0u, 0u, 0u};
                qn[(size_t)row * 8 + h] = sqrtf(n2);
            }
        } else if (part == 1) {
            const float ks_ = IR[(size_t)row * 2 + 1] * SQC_M;
            float fr[32]; float nr = 0.f;
#pragma unroll
            for (int i = 0; i < 32; ++i) { fr[i] = hh == 0 ? KR[(size_t)row * 32 + i] * SQC_M : 0.f; nr += fr[i] * fr[i]; }
            const u32x4 r0 = pk16_fp8(fr), r1 = pk16_fp8(fr + 16);
            { const int h = sub - 4;
                unsigned char* Kf = ws_ + R_KFMLA + ((size_t)(b * 8 + h) * KGPB + kgl) * 4096 + lane * 16;
                float f[32]; float n2 = nr;
#pragma unroll
                for (int i = 0; i < 4; ++i) { float t8[8]; unpack8(*(const bf16x8*)(KV + (size_t)row * 1024 + h * 128 + 32 * hh + i * 8), t8);
#pragma unroll
                    for (int j = 0; j < 8; ++j) { f[i * 8 + j] = t8[j] * ks_; n2 += f[i * 8 + j] * f[i * 8 + j]; } }
                *(u32x4*)Kf = pk16_fp8(f); *(u32x4*)(Kf + 1024) = pk16_fp8(f + 16);
                *(u32x4*)(Kf + 2048) = r0; *(u32x4*)(Kf + 3072) = r1;
                kmax_update(kmax + b * 8 + h, n2, tid);
            }
        } else {
            const int kg2 = kg >> 1, kg2l = kgl >> 1;
            float sc[32];
#pragma unroll
            for (int j = 0; j < 32; ++j) sc[j] = IR[(size_t)(kg2 * 64 + kappa(hh, j)) * 2 + 1];
            { const int hq = sub - 12;
                const int h = (kg & 1) * 4 + hq;
                unsigned char* Vf = ws_ + R_VFMLA + ((size_t)(b * 8 + h) * (KGPB / 2) + kg2l) * 4096 + lane * 16;
#pragma unroll 1
                for (int dvt = 0; dvt < 2; ++dvt) {
                    float f[32];
#pragma unroll
                    for (int j = 0; j < 32; ++j) f[j] = bf2f(KV[(size_t)(kg2 * 64 + kappa(hh, j)) * 1024 + h * 128 + 64 + dvt * 32 + n]) * sc[j];
                    *(u32x4*)(Vf + dvt * 2048) = pk16_fp8(f); *(u32x4*)(Vf + dvt * 2048 + 1024) = pk16_fp8(f + 16);
                }
            }
        }
    }
}

template <int DQK, int DV, bool NA>
DI void attn_wave(const bf16* Q  , const bf16* Kf, const bf16* Vf, int kg0, int kg1, float kmax2,
                  bf16* O  ,
                  const float* bias  , float bmax, int gr, int qh) {
    const int tid = ltid();
    constexpr int NKS = DQK / 16, NDT = DV / 32, KSTR = NKS * 512, VSTR = 2 * NDT * 512;
    const int lane = tid & 63, hh = lane >> 5;
    bf16x8 qf[NKS]; float qn = 0.f;
#pragma unroll
    for (int ks = 0; ks < NKS; ++ks) { qf[ks] = *(const bf16x8*)(Q + ks * 16 + 8 * hh); qn += sumsq8p(qf[ks]); }
    qn += __shfl_xor(qn, 32);
    const float m = sqrtf(qn) * sqrtf(kmax2) * 1.0001f + (NA ? fmaxf(bmax, 0.f) : 0.f);
    f32x16 cinit;
#pragma unroll
    for (int i = 0; i < 16; ++i) cinit[i] = -m;
    f32x16 o[NDT];
#pragma unroll
    for (int d = 0; d < NDT; ++d)
#pragma unroll
        for (int i = 0; i < 16; ++i) o[d][i] = 0.f;
    float lsum = 0.f;
    int rs = 0;
    if (NA) { rs = gr - 4; rs = rs < 0 ? 0 : (rs > 248 ? 248 : rs); }
    const int nsteps = NA ? 24 : (kg1 - kg0);
    auto kg_of = [&](int st) -> int { if (!NA) return kg0 + st; return st < 8 ? st : 8 + (rs + ((st - 8) >> 1)) * 2 + ((st - 8) & 1); };
    bf16x8 kf[NKS], vf[2 * NDT];
    { const int kg = kg_of(0);
#pragma unroll
      for (int ks = 0; ks < NKS; ++ks) kf[ks] = *(const bf16x8*)(Kf + (size_t)kg * KSTR + ks * 512 + lane * 8);
#pragma unroll
      for (int i = 0; i < 2 * NDT; ++i) vf[i] = *(const bf16x8*)(Vf + (size_t)kg * VSTR + i * 512 + lane * 8); }
    f32x4 bc[4];
#pragma unroll
    for (int q = 0; q < 4; ++q) bc[q] = (f32x4){0.f, 0.f, 0.f, 0.f};
#pragma unroll 1
    for (int st = 0; st < nsteps; ++st) {
        bf16x8 kn[NKS], vn[2 * NDT]; f32x4 bn[4];
        { const int sn = st + 1 < nsteps ? st + 1 : st; const int kg = kg_of(sn);
#pragma unroll
          for (int ks = 0; ks < NKS; ++ks) kn[ks] = *(const bf16x8*)(Kf + (size_t)kg * KSTR + ks * 512 + lane * 8);
#pragma unroll
          for (int i = 0; i < 2 * NDT; ++i) vn[i] = *(const bf16x8*)(Vf + (size_t)kg * VSTR + i * 512 + lane * 8);
          if (NA && sn >= 8) {
              const int i = (sn - 8) >> 1, cg = (sn - 8) & 1, ro = rs + i - gr + 7;
              const float* bt = bias + ((size_t)(ro * 2 + qh) * 2 + cg) * 1024 + lane * 16;
#pragma unroll
              for (int q = 0; q < 4; ++q) bn[q] = *(const f32x4*)(bt + q * 4);
          } else {
#pragma unroll
              for (int q = 0; q < 4; ++q) bn[q] = (f32x4){0.f, 0.f, 0.f, 0.f};
          } }
        f32x16 s = cinit;
        if (NA && st >= 8) {
#pragma unroll
            for (int q = 0; q < 4; ++q) { s[4 * q] += bc[q][0]; s[4 * q + 1] += bc[q][1]; s[4 * q + 2] += bc[q][2]; s[4 * q + 3] += bc[q][3]; }
        }
#pragma unroll
        for (int ks = 0; ks < NKS; ++ks) s = MFMA32(kf[ks], qf[ks], s);
        unsigned pp[8];
#pragma unroll
        for (int i = 0; i < 8; ++i) { const float p0 = __builtin_amdgcn_exp2f(s[2 * i]), p1 = __builtin_amdgcn_exp2f(s[2 * i + 1]); lsum += p0 + p1; pp[i] = pk2(p0, p1); }
        const u32x4 u0 = {pp[0], pp[1], pp[2], pp[3]}, u1 = {pp[4], pp[5], pp[6], pp[7]};
        const bf16x8 pf0 = __builtin_bit_cast(bf16x8, u0), pf1 = __builtin_bit_cast(bf16x8, u1);
#pragma unroll
        for (int d = 0; d < NDT; ++d) { o[d] = MFMA32(vf[d], pf0, o[d]); o[d] = MFMA32(vf[NDT + d], pf1, o[d]); }
#pragma unroll
        for (int ks = 0; ks < NKS; ++ks) kf[ks] = kn[ks];
#pragma unroll
        for (int i = 0; i < 2 * NDT; ++i) vf[i] = vn[i];
#pragma unroll
        for (int q = 0; q < 4; ++q) bc[q] = bn[q];
    }
    lsum += __shfl_xor(lsum, 32);
    const float inv = 1.f / lsum;
#pragma unroll
    for (int d = 0; d < NDT; ++d)
#pragma unroll
        for (int g = 0; g < 4; ++g) {
            u32x2 w; w.x = pk2(o[d][4 * g] * inv, o[d][4 * g + 1] * inv); w.y = pk2(o[d][4 * g + 2] * inv, o[d][4 * g + 3] * inv);
            *(u32x2*)(O + d * 32 + 8 * g + 4 * hh) = w;
        }
}


#define LAS3 __attribute__((address_space(3)))
template <int DQK, int DV, int SKG>
DI void attn_block(LAS3 unsigned char* lds, const bf16* Q, const bf16* Kf, const bf16* Vf, int nst, float kmax2, bf16* O, int tid) {
    constexpr int NKS = DQK / 16, NDT = DV / 32, KCH = NKS, VCH = 2 * NDT, SCH = SKG * (KCH + VCH), CPW = SCH / 8, SBYTES = SCH * 1024;
    static_assert(SCH % 8 == 0 && 3 * SBYTES <= 131072, "stage geometry");
    const int lane = tid & 63, hh = lane >> 5, w = __builtin_amdgcn_readfirstlane(tid >> 6);
    bf16x8 qf[NKS]; float qn = 0.f;
#pragma unroll
    for (int ks = 0; ks < NKS; ++ks) { qf[ks] = *(const bf16x8*)(Q + ks * 16 + 8 * hh); qn += sumsq8p(qf[ks]); }
    qn += __shfl_xor(qn, 32);
    const float m = sqrtf(qn) * sqrtf(kmax2) * 1.0001f;
    f32x16 cinit;
#pragma unroll
    for (int i = 0; i < 16; ++i) cinit[i] = -m;
    f32x16 o[NDT];
#pragma unroll
    for (int d = 0; d < NDT; ++d)
#pragma unroll
        for (int i = 0; i < 16; ++i) o[d][i] = 0.f;
    float lsum = 0.f;
#define ATT_ISSUE(st_, buf_) do { _Pragma("unroll") for (int i_ = 0; i_ < CPW; ++i_) { const int c_ = w * CPW + i_; \
        const bf16* src_ = c_ < SKG * KCH ? Kf + ((size_t)(st_) * (SKG * KCH) + c_) * 512 : Vf + ((size_t)(st_) * (SKG * VCH) + (c_ - SKG * KCH)) * 512; \
        __builtin_amdgcn_global_load_lds((const unsigned*)(src_ + lane * 8), (LAS3 unsigned*)(lds + (buf_) * SBYTES + c_ * 1024), 16, 0, 0); } } while (0)
    ATT_ISSUE(0, 0);
    if (nst > 1) ATT_ISSUE(1, 1);
    int buf = 0;
    for (int st = 0; st < nst; ++st) {
        if (st + 1 < nst) { if (CPW == 5) asm volatile("s_waitcnt vmcnt(5)" ::: "memory"); else if (CPW == 3) asm volatile("s_waitcnt vmcnt(3)" ::: "memory"); else asm volatile("s_waitcnt vmcnt(2)" ::: "memory"); }
        else asm volatile("s_waitcnt vmcnt(0)" ::: "memory");
        __builtin_amdgcn_s_barrier();
        asm volatile("" ::: "memory");
        if (st + 2 < nst) { const int nb = buf >= 1 ? buf - 1 : 2; ATT_ISSUE(st + 2, nb); }
        LAS3 const unsigned char* sb = lds + buf * SBYTES + lane * 16;
        bf16x8 kf[NKS];
#pragma unroll
        for (int ks = 0; ks < NKS; ++ks) kf[ks] = *(LAS3 const bf16x8*)(sb + ks * 1024);
#pragma unroll
        for (int g = 0; g < SKG; ++g) {
            bf16x8 vf[VCH], kn[NKS];
#pragma unroll
            for (int i = 0; i < VCH; ++i) vf[i] = *(LAS3 const bf16x8*)(sb + (SKG * KCH + g * VCH + i) * 1024);
            if (g + 1 < SKG) {
#pragma unroll
                for (int ks = 0; ks < NKS; ++ks) kn[ks] = *(LAS3 const bf16x8*)(sb + ((g + 1) * KCH + ks) * 1024);
            }
            asm volatile("" ::: "memory");
            f32x16 s = cinit;
#pragma unroll
            for (int ks = 0; ks < NKS; ++ks) s = MFMA32(kf[ks], qf[ks], s);
            unsigned pp[8];
#pragma unroll
            for (int i = 0; i < 8; ++i) { const float p0 = __builtin_amdgcn_exp2f(s[2 * i]), p1 = __builtin_amdgcn_exp2f(s[2 * i + 1]); lsum += p0 + p1; pp[i] = pk2(p0, p1); }
            const u32x4 u0 = {pp[0], pp[1], pp[2], pp[3]}, u1 = {pp[4], pp[5], pp[6], pp[7]};
            const bf16x8 pf0 = __builtin_bit_cast(bf16x8, u0), pf1 = __builtin_bit_cast(bf16x8, u1);
#pragma unroll
            for (int d = 0; d < NDT; ++d) { o[d] = MFMA32(vf[d], pf0, o[d]); o[d] = MFMA32(vf[NDT + d], pf1, o[d]); }
            if (g + 1 < SKG) {
#pragma unroll
                for (int ks = 0; ks < NKS; ++ks) kf[ks] = kn[ks];
            }
        }
        buf = buf == 2 ? 0 : buf + 1;
    }
#undef ATT_ISSUE
    lsum += __shfl_xor(lsum, 32);
    const float inv = 1.f / lsum;
#pragma unroll
    for (int d = 0; d < NDT; ++d)
#pragma unroll
        for (int g = 0; g < 4; ++g) {
            u32x2 wv; wv.x = pk2(o[d][4 * g] * inv, o[d][4 * g + 1] * inv); wv.y = pk2(o[d][4 * g + 2] * inv, o[d][4 * g + 3] * inv);
            *(u32x2*)(O + d * 32 + 8 * g + 4 * hh) = wv;
        }
    asm volatile("" ::: "memory");
    __builtin_amdgcn_s_barrier();
    asm volatile("" ::: "memory");
}


template <int NC, int NDT, bool VARB = true, bool ROT = true>
DI void attn_block8(LAS3 unsigned char* lds, const unsigned char* Q  , float qnorm, const unsigned char* Kf, const unsigned char* Vf, int nst, float kmax2,
                    bf16* O, int tid) {
    constexpr int KSB = 4 * NC * 2048, VSB = 2 * NDT * 2048, SBYTES = KSB + VSB, SCH = SBYTES / 1024, CPW = SCH / 8;
    static_assert(SCH == 24 && CPW == 3, "stage geometry");
    const int lane = tid & 63, hh = lane >> 5, w = __builtin_amdgcn_readfirstlane(tid >> 6);
    i32x8 qf[NC];
#pragma unroll
    for (int c = 0; c < NC; ++c) { const u32x4 a = *(const u32x4*)(Q + c * 64 + 32 * hh), b = *(const u32x4*)(Q + c * 64 + 32 * hh + 16);
        qf[c] = (i32x8){(int)a[0], (int)a[1], (int)a[2], (int)a[3], (int)b[0], (int)b[1], (int)b[2], (int)b[3]}; }
    const float csb = qnorm * sqrtf(kmax2) * 1.13f + 0.2f;
    f32x16 cinit;
    f32x16 o[NDT];
#pragma unroll
    for (int d = 0; d < NDT; ++d)
#pragma unroll
        for (int i = 0; i < 16; ++i) o[d][i] = 0.f;
    f32x16 lacc;
#pragma unroll
    for (int i = 0; i < 16; ++i) lacc[i] = 0.f;
    i32x8 ones8;
    asm volatile("v_mov_b32 %0, 0x38383838\n\tv_mov_b32 %1, 0x38383838\n\tv_mov_b32 %2, 0x38383838\n\tv_mov_b32 %3, 0x38383838\n\tv_mov_b32 %4, 0x38383838\n\tv_mov_b32 %5, 0x38383838\n\tv_mov_b32 %6, 0x38383838\n\tv_mov_b32 %7, 0x38383838"
                 : "=v"(ones8[0]), "=v"(ones8[1]), "=v"(ones8[2]), "=v"(ones8[3]), "=v"(ones8[4]), "=v"(ones8[5]), "=v"(ones8[6]), "=v"(ones8[7]));
#define ATT_ISSUE8(st_, buf_) do { _Pragma("unroll") for (int i_ = 0; i_ < CPW; ++i_) { const int c_ = w * CPW + i_; \
        const unsigned char* src_ = c_ < KSB / 1024 ? Kf + (size_t)(st_) * KSB + c_ * 1024 : Vf + (size_t)(st_) * VSB + (c_ - KSB / 1024) * 1024; \
        __builtin_amdgcn_global_load_lds((const unsigned*)(src_ + lane * 16), (LAS3 unsigned*)(lds + (buf_) * SBYTES + c_ * 1024), 16, 0, 0); } } while (0)
#define LD_FRAG8(dst_, off_) do { const u32x4 a_ = *(LAS3 const u32x4*)(sb + (off_)), b_ = *(LAS3 const u32x4*)(sb + (off_) + 1024); \
        dst_ = (i32x8){(int)a_[0], (int)a_[1], (int)a_[2], (int)a_[3], (int)b_[0], (int)b_[1], (int)b_[2], (int)b_[3]}; } while (0)
#define ATT_QK8X(kf_, s0, s1) do { s0 = cinit; s1 = cinit; \
        _Pragma("unroll") for (int c = 0; c < NC; ++c) { s0 = MFMA8(kf_[0][c], qf[c], s0, 0, 0); s1 = MFMA8(kf_[1][c], qf[c], s1, 0, 0); } } while (0)
#define ATT_QK8(kf_) ATT_QK8X(kf_, s0, s1)
#define CL8(x_) __builtin_amdgcn_fmed3f((x_), 0.f, 123.f)
#define PK4_U8(a_, b_, c_, d_) __builtin_amdgcn_cvt_pk_u8_f32(CL8(d_), 3, __builtin_amdgcn_cvt_pk_u8_f32(CL8(c_), 2, __builtin_amdgcn_cvt_pk_u8_f32(CL8(b_), 1, __builtin_amdgcn_cvt_pk_u8_f32(CL8(a_), 0, 0u))))
#define ATT_PV8(vf_) ATT_PV8X(vf_, s0, s1)
#define ATT_PV8X(vf_, s0, s1) do { i32x8 pf; \
        _Pragma("unroll") for (int q = 0; q < 4; ++q) pf[q] = (int)PK4_U8(s0[4 * q], s0[4 * q + 1], s0[4 * q + 2], s0[4 * q + 3]); \
        _Pragma("unroll") for (int q = 0; q < 4; ++q) pf[4 + q] = (int)PK4_U8(s1[4 * q], s1[4 * q + 1], s1[4 * q + 2], s1[4 * q + 3]); \
        lacc = MFMA8(ones8, pf, lacc, 0, 1); \
        _Pragma("unroll") for (int d = 0; d < NDT; ++d) o[d] = MFMA8(vf_[d], pf, o[d], 0, 1); } while (0)
    ATT_ISSUE8(0, 0);
    if (nst > 1) ATT_ISSUE8(1, 1);
    {
        if (nst > 1) asm volatile("s_waitcnt vmcnt(3)" ::: "memory"); else asm volatile("s_waitcnt vmcnt(0)" ::: "memory");
        __builtin_amdgcn_s_barrier();
        asm volatile("" ::: "memory");
        LAS3 const unsigned char* sb = lds + lane * 16;
        float emax = -1e30f;
#pragma unroll
        for (int t = 0; t < 4; ++t) {
            f32x16 sz;
#pragma unroll
            for (int i = 0; i < 16; ++i) sz[i] = 0.f;
#pragma unroll
            for (int c = 0; c < NC; ++c) { i32x8 kf_; LD_FRAG8(kf_, (t * NC + c) * 2048); sz = MFMA8(kf_, qf[c], sz, 0, 0); }
#pragma unroll
            for (int i = 0; i < 16; ++i) emax = fmaxf(emax, sz[i]);
        }
        emax = fmaxf(emax, __shfl_xor(emax, 32));
        const float m = fminf(csb, emax + 64.f) - 118.f;
#pragma unroll
        for (int i = 0; i < 16; ++i) cinit[i] = -m;
    }
    int sl = 0;
    for (int st = 0; st < nst; st += 2) {
        asm volatile("s_waitcnt vmcnt(0)" ::: "memory");
        __builtin_amdgcn_s_barrier();
        asm volatile("" ::: "memory");
        if (st + 2 < nst) { ATT_ISSUE8(st + 2, (sl ^ 2)); ATT_ISSUE8(st + 3, (sl ^ 2) + 1); }
        if constexpr (ROT) {
            LAS3 const unsigned char* b0 = lds + sl * SBYTES + lane * 16; LAS3 const unsigned char* b1 = b0 + SBYTES;
#define LD_FRAGB(dst_, base_, off_) do { const u32x4 a_ = *(LAS3 const u32x4*)((base_) + (off_)), b_ = *(LAS3 const u32x4*)((base_) + (off_) + 1024); \
            dst_ = (i32x8){(int)a_[0], (int)a_[1], (int)a_[2], (int)a_[3], (int)b_[0], (int)b_[1], (int)b_[2], (int)b_[3]}; } while (0)
#define LDK_(dst_, base_, tp_) do { _Pragma("unroll") for (int t = 0; t < 2; ++t) _Pragma("unroll") for (int c = 0; c < NC; ++c) LD_FRAGB(dst_[t][c], base_, ((2 * (tp_) + t) * NC + c) * 2048); } while (0)
#define LDV_(dst_, base_, tp_) do { _Pragma("unroll") for (int d = 0; d < NDT; ++d) LD_FRAGB(dst_[d], base_, KSB + ((tp_) * NDT + d) * 2048); } while (0)
            i32x8 ka[2][NC], kb[2][NC], vx[NDT], vy[NDT];
            f32x16 s0, s1, t0, t1;
            LDK_(ka, b0, 0); LDV_(vx, b0, 0);
            asm volatile("" ::: "memory");
            ATT_QK8X(ka, s0, s1);
            LDK_(kb, b0, 1);
            asm volatile("" ::: "memory");
            ATT_QK8X(kb, t0, t1);
            if constexpr (NDT <= 2) { LDV_(vy, b0, 1); asm volatile("" ::: "memory"); }
            ATT_PV8X(vx, s0, s1);
            if constexpr (NDT > 2) { LDV_(vy, b0, 1); }
            LDK_(ka, b1, 0);
            asm volatile("" ::: "memory");
            ATT_QK8X(ka, s0, s1);
            ATT_PV8X(vy, t0, t1);
            LDK_(kb, b1, 1); LDV_(vx, b1, 0);
            asm volatile("" ::: "memory");
            ATT_QK8X(kb, t0, t1);
            ATT_PV8X(vx, s0, s1);
            LDV_(vy, b1, 1);
            asm volatile("" ::: "memory");
            ATT_PV8X(vy, t0, t1);
#undef LD_FRAGB
#undef LDK_
#undef LDV_
        } else {
#pragma unroll
        for (int half = 0; half < 2; ++half) {
        LAS3 const unsigned char* sb = lds + (sl + half) * SBYTES + lane * 16;
        i32x8 kA[2][NC], kB[2][NC], vA[NDT], vB[NDT];
        f32x16 s0, s1;
#pragma unroll
        for (int t = 0; t < 2; ++t)
#pragma unroll
            for (int c = 0; c < NC; ++c) LD_FRAG8(kA[t][c], (t * NC + c) * 2048);
#pragma unroll
        for (int d = 0; d < NDT; ++d) LD_FRAG8(vA[d], KSB + d * 2048);
        asm volatile("" ::: "memory");
        ATT_QK8(kA);
#pragma unroll
        for (int t = 0; t < 2; ++t)
#pragma unroll
            for (int c = 0; c < NC; ++c) LD_FRAG8(kB[t][c], ((2 + t) * NC + c) * 2048);
        asm volatile("" ::: "memory");
        if constexpr (NDT <= 2) {
            f32x16 t0, t1;
            ATT_QK8X(kB, t0, t1);
#pragma unroll
            for (int d = 0; d < NDT; ++d) LD_FRAG8(vB[d], KSB + (NDT + d) * 2048);
            asm volatile("" ::: "memory");
            ATT_PV8(vA);
            ATT_PV8X(vB, t0, t1);
        } else if constexpr (VARB) {
            f32x16 t0, t1;
            ATT_QK8X(kB, t0, t1);
            ATT_PV8(vA);
#pragma unroll
            for (int d = 0; d < NDT; ++d) LD_FRAG8(vB[d], KSB + (NDT + d) * 2048);
            asm volatile("" ::: "memory");
            ATT_PV8X(vB, t0, t1);
        } else {
        ATT_PV8(vA);
#pragma unroll
        for (int d = 0; d < NDT; ++d) LD_FRAG8(vB[d], KSB + (NDT + d) * 2048);
        asm volatile("" ::: "memory");
        ATT_QK8(kB);
        ATT_PV8(vB);
        }
        }
        }
        sl ^= 2;
    }
#undef ATT_ISSUE8
#undef LD_FRAG8
#undef ATT_QK8
#undef ATT_QK8X
#undef ATT_PV8X
#undef ATT_PV8
#undef PK4_U8
#undef CL8
    const float lsum_ = lacc[0];
    const bool bad_ = !(lsum_ > 0.f) || !(lsum_ < 3.0e38f);
    const float inv = bad_ ? 0.f : 1.f / lsum_;

#pragma unroll
    for (int d = 0; d < NDT; ++d)
#pragma unroll
        for (int g = 0; g < 4; ++g) {
            u32x2 wv; wv.x = pk2(o[d][4 * g] * inv, o[d][4 * g + 1] * inv); wv.y = pk2(o[d][4 * g + 2] * inv, o[d][4 * g + 3] * inv);
            *(u32x2*)(O + d * 32 + 8 * g + 4 * hh) = wv;
        }
    asm volatile("" ::: "memory");
    __builtin_amdgcn_s_barrier();
    asm volatile("" ::: "memory");
}

DI void phase_attn(const Params& p, int layer, unsigned char* ldsg) {
    LAS3 unsigned char* lds = (LAS3 unsigned char*)ldsg;
    {   unsigned char* const ws_ = lws(p); const int tid = ltid(); const int w = tid >> 6, n = tid & 31;
        const unsigned* kmax = (const unsigned*)(ws_ + WS_KMAX) + layer * 48; const float* qn = (const float*)(ws_ + WS_QN) + (size_t)MROWS * 8;
        for (int k = 0; k * (int)gridDim.x + (int)blockIdx.x < 1024; ++k) {
            const int it = k * gridDim.x + blockIdx.x; int combo = it >> 6, qt = it & 63;
            if (gridDim.x == 256) { const int x = blockIdx.x & 7, r = blockIdx.x >> 3; combo = x * 2 + (k >> 1); qt = (k & 1) * 32 + r; }
            const int b = combo >> 3, hd = combo & 7;
            const int row = b * TPB + CTX + qt * 256 + w * 32 + n;
            attn_block8<2, 2, true>(lds, ws_ + R_QMLA + (size_t)row * 1024 + hd * 128, qn[(size_t)row * 8 + hd],
                ws_ + R_KFMLA + (size_t)(b * 8 + hd) * KGPB * 4096, ws_ + R_VFMLA + (size_t)(b * 8 + hd) * (KGPB / 2) * 4096,
                KGPB / 4, __uint_as_float(kmax[32 + b * 8 + hd]), (bf16*)(ws_ + R_YA) + (size_t)row * 1536 + 512 + hd * 64, tid);
        }
        for (int it = blockIdx.x; it < 16; it += gridDim.x) {
            const int b = it >> 3, hd = it & 7; const int row = b * TPB + w * 32 + n;
            attn_block8<2, 2, true>(lds, ws_ + R_QMLA + (size_t)row * 1024 + hd * 128, qn[(size_t)row * 8 + hd],
                ws_ + R_KFMLA + (size_t)(b * 8 + hd) * KGPB * 4096, ws_ + R_VFMLA + (size_t)(b * 8 + hd) * (KGPB / 2) * 4096,
                2, __uint_as_float(kmax[32 + b * 8 + hd]), (bf16*)(ws_ + R_YA) + (size_t)row * 1536 + 512 + hd * 64, tid);
        }
    }
    {   unsigned char* const ws_ = lws(p); const int tid = ltid(); const int w = tid >> 6, n = tid & 31;
        const unsigned* kmax = (const unsigned*)(ws_ + WS_KMAX) + layer * 48; const float* qn = (const float*)(ws_ + WS_QN);
        for (int k = 0; k * (int)gridDim.x + (int)blockIdx.x < 1024; ++k) {
            const int it = k * gridDim.x + blockIdx.x; int combo = it >> 6, qt = it & 63;
            if (gridDim.x == 256) { const int x = blockIdx.x & 7, r = blockIdx.x >> 3; combo = x * 2 + (k >> 1); qt = (k & 1) * 32 + r; }
            const int b = combo >> 3, hd = combo & 7;
            const int row = b * TPB + CTX + qt * 256 + w * 32 + n;
            attn_block8<1, 4, true>(lds, ws_ + R_QD + (size_t)row * 512 + hd * 64, qn[(size_t)row * 8 + hd],
                ws_ + R_KFD + (size_t)(b * 8 + hd) * KGPB * 2048, ws_ + R_VFD + (size_t)(b * 4 + (hd >> 1)) * (KGPB / 2) * 8192,
                KGPB / 4, __uint_as_float(kmax[16 + b * 8 + hd]), (bf16*)(ws_ + R_OD) + (size_t)row * 1024 + hd * 128, tid);
        }
        for (int it = blockIdx.x; it < 16; it += gridDim.x) {
            const int b = it >> 3, hd = it & 7; const int row = b * TPB + w * 32 + n;
            attn_block8<1, 4, true>(lds, ws_ + R_QD + (size_t)row * 512 + hd * 64, qn[(size_t)row * 8 + hd],
                ws_ + R_KFD + (size_t)(b * 8 + hd) * KGPB * 2048, ws_ + R_VFD + (size_t)(b * 4 + (hd >> 1)) * (KGPB / 2) * 8192,
                2, __uint_as_float(kmax[16 + b * 8 + hd]), (bf16*)(ws_ + R_OD) + (size_t)row * 1024 + hd * 128, tid);
        }
    }
    {   unsigned char* const ws_ = lws(p); const int tid = ltid(); const int w = tid >> 6, n = tid & 31;
        const unsigned* kmax = (const unsigned*)(ws_ + WS_KMAX) + layer * 48; const float* lamv = (const float*)(ws_ + WS_LAM);
        unsigned* ctr = (unsigned*)(ws_ + WS_CTL) + 8 + layer;
        volatile LAS3 int* nxt = (volatile LAS3 int*)ldsg;
        int par = 0;
        for (int it = blockIdx.x; it < 1024; ) {
            unsigned got = 0u;
            if (tid == 0) got = __hip_atomic_fetch_add(ctr, 1u, __ATOMIC_RELAXED, __HIP_MEMORY_SCOPE_AGENT);
            const int b = it >> 9, hd = (it >> 6) & 7, qt = it & 63;
            const int gr = qt * 4 + (w >> 1), qh = w & 1;
            const int row = b * TPB + CTX + gr * 64 + qh * 32 + n;
            attn_wave<64, 64, true>((const bf16*)(ws_ + R_QNA) + (size_t)row * 512 + hd * 64,
                (const bf16*)(ws_ + R_KFNA) + (size_t)(b * 8 + hd) * KGPB * 2048, (const bf16*)(ws_ + R_VFNA) + (size_t)(b * 8 + hd) * KGPB * 2048,
                0, 0, __uint_as_float(kmax[b * 8 + hd]), (bf16*)(ws_ + R_YA) + (size_t)row * 1536 + hd * 64,
                (const float*)(ws_ + WS_BIAS) + (size_t)(layer * 8 + hd) * 15 * 4 * 1024, lamv[4 + layer * 8 + hd], gr, qh);
            if (tid == 0) nxt[par] = (int)gridDim.x + (int)got;
            __syncthreads();
            it = nxt[par];
            par ^= 1;
        }
    }
    {   unsigned char* const ws_ = lws(p); const int tid = ltid(); const int w = tid >> 6, n = tid & 31;
        const unsigned* kmax = (const unsigned*)(ws_ + WS_KMAX) + layer * 48;
        for (int it = blockIdx.x; it < 16; it += gridDim.x) {
            const int b = it >> 3, hd = it & 7; const int row = b * TPB + w * 32 + n;
            attn_wave<64, 64, false>((const bf16*)(ws_ + R_QNA) + (size_t)row * 512 + hd * 64,
                (const bf16*)(ws_ + R_KFNA) + (size_t)(b * 8 + hd) * KGPB * 2048, (const bf16*)(ws_ + R_VFNA) + (size_t)(b * 8 + hd) * KGPB * 2048,
                0, 8, __uint_as_float(kmax[b * 8 + hd]), (bf16*)(ws_ + R_YA) + (size_t)row * 1536 + hd * 64, nullptr, 0.f, 0, 0);
        }
    }
}

DI void phase_diffcomb(const Params& p, int layer) {
    unsigned char* const ws_ = lws(p);
    const int tid = ltid();
    const int lane = tid & 63;
    const float* lamv = (const float*)(ws_ + WS_LAM); const float lam = lamv[layer], li = lamv[2 + layer];
    const float* gsub = p.in[16] + layer * 128;
    const bf16* OD = (const bf16*)(ws_ + R_OD); bf16* YC = (bf16*)(ws_ + R_YA) + 1024;
    const int h4 = lane >> 4, d0 = (lane & 15) * 8;
    for (int row = gwave(tid); row < MROWS; row += nwaves()) {
        float a[8], b2[8], y[8];
        unpack8(*(const bf16x8*)(OD + (size_t)row * 1024 + (2 * h4) * 128 + d0), a);
        unpack8(*(const bf16x8*)(OD + (size_t)row * 1024 + (2 * h4 + 1) * 128 + d0), b2);
        float ss = 0.f;
#pragma unroll
        for (int j = 0; j < 8; ++j) { y[j] = a[j] - lam * b2[j]; ss += y[j] * y[j]; }
#pragma unroll
        for (int o = 8; o >= 1; o >>= 1) ss += __shfl_xor(ss, o);
        const float r = rsqrtf(ss * (1.f / 128.f) + EPS) * (1.f - li);
#pragma unroll
        for (int j = 0; j < 8; ++j) y[j] = y[j] * r * gsub[d0 + j];
        *(bf16x8*)(YC + (size_t)row * 1536 + h4 * 128 + d0) = pack8(y);
    }
}

DI void phase_ln1_router(const Params& p, int layer, float* lds  ) {
    unsigned char* const ws_ = lws(p);
    const int tid = ltid();
    const int lane = tid & 63;
    const float* wr = p.in[25] + (size_t)layer * 1024 * 16;
    for (int i = tid; i < 16384; i += NWG_THREADS) { const int k = i >> 4, e = i & 15; lds[e * 1024 + k] = wr[i]; }
    __syncthreads();
    const float* mod = (const float*)(ws_ + WS_MOD) + (size_t)layer * 3 * 6144;
    const float* g1 = p.in[23] + layer * 1024; const float* b1 = p.in[24] + layer * 1024;
    float* X = (float*)(ws_ + WS_X); bf16* H = (bf16*)(ws_ + WS_H);
    float* affL = (float*)(ws_ + WS_AFF); float* affC = affL + 2 * 16 * 16384;
    for (int row = gwave(tid); row < MROWS; row += nwaves()) {
        float* xr = X + (size_t)row * D;
        f32x4 v[4];
#pragma unroll
        for (int i = 0; i < 4; ++i) v[i] = *(const f32x4*)(xr + i * 256 + lane * 4);
        float mu, rstd; ln_stats16(v, mu, rstd);
#pragma unroll
        for (int i = 0; i < 4; ++i) { const int c = i * 256 + lane * 4; v[i] = (v[i] - mu) * rstd * *(const f32x4*)(g1 + c) + *(const f32x4*)(b1 + c); }
        ln_stats16(v, mu, rstd);
        const float* mr = mod + (size_t)mod_row_of(row) * 6144;
        float lg[16];
#pragma unroll
        for (int i = 0; i < 4; ++i) {
            const int c = i * 256 + lane * 4;
            const f32x4 sh = *(const f32x4*)(mr + 3072 + c), sc = *(const f32x4*)(mr + 4096 + c);
            const f32x4 y = (v[i] - mu) * rstd * (sc + 1.f) + sh;
            *(unsigned*)((unsigned char*)H + (size_t)row * D + c) = pk4_fp8(y[0], y[1], y[2], y[3]);
            v[i] = y;
        }
#pragma unroll
        for (int e = 0; e < 16; ++e) {
            float a = 0.f;
#pragma unroll
            for (int i = 0; i < 4; ++i) { const f32x4 w = *(const f32x4*)(lds + e * 1024 + i * 256 + lane * 4); a += (v[i][0] * w[0] + v[i][1] * w[1]) + (v[i][2] * w[2] + v[i][3] * w[3]); }
            lg[e] = a;
            asm volatile("" : "+v"(lg[e]));
        }
        float r8[8], r4[4], r2[2], r1;
        { const bool hi = (lane & 32) != 0;
#pragma unroll
          for (int j = 0; j < 8; ++j) { const float keep = hi ? lg[8 + j] : lg[j], send = hi ? lg[j] : lg[8 + j]; r8[j] = keep + __shfl_xor(send, 32); } }
        { const bool hi = (lane & 16) != 0;
#pragma unroll
          for (int j = 0; j < 4; ++j) { const float keep = hi ? r8[4 + j] : r8[j], send = hi ? r8[j] : r8[4 + j]; r4[j] = keep + __shfl_xor(send, 16); } }
        { const bool hi = (lane & 8) != 0;
#pragma unroll
          for (int j = 0; j < 2; ++j) { const float keep = hi ? r4[2 + j] : r4[j], send = hi ? r4[j] : r4[2 + j]; r2[j] = keep + __shfl_xor(send, 8); } }
        { const bool hi = (lane & 4) != 0; const float keep = hi ? r2[1] : r2[0], send = hi ? r2[0] : r2[1]; r1 = keep + __shfl_xor(send, 4); }
        r1 += __shfl_xor(r1, 2); r1 += __shfl_xor(r1, 1);
        float mx = r1;
        mx = fmaxf(mx, __shfl_xor(mx, 4)); mx = fmaxf(mx, __shfl_xor(mx, 8)); mx = fmaxf(mx, __shfl_xor(mx, 16)); mx = fmaxf(mx, __shfl_xor(mx, 32));
        const float pe = expf(r1 - mx);
        float se = pe;
        se += __shfl_xor(se, 4); se += __shfl_xor(se, 8); se += __shfl_xor(se, 16); se += __shfl_xor(se, 32);
        const float mine = pe / se;
        const int eidx = ((lane >> 5) & 1) * 8 + ((lane >> 4) & 1) * 4 + ((lane >> 3) & 1) * 2 + ((lane >> 2) & 1);
        const int b = row / TPB, t = row - b * TPB;
        if ((lane & 3) == 0) { if (t < CTX) affC[(size_t)(b * 16 + eidx) * 256 + t] = mine; else affL[(size_t)(b * 16 + eidx) * 16384 + (t - CTX)] = mine; }
    }
}

DI void phase_topk(const Params& p, unsigned* lds  ) {
    unsigned char* const ws_ = lws(p);
    const int tid = ltid(), lane = tid & 63, wv = tid >> 6;
    unsigned* vals = lds; unsigned* hist = lds + 16384 + 512; unsigned* misc = hist + 256; unsigned* wsum = misc + 32;
    const float* affL = (const float*)(ws_ + WS_AFF); const float* affC = affL + 2 * 16 * 16384;
    int* selrow = (int*)(ws_ + WS_SELROW); float* selw = (float*)(ws_ + WS_SELW); int* slotof = (int*)(ws_ + WS_SLOTOF);
#define VPAD(i_) ((i_) + ((i_) >> 5))
    for (int pr = blockIdx.x; pr < 64; pr += gridDim.x) {
        const bool isc = pr >= 32; const int q = pr & 31, b = q >> 4, e = q & 15;
        const int n = isc ? 256 : 16384, k = isc ? CAP_C : CAP_L;
        const float* src = isc ? affC + (size_t)q * 256 : affL + (size_t)q * 16384;
        const int slotbase = isc ? NSLOT_L + (e * 2 + b) * CAP_C : (e * 2 + b) * CAP_L;
        const int rowbase = b * TPB + (isc ? 0 : CTX);
        __syncthreads();
        for (int i = tid; i < n; i += NWG_THREADS) vals[VPAD(i)] = __float_as_uint(src[i]);
        unsigned prefix = 0, mask = 0; int kk = k;
        for (int pass = 3; pass >= 0; --pass) {
            if (tid < 256) hist[tid] = 0;
            __syncthreads();
            for (int i = tid; i < n; i += NWG_THREADS) { const unsigned v = vals[VPAD(i)]; if ((v & mask) == prefix) atomicAdd(&hist[(v >> (8 * pass)) & 255], 1u); }
            __syncthreads();
            if (wv == 0) {
                const int c0 = (int)hist[4 * lane], c1 = (int)hist[4 * lane + 1], c2 = (int)hist[4 * lane + 2], c3 = (int)hist[4 * lane + 3];
                const int sl = c0 + c1 + c2 + c3;
                int suf = sl;
#pragma unroll
                for (int o = 1; o < 64; o <<= 1) { const int y = __shfl_down(suf, o); if (lane + o < 64) suf += y; }
                const int above = suf - sl;
                if (above < kk && kk <= suf) {
                    int cum = above, bin = 4 * lane + 3;
                    if (cum + c3 < kk) { cum += c3; bin = 4 * lane + 2; if (cum + c2 < kk) { cum += c2; bin = 4 * lane + 1; if (cum + c1 < kk) { cum += c1; bin = 4 * lane; } } }
                    misc[0] = (unsigned)bin; misc[1] = (unsigned)(kk - cum);
                }
            }
            __syncthreads();
            prefix |= misc[0] << (8 * pass); mask |= 0xffu << (8 * pass); kk = (int)misc[1];
        }
        const unsigned T = prefix;
        const int i0 = tid * 32;
        int gt = 0, eq = 0;
        if (i0 < n) for (int i = 0; i < 32; ++i) { const unsigned v = vals[tid * 33 + i]; gt += v > T; eq += v == T; }
        int x = eq;
#pragma unroll
        for (int o = 1; o < 64; o <<= 1) { const int y = __shfl_up(x, o); if (lane >= o) x += y; }
        if (lane == 63) wsum[wv] = (unsigned)x;
        __syncthreads();
        int eqbase = x - eq; for (int w2 = 0; w2 < wv; ++w2) eqbase += (int)wsum[w2];
        int take = kk - eqbase; take = take < 0 ? 0 : (take > eq ? eq : take);
        const int sel = gt + take;
        x = sel;
#pragma unroll
        for (int o = 1; o < 64; o <<= 1) { const int y = __shfl_up(x, o); if (lane >= o) x += y; }
        if (lane == 63) wsum[8 + wv] = (unsigned)x;
        __syncthreads();
        int pos = x - sel; for (int w2 = 0; w2 < wv; ++w2) pos += (int)wsum[8 + w2];
        if (i0 < n) {
            int eqc = 0;
            int* so = slotof + (size_t)e * MROWS + rowbase + i0;
            for (int i = 0; i < 32; ++i) {
                const unsigned v = vals[tid * 33 + i]; bool s = v > T;
                if (v == T) { s = eqc < take; ++eqc; }
                if (s) { selrow[slotbase + pos] = rowbase + i0 + i; selw[slotbase + pos] = __uint_as_float(v); so[i] = slotbase + pos; ++pos; }
                else so[i] = -1;
            }
        }
    }
#undef VPAD
}

DI void phase_gather(const Params& p) {
    unsigned char* const ws_ = lws(p);
    const int tid = ltid();
    const int lane = tid & 63;
    const int* selrow = (const int*)(ws_ + WS_SELROW); const bf16* H = (const bf16*)(ws_ + WS_H); unsigned char* XS = ws_ + R_XSEL;
    for (int c = gwave(tid); c < NSLOT / 32; c += nwaves()) {
        const int myrow = selrow[c * 32 + (lane & 31)];
#pragma unroll 4
        for (int j = 0; j < 32; ++j) {
            const int row = __builtin_amdgcn_readlane(myrow, j);
            float f[16];
            { float t8[8]; unpack8(*(const bf16x8*)(H + (size_t)row * D + lane * 16), t8);
#pragma unroll
              for (int q = 0; q < 8; ++q) f[q] = t8[q];
              unpack8(*(const bf16x8*)(H + (size_t)row * D + lane * 16 + 8), t8);
#pragma unroll
              for (int q = 0; q < 8; ++q) f[8 + q] = t8[q]; }
            *(u32x4*)(XS + (size_t)(c * 32 + j) * D + lane * 16) = pk16_fp8(f);
        }
    }
}

DI void phase_combine_ln2(const Params& p, int layer, float* lds  ) {
    unsigned char* const ws_ = lws(p);
    const int tid = ltid();
    const int lane = tid & 63;
    {   const float* mod = (const float*)(ws_ + WS_MOD) + (size_t)layer * 3 * 6144;
        const float* g1 = p.in[23] + layer * 1024; const float* b1 = p.in[24] + layer * 1024;
        const float* g2w = p.in[29] + layer * 1024; const float* b2w = p.in[30] + layer * 1024;
        for (int i = tid; i < 1024; i += NWG_THREADS) {
            lds[i] = g1[i]; lds[1024 + i] = b1[i]; lds[2048 + i] = g2w[i]; lds[3072 + i] = b2w[i];
#pragma unroll
            for (int r = 0; r < 3; ++r) {
                lds[(4 + r) * 1024 + i] = mod[r * 6144 + 5120 + i];
                if (layer == 0) { lds[(7 + r) * 1024 + i] = mod[3 * 6144 + r * 6144 + i]; lds[(10 + r) * 1024 + i] = mod[3 * 6144 + r * 6144 + 1024 + i]; }
            }
        }
        __syncthreads();
    }
    float* X = (float*)(ws_ + WS_X); const bf16* Y = (const bf16*)(ws_ + R_XSEL); const int* slotof = (const int*)(ws_ + WS_SLOTOF);
    unsigned char* H8 = ws_ + WS_H;
    const int nw = nwaves();
#define C18_SIDX(r_) slotof[(size_t)(lane & 15) * MROWS + ((r_) < MROWS ? (r_) : MROWS - 1)]
    int ra = gwave(tid);
    int sa = C18_SIDX(ra), sb = C18_SIDX(ra + nw);
#pragma unroll 1
    for (; ra < MROWS; ra += 2 * nw) {
        const int rb = ra + nw;
        const int rbc = rb < MROWS ? rb : ra;
        unsigned ma = (unsigned)__builtin_amdgcn_ballot_w64(sa >= 0) & 0xFFFFu, mb = (unsigned)__builtin_amdgcn_ballot_w64(sb >= 0) & 0xFFFFu;
        int qa[4], qb[4]; float wa[4], wb[4];
#pragma unroll
        for (int j = 0; j < 4; ++j) {
            { const bool h = ma != 0u; const int e = h ? __builtin_ctz(ma) : 0; const int q = __builtin_amdgcn_readlane(sa, e); qa[j] = h ? q : 0; wa[j] = h ? 1.f : 0.f; ma &= ma - 1u; }
            { const bool h = mb != 0u; const int e = h ? __builtin_ctz(mb) : 0; const int q = __builtin_amdgcn_readlane(sb, e); qb[j] = h ? q : 0; wb[j] = h ? 1.f : 0.f; mb &= mb - 1u; }
        }
        u32x2 ua[4][4], ub[4][4]; f32x4 va[4], vb[4];
#pragma unroll
        for (int j = 0; j < 4; ++j)
#pragma unroll
            for (int i = 0; i < 4; ++i) { ua[j][i] = *(const u32x2*)(Y + (size_t)qa[j] * D + i * 256 + lane * 4); ub[j][i] = *(const u32x2*)(Y + (size_t)qb[j] * D + i * 256 + lane * 4); }
#pragma unroll
        for (int i = 0; i < 4; ++i) { va[i] = *(const f32x4*)(X + (size_t)ra * D + i * 256 + lane * 4); vb[i] = *(const f32x4*)(X + (size_t)rbc * D + i * 256 + lane * 4); }
        const int na = C18_SIDX(ra + 2 * nw), nb = C18_SIDX(rb + 2 * nw);
        f32x4 fa[4], fb[4];
#pragma unroll
        for (int i = 0; i < 4; ++i) { fa[i] = (f32x4){0.f, 0.f, 0.f, 0.f}; fb[i] = fa[i]; }
#pragma unroll
        for (int j = 0; j < 4; ++j)
#pragma unroll
            for (int i = 0; i < 4; ++i) {
                fa[i][0] += wa[j] * lo_f(ua[j][i].x); fa[i][1] += wa[j] * hi_f(ua[j][i].x); fa[i][2] += wa[j] * lo_f(ua[j][i].y); fa[i][3] += wa[j] * hi_f(ua[j][i].y);
                fb[i][0] += wb[j] * lo_f(ub[j][i].x); fb[i][1] += wb[j] * hi_f(ub[j][i].x); fb[i][2] += wb[j] * lo_f(ub[j][i].y); fb[i][3] += wb[j] * hi_f(ub[j][i].y);
            }
        while (ma) {
            const int s = __builtin_amdgcn_readlane(sa, __builtin_ctz(ma)); ma &= ma - 1u;
#pragma unroll
            for (int i = 0; i < 4; ++i) { const u32x2 u = *(const u32x2*)(Y + (size_t)s * D + i * 256 + lane * 4); fa[i][0] += lo_f(u.x); fa[i][1] += hi_f(u.x); fa[i][2] += lo_f(u.y); fa[i][3] += hi_f(u.y); }
        }
        while (mb) {
            const int s = __builtin_amdgcn_readlane(sb, __builtin_ctz(mb)); mb &= mb - 1u;
#pragma unroll
            for (int i = 0; i < 4; ++i) { const u32x2 u = *(const u32x2*)(Y + (size_t)s * D + i * 256 + lane * 4); fb[i][0] += lo_f(u.x); fb[i][1] += hi_f(u.x); fb[i][2] += lo_f(u.y); fb[i][3] += hi_f(u.y); }
        }
#define C18_TAIL(row_, v, f) do { \
            const int b_ = (row_) / TPB, t_ = (row_) - b_ * TPB; const int mrow_ = t_ < CTX ? 2 : b_; \
            if ((row_) < MROWS && !(layer == 1 && t_ < CTX)) {       \
                float mu, rstd; ln_stats16(v, mu, rstd); \
                _Pragma("unroll") for (int i = 0; i < 4; ++i) { const int c = i * 256 + lane * 4; \
                    const f32x4 x1 = (v[i] - mu) * rstd * *(const f32x4*)(lds + c) + *(const f32x4*)(lds + 1024 + c);        \
                    v[i] = x1 * ALPHA + *(const f32x4*)(lds + (4 + mrow_) * 1024 + c) * f[i]; } \
                ln_stats16(v, mu, rstd); \
                _Pragma("unroll") for (int i = 0; i < 4; ++i) { const int c = i * 256 + lane * 4; \
                    v[i] = (v[i] - mu) * rstd * *(const f32x4*)(lds + 2048 + c) + *(const f32x4*)(lds + 3072 + c); \
                    if (layer == 1) *(f32x4*)(p.out + ((size_t)b_ * SEQ + (t_ - CTX)) * D + c) = v[i]; \
                    else *(f32x4*)(X + (size_t)(row_) * D + c) = v[i]; } \
                if (layer == 0) {         \
                    ln_stats16(v, mu, rstd); \
                    _Pragma("unroll") for (int i = 0; i < 4; ++i) { const int c = i * 256 + lane * 4; \
                        const f32x4 sh = *(const f32x4*)(lds + (7 + mrow_) * 1024 + c), sc = *(const f32x4*)(lds + (10 + mrow_) * 1024 + c); \
                        const f32x4 y = (v[i] - mu) * rstd * (sc + 1.f) + sh; \
                        *(unsigned*)(H8 + (size_t)(row_) * D + c) = pk4_fp8(y[0], y[1], y[2], y[3]); } } } } while (0)
        C18_TAIL(ra, va, fa);
        C18_TAIL(rb, vb, fb);
#undef C18_TAIL
        sa = na; sb = nb;
    }
#undef C18_SIDX
    __syncthreads();
}


namespace pg8 {
#define PG8_LAS __attribute__((address_space(3)))
constexpr int BM = 256, BK = 64, HALF = 128, HTB = HALF * BK * 2, STAGE_BYTES = 8 * HTB, NXCD = 8, WGM = 8;
__host__ __device__ __forceinline__ int lds_byte(int r, int c) { const int st = (r >> 4) * 2 + (c >> 5), rr = r & 15, cc = c & 31, ob = rr * 64 + cc * 2; return st * 1024 + (ob ^ (((ob >> 9) & 1) << 5)); }
__host__ __device__ __forceinline__ void stage_rc(int b, int& R, int& C) { const int st = b / 1024, sb = b % 1024, swz = sb ^ (((sb >> 9) & 1) << 5); R = (st >> 1) * 16 + swz / 64; C = (st & 1) * 32 + (swz % 64) / 2; }
struct Unit { int pm, pn; };
struct Gemm { const bf16* A; const bf16* Bt; int lda, ldb, K; };
struct StaticOrder {
    int nM, nN, nwg, G, c;
    __device__ void init(int nM_, int nN_, int G_, int c_) { nM = nM_; nN = nN_; nwg = nM * nN; G = G_; c = c_; }
    __device__ bool next(int i, Unit& u) const {
        const long L = (long)i * G + c; if (L >= nwg) return false;
        int wgid = (int)L; { const int q = nwg / NXCD, r = nwg % NXCD, xcd = wgid % NXCD, off = wgid / NXCD; wgid = (xcd < r ? xcd * (q + 1) : r * (q + 1) + (xcd - r) * q) + off; }
        const int nig = WGM * nN, gid = wgid / nig, fm = gid * WGM, gsz = (nM - fm) < WGM ? (nM - fm) : WGM;
        u.pm = fm + ((wgid % nig) % gsz); u.pn = (wgid % nig) / gsz; return true;
    }
};
struct NoHook { static constexpr bool ENABLED = false; };
template <class Epi, class Sched, bool FP8 = false, class Hook = NoHook, bool GATHER = false>
__device__ __forceinline__ void gemm_phase(PG8_LAS unsigned char* lds, const Gemm g, const Sched& S, const Epi& E, int tid, const Hook& H = Hook(), const int* gidx = nullptr) {
    const int wid = __builtin_amdgcn_readfirstlane(tid >> 6), lane = tid & 63, wr = wid >> 2, wc = wid & 3, fr = lane & 15, fq = lane >> 4;
    const int K = g.K, nt = K / BK;
    unsigned voffA[2], voffB[2];
    int gR[2]; unsigned gC[2];
#pragma unroll
    for (int i = 0; i < 2; ++i) { int R, C; stage_rc(tid * 16 + i * 8192, R, C); voffA[i] = (unsigned)(R * g.lda + C) * 2u; voffB[i] = (unsigned)(R * g.ldb + C) * 2u; gR[i] = R; gC[i] = (unsigned)C * 2u; }
    const size_t kstep = (size_t)(BK * 2);
    const size_t hstepA = GATHER ? 0 : (size_t)HALF * g.lda * 2, hstepB = (size_t)HALF * g.ldb * 2, tstepA = 2 * hstepA, tstepB = 2 * hstepB;
    unsigned gvc[2][2], gvn[2][2], gv2[2][2];
    const int gsrc = ((lane >> 5) & 1) * HALF + (((wid + 8 * ((lane >> 4) & 1)) >> 1) * 16) + (lane & 15);
#define PG8_GDMA(pm_) __builtin_amdgcn_global_load_lds((const unsigned*)(gidx + (pm_) * BM + gsrc), (PG8_LAS unsigned*)(lds + STAGE_BYTES + ldsw / 4), 4, 0, 0)
#define PG8_GREAD(h_, i_) ((unsigned)*(const PG8_LAS int*)(lds + STAGE_BYTES + ldsw / 4 + (((h_) * 2 + (i_)) * 16 + (lane >> 2)) * 4) * (unsigned)(g.lda * 2) + gC[i_])
    const unsigned ldsw = (unsigned)wid * 1024u;
    const int aoff = lds_byte(wr * 64 + fr, fq * 8), boff = lds_byte(wc * 32 + fr, fq * 8);
#define PG8_SA(b, h) (((b) * 2 + (h)) * HTB)
#define PG8_SB(b, h) ((4 + (b) * 2 + (h)) * HTB)
#define PG8_STAGE(bufoff, gbase, voff) do { _Pragma("unroll") for (int _i = 0; _i < 2; ++_i) \
        __builtin_amdgcn_global_load_lds((const unsigned*)((const char*)(gbase) + (voff)[_i]), (PG8_LAS unsigned*)(lds + (bufoff) + ldsw + _i * 8192), 16, 0, 0); } while (0)
#define PG8_STAGE_A(bufoff, gbase, h_, NX) do { if constexpr (GATHER) { if (NX) PG8_STAGE(bufoff, gbase, gv2[h_]); else PG8_STAGE(bufoff, gbase, gvc[h_]); } \
        else PG8_STAGE(bufoff, (gbase) + (h_) * hstepA, voffA); } while (0)
#define PG8_LD2(dst_, off_) do { const u32x4 x_ = *(const PG8_LAS u32x4*)(lds + (off_)), y_ = *(const PG8_LAS u32x4*)(lds + (off_) + 1024); \
        dst_ = (i32x8){(int)x_[0], (int)x_[1], (int)x_[2], (int)x_[3], (int)y_[0], (int)y_[1], (int)y_[2], (int)y_[3]}; } while (0)
#define PG8_LDA(dst, b, h) do { if constexpr (FP8) { _Pragma("unroll") for (int m = 0; m < 4; ++m) PG8_LD2(dst##8[m], PG8_SA(b, h) + aoff + m * 2048); } \
        else { _Pragma("unroll") for (int m = 0; m < 4; ++m) _Pragma("unroll") for (int k = 0; k < 2; ++k) dst[m][k] = *(const PG8_LAS bf16x8*)(lds + PG8_SA(b, h) + aoff + m * 2048 + k * 1024); } } while (0)
#define PG8_LDB(dst, b, h) do { if constexpr (FP8) { _Pragma("unroll") for (int n = 0; n < 2; ++n) PG8_LD2(dst##8[n], PG8_SB(b, h) + boff + n * 2048); } \
        else { _Pragma("unroll") for (int n = 0; n < 2; ++n) _Pragma("unroll") for (int k = 0; k < 2; ++k) dst[n][k] = *(const PG8_LAS bf16x8*)(lds + PG8_SB(b, h) + boff + n * 2048 + k * 1024); } } while (0)
#define PG8_MMA(ai, bj, At, Bt) do { __builtin_amdgcn_s_setprio(1); _Pragma("unroll") for (int m = 0; m < 4; ++m) _Pragma("unroll") for (int n = 0; n < 2; ++n) { \
        if constexpr (FP8) asm volatile("v_mfma_scale_f32_16x16x128_f8f6f4 %0, %1, %2, %0, %3, %3 op_sel_hi:[0,0,0]" : "+v"(acc[ai][bj][m][n]) : "v"(Bt##8[n]), "v"(At##8[m]), "v"(sc1)); \
        else { _Pragma("unroll") for (int k = 0; k < 2; ++k) acc[ai][bj][m][n] = __builtin_amdgcn_mfma_f32_16x16x32_bf16(Bt[n][k], At[m][k], acc[ai][bj][m][n], 0, 0, 0); } } \
        __builtin_amdgcn_s_setprio(0); } while (0)
#define PG8_WAIT_V(n) asm volatile("s_waitcnt vmcnt(" #n ")" ::: "memory")
#define PG8_WAIT_L(n) asm volatile("s_waitcnt lgkmcnt(" #n ")" ::: "memory")
#define PG8_BAR __builtin_amdgcn_s_barrier()
#define PG8_SCHED __builtin_amdgcn_sched_barrier(0)
    Unit cur, nxt; int ui = 0;
    if (!S.next(0, cur)) return;
    int sc1 = 0x7f7f7f7f; asm volatile("" : "+v"(sc1));
    f32x4 acc[2][2][4][2];
#pragma unroll
    for (int a = 0; a < 2; ++a)
#pragma unroll
        for (int b = 0; b < 2; ++b)
#pragma unroll
            for (int m = 0; m < 4; ++m)
#pragma unroll
                for (int n = 0; n < 2; ++n) acc[a][b][m][n] = (f32x4){0.f, 0.f, 0.f, 0.f};
    bf16x8 At[4][2], B0[2][2], B1[2][2];
    i32x8 At8[4], B08[2], B18[2];
    const char* cA = (const char*)g.A + (size_t)cur.pm * tstepA; const char* cB = (const char*)g.Bt + (size_t)cur.pn * tstepB;
    if constexpr (GATHER) {
        PG8_GDMA(cur.pm); PG8_WAIT_V(0);
#pragma unroll
        for (int h = 0; h < 2; ++h)
#pragma unroll
            for (int i = 0; i < 2; ++i) { gvc[h][i] = PG8_GREAD(h, i); gvn[h][i] = gvc[h][i]; }
        PG8_WAIT_L(0);
    }
    PG8_STAGE(PG8_SB(0, 0), cB, voffB); PG8_STAGE_A(PG8_SA(0, 0), cA, 0, false); PG8_STAGE(PG8_SB(0, 1), cB + hstepB, voffB); PG8_STAGE_A(PG8_SA(0, 1), cA, 1, false);
    if (wr == 1) PG8_BAR;
    PG8_WAIT_V(4); PG8_BAR;
    PG8_STAGE(PG8_SB(1, 0), cB + kstep, voffB); PG8_STAGE_A(PG8_SA(1, 0), cA + kstep, 0, false); PG8_STAGE(PG8_SB(1, 1), cB + hstepB + kstep, voffB);
    PG8_WAIT_V(6); PG8_BAR;
    for (;;) {
        const bool has_next = S.next(ui + 1, nxt);
        if constexpr (GATHER) PG8_GDMA(has_next ? nxt.pm : cur.pm);
        const char* nA = has_next ? (const char*)g.A + (size_t)nxt.pm * tstepA : cA; const char* nB = has_next ? (const char*)g.Bt + (size_t)nxt.pn * tstepB : cB;
        for (int t = 0; t < nt; t += 2) {
            if constexpr (Hook::ENABLED) { if (t == 8 || t == 16) H(acc, cur, t >> 3, wr, wc, fr, fq); }
            const bool last = (t == nt - 2);
            const char* a1 = cA + (size_t)(t + 1) * kstep;
            const char* a2 = last ? nA : cA + (size_t)(t + 2) * kstep; const char* b2 = last ? nB : cB + (size_t)(t + 2) * kstep;
            const char* a3 = a2 + kstep; const char* b3 = b2 + kstep;
            if constexpr (GATHER) {
#pragma unroll
                for (int h = 0; h < 2; ++h)
#pragma unroll
                    for (int i = 0; i < 2; ++i) { gvn[h][i] = PG8_GREAD(h, i); gv2[h][i] = last ? gvn[h][i] : gvc[h][i]; }
            }
            PG8_LDB(B0, 0, 0); PG8_SCHED; PG8_LDA(At, 0, 0); PG8_STAGE_A(PG8_SA(1, 1), a1, 1, false);
            PG8_WAIT_L(8); PG8_BAR; PG8_WAIT_L(0); PG8_MMA(0, 0, At, B0); PG8_BAR; PG8_SCHED;
            PG8_LDB(B1, 0, 1); PG8_STAGE(PG8_SB(0, 0), b2, voffB);
            PG8_BAR; PG8_WAIT_L(0); PG8_MMA(0, 1, At, B1); PG8_BAR;
            PG8_LDA(At, 0, 1); PG8_STAGE_A(PG8_SA(0, 0), a2, 0, true);
            PG8_BAR; PG8_WAIT_L(0); PG8_MMA(1, 0, At, B0); PG8_BAR; PG8_SCHED;
            PG8_STAGE(PG8_SB(0, 1), b2 + hstepB, voffB);
            PG8_WAIT_V(6); PG8_BAR; PG8_MMA(1, 1, At, B1); PG8_BAR;
            PG8_LDB(B0, 1, 0); PG8_SCHED; PG8_LDA(At, 1, 0); PG8_STAGE_A(PG8_SA(0, 1), a2, 1, true);
            PG8_WAIT_L(8); PG8_BAR; PG8_WAIT_L(0); PG8_MMA(0, 0, At, B0); PG8_BAR; PG8_SCHED;
            PG8_LDB(B1, 1, 1); PG8_STAGE(PG8_SB(1, 0), b3, voffB);
            PG8_BAR; PG8_WAIT_L(0); PG8_MMA(0, 1, At, B1); PG8_BAR;
            PG8_LDA(At, 1, 1); PG8_STAGE_A(PG8_SA(1, 0), a3, 0, true);
            PG8_BAR; PG8_WAIT_L(0); PG8_MMA(1, 0, At, B0); PG8_BAR; PG8_SCHED;
            PG8_STAGE(PG8_SB(1, 1), b3 + hstepB, voffB);
            PG8_WAIT_V(6); PG8_BAR; PG8_MMA(1, 1, At, B1); PG8_BAR;
        }
        if constexpr (FP8) asm volatile("s_nop 15\n\ts_nop 15" ::: "memory");
        E(acc, cur, wr, wc, fr, fq);
        if (!has_next) break;
#pragma unroll
        for (int a = 0; a < 2; ++a)
#pragma unroll
            for (int b = 0; b < 2; ++b)
#pragma unroll
                for (int m = 0; m < 4; ++m)
#pragma unroll
                    for (int n = 0; n < 2; ++n) acc[a][b][m][n] = (f32x4){0.f, 0.f, 0.f, 0.f};
        cur = nxt; cA = nA; cB = nB; ++ui;
        if constexpr (GATHER) {
#pragma unroll
            for (int h = 0; h < 2; ++h)
#pragma unroll
                for (int i = 0; i < 2; ++i) gvc[h][i] = gvn[h][i];
        }
    }
    PG8_WAIT_V(0);
    if (wr == 0) PG8_BAR;
    PG8_BAR;
#undef PG8_SA
#undef PG8_SB
#undef PG8_STAGE
#undef PG8_STAGE_A
#undef PG8_GDMA
#undef PG8_GREAD
#undef PG8_LDA
#undef PG8_LD2
#undef PG8_LDB
#undef PG8_MMA
#undef PG8_WAIT_V
#undef PG8_WAIT_L
#undef PG8_BAR
#undef PG8_SCHED
}
struct LatOrder : StaticOrder { __device__ bool next(int i, Unit& u) const { if (!StaticOrder::next(i, u)) return false; u.pm += 1 + (u.pm >= 64 ? 1 : 0); return true; } };
struct MoeOrder : StaticOrder { __device__ bool next(int i, Unit& u) const { if (!StaticOrder::next(i, u)) return false; u.pn += (u.pm >> 4) * nN; return true; } };
template <class F> struct EpiAdapt { F f; int nN_local;
    __device__ __forceinline__ void operator()(const f32x4 (&acc)[2][2][4][2], const Unit& u, int wr, int wc, int fr, int fq) const {
        const int pnl = nN_local > 0 ? u.pn % nN_local : u.pn;
        const int row0 = u.pm * BM + wr * 64 + fr, col0 = pnl * BM + wc * 32 + 4 * fq;
        if constexpr (F::BATCH) {
#pragma unroll
            for (int ai = 0; ai < 2; ++ai)
#pragma unroll
                for (int mp = 0; mp < 2; ++mp) {
                    typename F::Pre pre[2][2][2];
#pragma unroll
                    for (int mm = 0; mm < 2; ++mm)
#pragma unroll
                        for (int bj = 0; bj < 2; ++bj)
#pragma unroll
                            for (int n = 0; n < 2; ++n) pre[mm][bj][n] = f.load(row0 + ai * HALF + (2 * mp + mm) * 16, col0 + bj * HALF + n * 16);
#pragma unroll
                    for (int mm = 0; mm < 2; ++mm)
#pragma unroll
                        for (int bj = 0; bj < 2; ++bj)
#pragma unroll
                            for (int n = 0; n < 2; ++n) f.apply(row0 + ai * HALF + (2 * mp + mm) * 16, col0 + bj * HALF + n * 16, acc[ai][bj][2 * mp + mm][n], pre[mm][bj][n]);
                }
        } else {
#pragma unroll
        for (int ai = 0; ai < 2; ++ai)
#pragma unroll
            for (int m = 0; m < 4; ++m)
#pragma unroll
                for (int bj = 0; bj < 2; ++bj)
#pragma unroll
                    for (int n = 0; n < 2; ++n) f.store4(row0 + ai * HALF + m * 16, col0 + bj * HALF + n * 16, acc[ai][bj][m][n]);
        }
    }
};
template <class F> struct EpiAdaptPair { F f; int nN_local;
    __device__ __forceinline__ void operator()(const f32x4 (&acc)[2][2][4][2], const Unit& u, int wr, int wc, int fr, int fq) const {
        const int pnl = u.pn % nN_local;
        const int row0 = u.pm * BM + wr * 64 + fr;
#pragma unroll
        for (int ai = 0; ai < 2; ++ai)
#pragma unroll
            for (int m = 0; m < 4; ++m)
#pragma unroll
                for (int bj = 0; bj < 2; ++bj) f.store_pair(row0 + ai * HALF + m * 16, (pnl * 8 + bj * 4 + wc) * 16 + 4 * fq, acc[ai][bj][m][0], acc[ai][bj][m][1]);
    }
};
}

DI f32x4 gate4(u32x2 g) { const float t = 9.094947e-13f; return (f32x4){fmaxf(lo_f(g.x), t), fmaxf(hi_f(g.x), t), fmaxf(lo_f(g.y), t), fmaxf(hi_f(g.y), t)}; }
struct MergeHook { static constexpr bool ENABLED = true; const bf16* G;
    DI void operator()(f32x4 (&acc)[2][2][4][2], const pg8::Unit& u, int seg, int wr, int wc, int fr, int fq) const {
        const int row0 = u.pm * 256 + wr * 64 + fr, col0 = u.pn * 256 + wc * 32 + 4 * fq;
#pragma unroll
        for (int ai = 0; ai < 2; ++ai)
#pragma unroll
            for (int mp = 0; mp < 2; ++mp) {
                u32x2 ga[2][2][2], gb[2][2][2];
#pragma unroll
                for (int mm = 0; mm < 2; ++mm)
#pragma unroll
                    for (int bj = 0; bj < 2; ++bj)
#pragma unroll
                        for (int n = 0; n < 2; ++n) { const bf16* gp = G + (size_t)(row0 + ai * 128 + (2 * mp + mm) * 16) * 3072 + (seg - 1) * 1024 + col0 + bj * 128 + n * 16;
                            ga[mm][bj][n] = *(const u32x2*)gp; gb[mm][bj][n] = *(const u32x2*)(gp + 1024); }
#pragma unroll
                for (int mm = 0; mm < 2; ++mm)
#pragma unroll
                    for (int bj = 0; bj < 2; ++bj)
#pragma unroll
                        for (int n = 0; n < 2; ++n) { const f32x4 a = gate4(ga[mm][bj][n]), b = gate4(gb[mm][bj][n]);
                            const f32x4 r = {a[0] * __builtin_amdgcn_rcpf(b[0]), a[1] * __builtin_amdgcn_rcpf(b[1]), a[2] * __builtin_amdgcn_rcpf(b[2]), a[3] * __builtin_amdgcn_rcpf(b[3])};
                            acc[ai][bj][2 * mp + mm][n] *= r; }
            }
    }
};
struct EpiMergeFinal { static constexpr bool PAIR = false, BATCH = true; const bf16* G; bf16* Mb;
    struct Pre { u32x2 g; };
    DI Pre load(int r, int c) const { Pre p; p.g = *(const u32x2*)(G + (size_t)r * 3072 + 2048 + c); return p; }
    DI void apply(int r, int c, f32x4 v, const Pre& p) const { const f32x4 m = v * gate4(p.g); u32x2 o; o.x = pk2(m[0], m[1]); o.y = pk2(m[2], m[3]); *(u32x2*)(Mb + (size_t)r * D + c) = o; }
    DI void store4(int r, int c, f32x4 v) const { apply(r, c, v, load(r, c)); } };

template <bool FP8 = false, class F>
DI void dense_gemm(const bf16* A, int lda, const bf16* Bt, int ldb, int N, int K, const F& f, unsigned char* lds, bool do_ctx = true) {
    const int tid = ltid();
    if (do_ctx) sgemm_phase<F, BSelNone, RowMapCtx, FP8>(A, lda, Bt, ldb, 512, N, K, f, BSelNone(), RowMapCtx());
    pg8::Gemm g{A, Bt, lda, ldb, K}; pg8::LatOrder S; S.init(128, N / 256, (int)gridDim.x, (int)blockIdx.x);
    pg8::EpiAdapt<F> E{f, 0};
    pg8::gemm_phase<pg8::EpiAdapt<F>, pg8::LatOrder, FP8>((PG8_LAS unsigned char*)lds, g, S, E, tid);
}

#define XB_TMO      128
#define XB_XCNT(j)  (256  + 64 * (j))
#define XB_XSUB(j)  (1280 + 64 * (j))
#define XB_XGEN(j)  (2304 + 64 * (j))
#define XB_TOP      3328
#define XB_TOPGEN   3392
#define XCD_BAR_WORDS 3456
#define XB_SPIN_CAP (1u << 18)
#define LAS __attribute__((address_space(3)))

__device__ __forceinline__ unsigned xb_ld(unsigned* p)              { return __hip_atomic_load(p, __ATOMIC_RELAXED, __HIP_MEMORY_SCOPE_AGENT); }
__device__ __forceinline__ unsigned xb_add(unsigned* p, unsigned v) { return __hip_atomic_fetch_add(p, v, __ATOMIC_RELAXED, __HIP_MEMORY_SCOPE_AGENT); }
__device__ __forceinline__ unsigned xb_xcc_id() { return (unsigned)__builtin_amdgcn_s_getreg((3 << 11) | 20) & 0xFu; }
#define XB_SPIN(cond, bar) do { unsigned _sp = 0; while (cond) { __builtin_amdgcn_s_sleep(1); \
    if ((++_sp & 255u) == 0u) { if (xb_ld(&(bar)[XB_TMO])) break; if (_sp > XB_SPIN_CAP) { atomicAdd(&(bar)[XB_TMO], 1u); break; } } } } while (0)

struct XcdBarrier {
    unsigned* bar; unsigned x;
    volatile LAS unsigned* st;
};

__device__ __forceinline__ XcdBarrier xcd_barrier_post(unsigned* bar, volatile LAS unsigned* st) {
    XcdBarrier b; b.bar = bar; b.x = xb_xcc_id(); b.st = st;
    if (threadIdx.x == 0) (void)xb_add(&bar[XB_XCNT(b.x)], 1u);
    return b;
}
__device__ __forceinline__ void xcd_barrier_complete(unsigned* bar, unsigned x, unsigned& nloc, unsigned& nx) {
    const unsigned G = gridDim.x * gridDim.y * gridDim.z;
    unsigned sum, cnt, mine, sp = 0u;
    for (;;) {
        sum = 0u; cnt = 0u; mine = 0u;
#pragma unroll
        for (unsigned j = 0; j < 16; ++j) { const unsigned c = xb_ld(&bar[XB_XCNT(j)]); sum += c; cnt += (c > 0u) ? 1u : 0u; mine = (j == x) ? c : mine; }
        if (sum == G) break;
        __builtin_amdgcn_s_sleep(1);
        if ((++sp & 255u) == 0u) { if (xb_ld(&bar[XB_TMO])) break; if (sp > XB_SPIN_CAP) { atomicAdd(&bar[XB_TMO], 1u); break; } }
    }
    nloc = mine > 0u ? mine : 1u; nx = cnt > 0u ? cnt : 1u;
}

__device__ __forceinline__ void xcd_barrier(const XcdBarrier& b) {
    asm volatile("s_waitcnt vmcnt(0)" ::: "memory");
    __syncthreads();
    if (threadIdx.x == 0) {
        unsigned* bar = b.bar;
        __builtin_amdgcn_s_waitcnt(0);
        unsigned nloc = b.st[0], nx = b.st[1];
        if (nloc == 0u) { xcd_barrier_complete(bar, b.x, nloc, nx); b.st[0] = nloc; b.st[1] = nx; }
        const unsigned old = xb_add(&bar[XB_XSUB(b.x)], 1u);
        const unsigned gen = old / nloc;
        if (old + 1u == (gen + 1u) * nloc) {
            __builtin_amdgcn_fence(__ATOMIC_RELEASE, "agent");
            asm volatile("s_waitcnt vmcnt(0)" ::: "memory");
            const unsigned og = xb_add(&bar[XB_TOP], 1u);
            const unsigned tg = og / nx;
            if (og + 1u == (tg + 1u) * nx) xb_add(&bar[XB_TOPGEN], 1u);
            else XB_SPIN(xb_ld(&bar[XB_TOPGEN]) == tg, bar);
            __builtin_amdgcn_fence(__ATOMIC_ACQUIRE, "agent");
            xb_add(&bar[XB_XGEN(b.x)], 1u);
            asm volatile("s_waitcnt vmcnt(0)" ::: "memory");
        } else {
            XB_SPIN(xb_ld(&bar[XB_XGEN(b.x)]) == gen, bar);
            __builtin_amdgcn_fence(__ATOMIC_ACQUIRE, "agent");
            asm volatile("s_waitcnt vmcnt(0)" ::: "memory");
        }
    }
    __syncthreads();
}


__device__ __forceinline__ void xcd_barrier_fill(const XcdBarrier& b, const Params& p, unsigned char* ldsb, int flayer) {
    asm volatile("s_waitcnt vmcnt(0)" ::: "memory");
    __syncthreads();
    unsigned gen = 0u;
    if (threadIdx.x == 0) {
        unsigned* bar = b.bar;
        __builtin_amdgcn_s_waitcnt(0);
        unsigned nloc = b.st[0], nx = b.st[1];
        if (nloc == 0u) { xcd_barrier_complete(bar, b.x, nloc, nx); b.st[0] = nloc; b.st[1] = nx; }
        const unsigned old = xb_add(&bar[XB_XSUB(b.x)], 1u);
        gen = old / nloc;
        if (old + 1u == (gen + 1u) * nloc) {
            __builtin_amdgcn_fence(__ATOMIC_RELEASE, "agent");
            asm volatile("s_waitcnt vmcnt(0)" ::: "memory");
            const unsigned og = xb_add(&bar[XB_TOP], 1u);
            const unsigned tg = og / nx;
            if (og + 1u == (tg + 1u) * nx) xb_add(&bar[XB_TOPGEN], 1u);
            else XB_SPIN(xb_ld(&bar[XB_TOPGEN]) == tg, bar);
            __builtin_amdgcn_fence(__ATOMIC_ACQUIRE, "agent");
            xb_add(&bar[XB_XGEN(b.x)], 1u);
            asm volatile("s_waitcnt vmcnt(0)" ::: "memory");
            b.st[2] = 0u;
        } else {
            b.st[2] = (old - gen * nloc) * 2u < nloc ? 2u : 1u;
        }
    }
    __syncthreads();
    const unsigned mode = b.st[2];
    if (mode == 2u) {
        unsigned char* ws_ = lws(p); unsigned* cctr = (unsigned*)(ws_ + WS_CTL) + 10 + flayer;
        const int tid = ltid();
        int cur = 0;
        if (threadIdx.x == 0) { cur = (int)b.st[4]; b.st[4] = 0xffffffffu; if (cur < 0) cur = (int)__hip_atomic_fetch_add(cctr, 8u, __ATOMIC_RELAXED, __HIP_MEMORY_SCOPE_AGENT); }
        for (;;) {
            __syncthreads();
            int nxt = -1;
            if (threadIdx.x == 0) {
                unsigned* bar = b.bar; const unsigned nloc = b.st[0];
                const bool rel = xb_ld(&bar[XB_XGEN(b.x)]) != gen;
                const bool allhere = xb_ld(&bar[XB_XSUB(b.x)]) >= (gen + 1u) * nloc;
                if (rel || allhere || cur >= MOE_TILES) { if (cur < MOE_TILES) b.st[4] = (unsigned)cur; b.st[3] = 0xffffffffu; }
                else { b.st[3] = (unsigned)cur; nxt = (int)__hip_atomic_fetch_add(cctr, 8u, __ATOMIC_RELAXED, __HIP_MEMORY_SCOPE_AGENT); }
            }
            __syncthreads();
            const int g0 = (int)b.st[3];
            if (g0 < 0) break;
            cvt_moe_tile(p, ws_, flayer, g0 + (tid >> 6), (float*)ldsb, tid);
            cur = nxt;
        }
    }
    if (threadIdx.x == 0 && mode != 0u) {
        unsigned* bar = b.bar;
        XB_SPIN(xb_ld(&bar[XB_XGEN(b.x)]) == gen, bar);
        __builtin_amdgcn_fence(__ATOMIC_ACQUIRE, "agent");
        asm volatile("s_waitcnt vmcnt(0)" ::: "memory");
    }
    __syncthreads();
}

template <int PH> DI void run_phase(const Params& p, int layer, unsigned char* lds) {
    unsigned char* const ws_ = lws(p);
    const bf16* H = (const bf16*)(ws_ + WS_H);
    if constexpr (PH == 0) { phase_cvt(p, (float*)lds, 0, 8, blockIdx.x * 8, gridDim.x * 8, true); phase_cvt(p, (float*)lds, 56, 64, blockIdx.x * 8, gridDim.x * 8, false); }
    if constexpr (PH == 1) { phase_mod(p, (float*)lds); }
    if constexpr (PH == 2) { phase_tables(p); }
    if constexpr (PH == 3) { if (layer == 0) phase_lnmod1(p, layer); }
    if constexpr (PH == 4) {
        if (FP8_INPROJ) { EpiStoreBf16 E{(bf16*)(ws_ + R_Z), ZLD, 1.f / WD_SCALE}; dense_gemm<true>(H, 512, (const bf16*)(ws_ + WS_BT_IN + (size_t)layer * ZLD * 1024), 512, ZLD, 512, E, lds); }
        else { EpiStoreBf16 E{(bf16*)(ws_ + R_Z), ZLD, 1.f}; dense_gemm(H, D, (const bf16*)(ws_ + WS_BT_IN) + (size_t)layer * ZLD * 1024, 1024, ZLD, 1024, E, lds); } }
    if constexpr (PH == 5) { phase_prep1(p, layer); }
    if constexpr (PH == 6) { EpiStoreBf16 E{(bf16*)(ws_ + R_QRAW), 768, 1.f}; dense_gemm((const bf16*)(ws_ + R_Z) + ZO_CQ, ZLD, (const bf16*)(ws_ + WS_BT_UQ) + (size_t)layer * 768 * 256, 256, 768, 256, E, lds);
              EpiStoreBf16 E2{(bf16*)(ws_ + R_KVRAW), 1024, 1.f}; dense_gemm((const bf16*)(ws_ + R_Z) + ZO_CKV, ZLD, (const bf16*)(ws_ + WS_BT_UKV) + (size_t)layer * 1024 * 256, 256, 1024, 256, E2, lds); }
    if constexpr (PH == 7) { phase_prep2(p, layer); }
    if constexpr (PH == 8) { phase_attn(p, layer, lds); }
    if constexpr (PH == 9) { phase_diffcomb(p, layer);
        if (FP8_GATE) { EpiGate E{(bf16*)(ws_ + R_G), p.in[21] + layer * 3072, 1.f / WD_SCALE}; dense_gemm<true>(H, 512, (const bf16*)(ws_ + WS_BT_GATE + (size_t)layer * 3072 * 1024), 512, 3072, 512, E, lds, layer == 0); }
        else { EpiGate E{(bf16*)(ws_ + R_G), p.in[21] + layer * 3072, 1.f}; dense_gemm(H, D, (const bf16*)(ws_ + WS_BT_GATE) + (size_t)layer * 3072 * 1024, 1024, 3072, 1024, E, lds, layer == 0); } }
    if constexpr (PH == 11) { const bf16* G = (const bf16*)(ws_ + R_G); bf16* Mp = (bf16*)(ws_ + R_M32); bf16* Mb = (bf16*)(ws_ + R_M);
               const bf16* Y = (const bf16*)(ws_ + R_YA); const bf16* Bb = (const bf16*)(ws_ + WS_BT_BR) + (size_t)layer * 1024 * 1536;
               if (layer == 0) {
                   { EpiMerge<0> E{G, Mp, Mb}; sgemm_phase(Y, 1536, Bb, 1536, 512, 1024, 512, E, BSelNone(), RowMapCtx()); }
                   { EpiMerge<1> E{G, Mp, Mb}; sgemm_phase(Y + 512, 1536, Bb + 512, 1536, 512, 1024, 512, E, BSelNone(), RowMapCtx()); }
                   { EpiMerge<2> E{G, Mp, Mb}; sgemm_phase(Y + 1024, 1536, Bb + 1024, 1536, 512, 1024, 512, E, BSelNone(), RowMapCtx()); } }
               const int tid = ltid(); pg8::Gemm g{Y, Bb, 1536, 1536, 1536}; pg8::LatOrder S; S.init(128, 4, (int)gridDim.x, (int)blockIdx.x);
               EpiMergeFinal EF{G, Mb}; pg8::EpiAdapt<EpiMergeFinal> E{EF, 0}; MergeHook H{G};
               pg8::gemm_phase<pg8::EpiAdapt<EpiMergeFinal>, pg8::LatOrder, false, MergeHook>((PG8_LAS unsigned char*)lds, g, S, E, tid, H); }
    if constexpr (PH == 12) { EpiOut E{p.in[0], p.in[2], layer, (const float*)(ws_ + WS_MOD) + (size_t)layer * 3 * 6144, (float*)(ws_ + WS_X)};
               dense_gemm((const bf16*)(ws_ + R_M), D, (const bf16*)(ws_ + WS_BT_OUT) + (size_t)layer * 1024 * 1024, 1024, 1024, 1024, E, lds, layer == 0); }
    if constexpr (PH == 13) { phase_ln1_router(p, layer, (float*)lds); }
    if constexpr (PH == 14) {
        phase_topk(p, (unsigned*)lds); __syncthreads();
        {
            unsigned* cctr = (unsigned*)(ws_ + WS_CTL) + 10 + layer; const int tid = ltid();
            volatile LAS unsigned* slot = (volatile LAS unsigned*)(lds + 8 * 64 * 65 * 4  ) + 2;
            unsigned pend = 0u; if (tid == 0) { pend = slot[2]; slot[2] = 0xffffffffu; if ((int)pend < 0) pend = __hip_atomic_fetch_add(cctr, 8u, __ATOMIC_RELAXED, __HIP_MEMORY_SCOPE_AGENT); }
            int par = 0;
            for (;;) {
                unsigned nxt = 0u;
                if (tid == 0) { slot[par] = pend; nxt = __hip_atomic_fetch_add(cctr, 8u, __ATOMIC_RELAXED, __HIP_MEMORY_SCOPE_AGENT); }
                __syncthreads();
                const int g0 = (int)slot[par]; par ^= 1;
                if (g0 >= MOE_TILES) break;
                cvt_moe_tile(p, ws_, layer, g0 + (tid >> 6), (float*)lds, tid);
                pend = nxt;
            }
            __syncthreads();
        } }
    if constexpr (PH == 15) { phase_gather(p); }
    if constexpr (PH == 16) { EpiAct E{ws_ + R_ACT}; BSelMoe bs{(size_t)5632 * 512};
               const bf16* A = (const bf16*)(ws_ + WS_H); const bf16* Bt = (const bf16*)(ws_ + WS_BT_M1 + (size_t)layer * NE * 5632 * 1024); const int* selrow = (const int*)(ws_ + WS_SELROW);
               if (layer == 0) sgemm_phase<EpiAct, BSelMoe, RowMapOff, true>(A, 512, Bt, 512, NSLOT - NSLOT_L, 5632, 512, E, bs, RowMapOff{NSLOT_L}, selrow);
               const int tid = ltid(); pg8::Gemm g{A, Bt, 512, 512, 512}; pg8::MoeOrder S; S.init(256, 22, (int)gridDim.x, (int)blockIdx.x); pg8::EpiAdaptPair<EpiAct> EA{E, 22};
               pg8::gemm_phase<pg8::EpiAdaptPair<EpiAct>, pg8::MoeOrder, true, pg8::NoHook, true>((PG8_LAS unsigned char*)lds, g, S, EA, tid, pg8::NoHook(), selrow); }
    if constexpr (PH == 17) { EpiDown E{(bf16*)(ws_ + R_XSEL), (const float*)(ws_ + WS_SELW)}; BSelMoe bs{(size_t)1024 * (FF / 2)};
               const bf16* A = (const bf16*)(ws_ + R_ACT); const bf16* Bt = (const bf16*)(ws_ + WS_BT_M2 + (size_t)layer * NE * 1024 * FF);
               if (layer == 0) sgemm_phase<EpiDown, BSelMoe, RowMapOff, true>(A, FF / 2, Bt, FF / 2, NSLOT - NSLOT_L, 1024, FF / 2, E, bs, RowMapOff{NSLOT_L});
               const int tid = ltid(); pg8::Gemm g{A, Bt, FF / 2, FF / 2, FF / 2}; pg8::MoeOrder S; S.init(256, 4, (int)gridDim.x, (int)blockIdx.x); pg8::EpiAdapt<EpiDown> EA{E, 4};
               pg8::gemm_phase<pg8::EpiAdapt<EpiDown>, pg8::MoeOrder, true>((PG8_LAS unsigned char*)lds, g, S, EA, tid); }
    if constexpr (PH == 18) { phase_combine_ln2(p, layer, (float*)lds); }
}

#define GRID_BAR() do { unsigned char* w_ = lws(p); XcdBarrier b_; b_.bar = (unsigned*)(w_ + WS_CTL); b_.x = xb_xcc_id(); b_.st = xbw; xcd_barrier(b_); } while (0)
#define GRID_BAR_F(fl) do { unsigned char* w_ = lws(p); XcdBarrier b_; b_.bar = (unsigned*)(w_ + WS_CTL); b_.x = xb_xcc_id(); b_.st = xbw; xcd_barrier_fill(b_, p, lds, fl); } while (0)
constexpr int LDS_MAIN = 8 * 64 * 65 * 4  , LDS_BYTES = LDS_MAIN + 32;
__global__ void __launch_bounds__(NWG_THREADS, 2) k_mega(Params p) {
    extern __shared__ __attribute__((aligned(16))) unsigned char lds[];
    volatile LAS unsigned* xbw = (volatile LAS unsigned*)(lds + LDS_MAIN);
    if (threadIdx.x == 0) { xbw[0] = 0u; xbw[1] = 0u; xbw[2] = 0u; xbw[3] = 0u; xbw[4] = 0xffffffffu; }
    __syncthreads();
    (void)xcd_barrier_post((unsigned*)(p.ws + WS_CTL), xbw);
    run_phase<0>(p, 0, lds); run_phase<1>(p, 0, lds); run_phase<2>(p, 0, lds);
    GRID_BAR();
#define LAYER_BODY(l) do { \
        run_phase<3>(p, l, lds); GRID_BAR(); \
        run_phase<4>(p, l, lds); GRID_BAR_F(l); \
        run_phase<5>(p, l, lds); \
        run_phase<6>(p, l, lds); GRID_BAR_F(l); \
        run_phase<7>(p, l, lds); GRID_BAR(); \
        run_phase<8>(p, l, lds); GRID_BAR_F(l); \
        run_phase<9>(p, l, lds); GRID_BAR_F(l); \
        run_phase<11>(p, l, lds); GRID_BAR_F(l); \
        run_phase<12>(p, l, lds); GRID_BAR_F(l); \
        run_phase<13>(p, l, lds); GRID_BAR_F(l); \
        run_phase<14>(p, l, lds); GRID_BAR(); \
        run_phase<16>(p, l, lds); if ((l) == 0) GRID_BAR_F(1); else GRID_BAR(); \
        run_phase<17>(p, l, lds); if ((l) == 0) GRID_BAR_F(1); else GRID_BAR(); \
        run_phase<18>(p, l, lds); \
    } while (0)
    LAYER_BODY(0);
    LAYER_BODY(1);
#undef LAYER_BODY
}

extern "C" void kernel_launch(void* const* d_in, const int* in_sizes, int n_in, void* d_out, int out_size, void* d_ws, size_t ws_size, hipStream_t stream) {
    if (n_in != 31 || ws_size < WS_TOTAL) { fprintf(stderr, "kernel_launch: need 31 inputs and %zu bytes of workspace (got %d, %zu)\n", (size_t)WS_TOTAL, n_in, ws_size); return; }
    static int grid = 0;
    if (!grid) {
        int dev = 0, cus = 0, per_cu = 0;
        (void)hipGetDevice(&dev);
        (void)hipDeviceGetAttribute(&cus, hipDeviceAttributeMultiprocessorCount, dev);
        (void)hipFuncSetAttribute((const void*)k_mega, hipFuncAttributeMaxDynamicSharedMemorySize, LDS_BYTES);
        (void)hipOccupancyMaxActiveBlocksPerMultiprocessor(&per_cu, (const void*)k_mega, NWG_THREADS, LDS_BYTES);
        if (per_cu < 1) { fprintf(stderr, "kernel_launch: occupancy query reports %d blocks per CU\n", per_cu); per_cu = 1; }
        grid = cus * 1;
        if (grid <= 0) grid = 256;
    }
    Params p; memset(&p, 0, sizeof(p));
    for (int i = 0; i < 31; ++i) p.in[i] = (const float*)d_in[i];
    p.out = (float*)d_out; p.ws = (unsigned char*)d_ws;
    (void)hipMemsetAsync(d_ws, 0, 65536, stream);
    hipLaunchKernelGGL(k_mega, dim3(grid), dim3(NWG_THREADS), LDS_BYTES, stream, p);
}
```

```cpp
#include <hip/hip_runtime.h>
#include <stdint.h>
#include <stdio.h>
#include <string.h>

typedef unsigned short bf16;
typedef short bf16x8 __attribute__((ext_vector_type(8)));
typedef float f32x2 __attribute__((ext_vector_type(2)));
typedef float f32x4 __attribute__((ext_vector_type(4)));
typedef float f32x16 __attribute__((ext_vector_type(16)));
typedef unsigned u32x2 __attribute__((ext_vector_type(2)));
typedef unsigned u32x4 __attribute__((ext_vector_type(4)));
typedef __bf16 bf16x2_t __attribute__((ext_vector_type(2)));
#define DI __device__ __forceinline__
#define MFMA32(a, b, c) __builtin_amdgcn_mfma_f32_32x32x16_bf16((a), (b), (c), 0, 0, 0)

constexpr int D = 1024, NB = 2, SEQ = 16384, CTX = 256, TPB = SEQ + CTX  , MROWS = NB * TPB  ;
constexpr int GRID_W = 64, KGPB = TPB / 32  , NKG = MROWS / 32  ;
constexpr int IN_DIM = 3488, ZLD = 3584;
constexpr int ZO_AQ = 0, ZO_AK = 512, ZO_AV = 1024, ZO_CQ = 1536, ZO_CKV = 1792, ZO_KR = 1920, ZO_DQ = 1952, ZO_DK = 2464, ZO_DV = 2976;
constexpr int NE = 16, FF = 2816, CAP_L = 2048, CAP_C = 32, NSLOT_L = NE * NB * CAP_L  , NSLOT = NSLOT_L + NE * NB * CAP_C  ;
constexpr float LOG2E = 1.4426950408889634f;
constexpr float ALPHA = 1.4142135623730951f;
constexpr float EPS = 1e-6f;
constexpr int NWG_THREADS = 512;

constexpr size_t al256(size_t x) { return (x + 255) & ~(size_t)255; }
constexpr size_t WS_CTL = 0;
constexpr size_t WS_KMAX = 16384;
constexpr size_t WS_MOD = 65536;
constexpr size_t WS_ROPE = WS_MOD + al256(2 * 3 * 6144 * 4);
constexpr size_t ROPE_MROW = 0, ROPE_MCOL = 256 * 16, ROPE_DROW = ROPE_MCOL + 64 * 16, ROPE_DCOL = ROPE_DROW + 256 * 32, ROPE_FLOATS = ROPE_DCOL + 64 * 32;
constexpr size_t WS_LAM = WS_ROPE + al256(ROPE_FLOATS * 4);
constexpr size_t WS_BIAS = WS_LAM + 256;
constexpr size_t BIAS_TILE = 64 * 16;
constexpr size_t WS_BT_IN = WS_BIAS + al256((size_t)2 * 8 * 15 * 4 * BIAS_TILE * 4);
constexpr size_t WS_BT_GATE = WS_BT_IN + (size_t)2 * ZLD * 1024 * 2;
constexpr size_t WS_BT_BR = WS_BT_GATE + (size_t)2 * 3072 * 1024 * 2;
constexpr size_t WS_BT_OUT = WS_BT_BR + (size_t)2 * 3 * 1024 * 512 * 2;
constexpr size_t WS_BT_UQ = WS_BT_OUT + (size_t)2 * 1024 * 1024 * 2;
constexpr size_t WS_BT_UKV = WS_BT_UQ + (size_t)2 * 768 * 256 * 2;
constexpr size_t WS_BT_M1 = WS_BT_UKV + (size_t)2 * 1024 * 256 * 2;
constexpr size_t WS_BT_M2 = WS_BT_M1 + (size_t)2 * NE * 5632 * 1024;
constexpr size_t WS_X = WS_BT_M2 + (size_t)2 * NE * 1024 * FF;
constexpr size_t WS_H = WS_X + (size_t)MROWS * D * 4;
constexpr size_t WS_INVRMS = WS_H + (size_t)MROWS * D * 2;
constexpr size_t WS_KROPE = WS_INVRMS + al256((size_t)MROWS * 2 * 4);
constexpr size_t WS_AFF = WS_KROPE + (size_t)MROWS * 32 * 4;
constexpr size_t WS_SELROW = WS_AFF + (size_t)(2 * 16 * 16384 + 2 * 16 * 256) * 4;
constexpr size_t WS_SELW = WS_SELROW + (size_t)NSLOT * 4;
constexpr size_t WS_SLOTOF = WS_SELW + (size_t)NSLOT * 4;
constexpr size_t WS_QN = WS_SLOTOF + (size_t)MROWS * 16 * 4;
constexpr size_t WS_R1 = WS_QN + (size_t)2 * MROWS * 8 * 4;
constexpr size_t SZ512 = (size_t)MROWS * 512 * 2, SZ768 = (size_t)MROWS * 768 * 2, SZ1024 = (size_t)MROWS * 1024 * 2;
constexpr size_t R_Z = WS_R1;
constexpr size_t R_QNA = R_Z + (size_t)MROWS * ZLD * 2, R_KFNA = R_QNA + SZ512, R_VFNA = R_KFNA + SZ512, R_QD = R_VFNA + SZ512, R_KFD = R_QD + SZ512, R_VFD = R_KFD + SZ512;
constexpr size_t R_QRAW = R_VFD + SZ512, R_KVRAW = R_QRAW + SZ768, R_END = R_KVRAW + SZ1024;
constexpr size_t R_QMLA = WS_R1, R_KFMLA = R_QMLA + SZ768, R_VFMLA = R_KFMLA + SZ768, R_OD = R_VFMLA + SZ512;
static_assert(R_OD + SZ1024 <= R_QNA, "alias map");
constexpr size_t R_G = R_END;
constexpr size_t R_M32 = R_QNA, R_M = R_M32 + (size_t)MROWS * D * 4;
static_assert(R_M + SZ1024 <= R_QRAW, "alias map");
constexpr size_t R_YA = R_QRAW, R_YB = R_YA + SZ512, R_YC = R_YB + SZ512;
static_assert(R_YC + SZ512 <= R_END, "alias map");
constexpr size_t R_XSEL = WS_R1, R_ACT = R_XSEL + (size_t)NSLOT * D * 2;
static_assert(R_ACT + (size_t)NSLOT * FF * 2 <= R_END, "alias map");
constexpr size_t WS_TOTAL = R_G + (size_t)MROWS * 3072 * 2;

struct Params { const float* in[31]; float* out; unsigned char* ws; };

DI float bf2f(bf16 v) { return __uint_as_float((unsigned)v << 16); }
DI unsigned pk2(float a, float b) { f32x2 v = {a, b}; bf16x2_t r = __builtin_convertvector(v, bf16x2_t); return __builtin_bit_cast(unsigned, r); }
DI bf16 f2bf(float a) { return (bf16)(pk2(a, 0.f) & 0xffffu); }
DI float lo_f(unsigned u) { return __uint_as_float(u << 16); }
DI float hi_f(unsigned u) { return __uint_as_float(u & 0xffff0000u); }
DI float wave_sum(float v) {
#pragma unroll
    for (int o = 32; o >= 1; o >>= 1) v += __shfl_xor(v, o);
    return v;
}
DI float wave_max(float v) {
#pragma unroll
    for (int o = 32; o >= 1; o >>= 1) v = fmaxf(v, __shfl_xor(v, o));
    return v;
}
DI int ltid() { int t = threadIdx.x; asm volatile("" : "+v"(t)); return t; }
DI unsigned char* lws(const Params& p) {
    const unsigned long long w = (unsigned long long)p.ws; unsigned lo, hi;
    asm volatile("v_mov_b32 %0, %2\n\tv_mov_b32 %1, %3" : "=v"(lo), "=v"(hi) : "s"((unsigned)w), "s"((unsigned)(w >> 32)));
    lo = __builtin_amdgcn_readfirstlane(lo); hi = __builtin_amdgcn_readfirstlane(hi);
    typedef __attribute__((address_space(1))) unsigned char* gptr_t;
    return (unsigned char*)(gptr_t)(((unsigned long long)hi << 32) | lo);
}
DI int gwave(int tid) { return blockIdx.x * 8 + (tid >> 6); }
DI int nwaves() { return gridDim.x * 8; }
DI float sigmoidf_(float x) { return __builtin_amdgcn_rcpf(1.f + __builtin_amdgcn_exp2f(-x * LOG2E)); }

DI bf16x8 scale8(bf16x8 v, float s) {
    u32x4 u = __builtin_bit_cast(u32x4, v), o;
#pragma unroll
    for (int i = 0; i < 4; ++i) o[i] = pk2(lo_f(u[i]) * s, hi_f(u[i]) * s);
    return __builtin_bit_cast(bf16x8, o);
}
DI void unpack8(bf16x8 v, float (&f)[8]) { const u32x4 u = __builtin_bit_cast(u32x4, v);
#pragma unroll
    for (int i = 0; i < 4; ++i) { f[2 * i] = lo_f(u[i]); f[2 * i + 1] = hi_f(u[i]); } }
DI bf16x8 pack8(const float (&f)[8]) { u32x4 o;
#pragma unroll
    for (int i = 0; i < 4; ++i) o[i] = pk2(f[2 * i], f[2 * i + 1]);
    return __builtin_bit_cast(bf16x8, o); }
DI float sumsq8(const float (&f)[8]) { float s = 0.f;
#pragma unroll
    for (int i = 0; i < 8; ++i) s += f[i] * f[i];
    return s; }
DI float sumsq8p(bf16x8 v) { float f[8]; unpack8(v, f); return sumsq8(f); }


typedef int i32x8 __attribute__((ext_vector_type(8)));
DI unsigned pk4_fp8(float a, float b, float c, float d) { int w = __float_as_int(a); w = __builtin_amdgcn_cvt_pk_fp8_f32(a, b, w, false); w = __builtin_amdgcn_cvt_pk_fp8_f32(c, d, w, true); return (unsigned)w; }
DI unsigned pk4_bf8(float a, float b, float c, float d) { int w = __float_as_int(a); w = __builtin_amdgcn_cvt_pk_bf8_f32(a, b, w, false); w = __builtin_amdgcn_cvt_pk_bf8_f32(c, d, w, true); return (unsigned)w; }
DI u32x4 pk16_fp8(const float* f) { u32x4 o;
#pragma unroll
    for (int i = 0; i < 4; ++i) o[i] = pk4_fp8(f[4 * i], f[4 * i + 1], f[4 * i + 2], f[4 * i + 3]);
    return o; }
DI i32x8 cat8(bf16x8 a, bf16x8 b) { const u32x4 x = __builtin_bit_cast(u32x4, a), y = __builtin_bit_cast(u32x4, b); return (i32x8){(int)x[0], (int)x[1], (int)x[2], (int)x[3], (int)y[0], (int)y[1], (int)y[2], (int)y[3]}; }
#define MFMA8(a, b, c, fa, fb) __builtin_amdgcn_mfma_scale_f32_32x32x64_f8f6f4((a), (b), (c), (fa), (fb), 0, 0x7f7f7f7f, 0, 0x7f7f7f7f)
DI int kappa(int h, int j) { return (j >> 4) * 32 + (j & 3) + 8 * ((j & 15) >> 2) + 4 * h; }
constexpr bool FP8_INPROJ = true, FP8_GATE = true;
constexpr float WD_SCALE = 32.f;
constexpr float W1_SCALE = 32.f, W2_SCALE = 64.f, ACT_SCALE = 4.f;
constexpr float SQC_D = 2.f * 0.42466090014400953f;
constexpr float SQC_M = 2.f * 0.38372760731440503f;

DI int mod_row_of(int row) { const int b = row / TPB, t = row - b * TPB; return t < CTX ? 2 : b; }
DI const float* x_src_row(const float* xin, const float* cin, const float* xbuf, int layer, int row) {
    if (layer > 0) return xbuf + (size_t)row * D;
    const int b = row / TPB, t = row - b * TPB;
    return t < CTX ? cin + ((size_t)b * CTX + t) * D : xin + ((size_t)b * SEQ + (t - CTX)) * D;
}

struct CvtJob { const float* src; bf16* dst; const float* scale; int K, N, ld_dst, nmul, nadd, fp8  ; float wscale; };
DI bool get_job(const Params& p, unsigned char* ws_, int j, CvtJob& J) {
    const int l = j / 56, r = j % 56;
    if (l >= 2) return false;
    J.scale = nullptr; J.nmul = 1; J.nadd = 0; J.fp8 = 0; J.wscale = 1.f;
    if (r == 0) { J.src = p.in[6] + (size_t)l * 1024 * IN_DIM; J.K = 1024; J.N = IN_DIM;
        if (FP8_INPROJ) { J.dst = (bf16*)(ws_ + WS_BT_IN + (size_t)l * ZLD * 1024); J.ld_dst = 1024; J.fp8 = 3; J.wscale = WD_SCALE; }
        else { J.dst = (bf16*)(ws_ + WS_BT_IN) + (size_t)l * ZLD * 1024; J.ld_dst = 1024; } }
    else if (r == 1) { J.src = p.in[20] + (size_t)l * 1024 * 3072; J.K = 1024; J.N = 3072;
        if (FP8_GATE) { J.dst = (bf16*)(ws_ + WS_BT_GATE + (size_t)l * 3072 * 1024); J.ld_dst = 1024; J.fp8 = 3; J.wscale = WD_SCALE; }
        else { J.dst = (bf16*)(ws_ + WS_BT_GATE) + (size_t)l * 3072 * 1024; J.ld_dst = 1024; } }
    else if (r <= 4) { J.src = p.in[17 + (r - 2)] + (size_t)l * 512 * 1024; J.dst = (bf16*)(ws_ + WS_BT_BR) + (size_t)l * 1024 * 1536 + (r - 2) * 512; J.K = 512; J.N = 1024; J.ld_dst = 1536; }
    else if (r == 5) { J.src = p.in[22] + (size_t)l * 1024 * 1024; J.dst = (bf16*)(ws_ + WS_BT_OUT) + (size_t)l * 1024 * 1024; J.K = 1024; J.N = 1024; J.ld_dst = 1024; }
    else if (r == 6) { J.src = p.in[10] + (size_t)l * 256 * 768; J.dst = (bf16*)(ws_ + WS_BT_UQ) + (size_t)l * 768 * 256; J.K = 256; J.N = 768; J.ld_dst = 256; J.scale = p.in[8] + l * 256; }
    else if (r == 7) { J.src = p.in[11] + (size_t)l * 128 * 1024; J.dst = (bf16*)(ws_ + WS_BT_UKV) + (size_t)l * 1024 * 256; J.K = 128; J.N = 1024; J.ld_dst = 256; J.scale = p.in[9] + l * 128; }
    else {
        const int q = r - 8, e = q / 3, w = q % 3;
        unsigned char* m1 = ws_ + WS_BT_M1 + ((size_t)l * NE + e) * 5632 * 1024; unsigned char* m2 = ws_ + WS_BT_M2 + ((size_t)l * NE + e) * 1024 * FF;
        if (w == 0) { J.src = p.in[26] + ((size_t)l * NE + e) * 1024 * FF; J.dst = (bf16*)m1; J.K = 1024; J.N = FF; J.ld_dst = 1024; J.fp8 = 1; J.wscale = W1_SCALE; }
        else if (w == 1) { J.src = p.in[27] + ((size_t)l * NE + e) * 1024 * FF; J.dst = (bf16*)m1; J.K = 1024; J.N = FF; J.ld_dst = 1024; J.fp8 = 2; J.wscale = W1_SCALE; }
        else { J.src = p.in[28] + ((size_t)l * NE + e) * FF * 1024; J.dst = (bf16*)m2; J.K = FF; J.N = 1024; J.ld_dst = FF; J.fp8 = 3; J.wscale = W2_SCALE; }
    }
    return true;
}
DI void cvt_tile(const CvtJob& J, int t, int tn, float* lw, int lane) {
    const int k0 = (t / tn) * 64, n0 = (t % tn) * 64;
    const int r4 = lane >> 4, c4 = (lane & 15) * 4;
    f32x4 v[16];
    const bool full = n0 + 64 <= J.N;
#pragma unroll
    for (int i = 0; i < 16; ++i) {
        const float* sp = J.src + (size_t)(k0 + i * 4 + r4) * J.N + n0 + c4;
        if (full || n0 + c4 + 3 < J.N) v[i] = *(const f32x4*)sp; else v[i] = (f32x4){0.f, 0.f, 0.f, 0.f};
    }
    if (J.scale) {
#pragma unroll
        for (int i = 0; i < 16; ++i) v[i] *= J.scale[k0 + i * 4 + r4];
    }
#pragma unroll
    for (int i = 0; i < 16; ++i) { float* d = lw + (i * 4 + r4) * 65 + c4; d[0] = v[i][0]; d[1] = v[i][1]; d[2] = v[i][2]; d[3] = v[i][3]; }
    asm volatile("s_waitcnt lgkmcnt(0)" ::: "memory");
    const int g = lane & 7, ns = lane >> 3;
#pragma unroll
    for (int nb = 0; nb < 8; ++nb) {
        const int nn = nb * 8 + ns;
        float f[8];
#pragma unroll
        for (int q = 0; q < 8; ++q) f[q] = lw[(g * 8 + q) * 65 + nn];
        if (n0 + nn < J.N) {
            if (J.fp8 == 0) *(bf16x8*)(J.dst + (size_t)((n0 + nn) * J.nmul + J.nadd) * J.ld_dst + k0 + g * 8) = pack8(f);
            else {
                const int nsrc = n0 + nn, nrow = J.fp8 == 3 ? nsrc : (nsrc >> 4) * 32 + (J.fp8 == 2 ? 16 : 0) + (nsrc & 15);
                u32x2 o; o.x = pk4_fp8(f[0] * J.wscale, f[1] * J.wscale, f[2] * J.wscale, f[3] * J.wscale); o.y = pk4_fp8(f[4] * J.wscale, f[5] * J.wscale, f[6] * J.wscale, f[7] * J.wscale);
                *(u32x2*)((unsigned char*)J.dst + (size_t)nrow * J.ld_dst + k0 + g * 8) = o;
            }
        }
    }
    asm volatile("s_waitcnt lgkmcnt(0)" ::: "memory");
}
constexpr int MOE_TILES = 48 * 704;
DI void cvt_moe_tile(const Params& p, unsigned char* ws_, int layer, int G, float* lds, int tid) {
    if (G < MOE_TILES) { CvtJob J; get_job(p, ws_, layer * 56 + 8 + G / 704, J); cvt_tile(J, G % 704, (J.N + 63) / 64, lds + (tid >> 6) * (64 * 65), tid & 63); }
}
DI void phase_cvt(const Params& p, float* lds  , int j0, int j1, int wv0, int wvn, bool fills) {
    unsigned char* const ws_ = lws(p);
    const int tid = ltid();
    if (fills) for (int l = 0; l < 2; ++l) {
        bf16* bi = FP8_INPROJ ? (bf16*)(ws_ + WS_BT_IN + (size_t)l * ZLD * 1024 + (size_t)IN_DIM * 1024) : (bf16*)(ws_ + WS_BT_IN) + (size_t)l * ZLD * 1024 + (size_t)IN_DIM * 1024;
        for (int i = blockIdx.x * NWG_THREADS + tid; i < (ZLD - IN_DIM) * (FP8_INPROJ ? 512 : 1024); i += gridDim.x * NWG_THREADS) bi[i] = 0;
        bf16* bk = (bf16*)(ws_ + WS_BT_UKV) + (size_t)l * 1024 * 256;
        for (int i = blockIdx.x * NWG_THREADS + tid; i < 1024 * 128; i += gridDim.x * NWG_THREADS) bk[(size_t)(i >> 7) * 256 + 128 + (i & 127)] = 0;
    }
    const int lane = tid & 63;
    float* lw = lds + (tid >> 6) * (64 * 65);
    int gbase = 0;
    for (int j = j0; j < j1; ++j) {
        CvtJob J; get_job(p, ws_, j, J);
        const int tk = J.K / 64, tn = (J.N + 63) / 64, nt = tk * tn;
        int t0 = (wv0 + (tid >> 6) - gbase) % wvn; if (t0 < 0) t0 += wvn;
        gbase = (gbase + nt) % wvn;
        for (int t = t0; t < nt; t += wvn) cvt_tile(J, t, tn, lw, lane);
    }
    __syncthreads();
}

DI void phase_mod(const Params& p, float* lds) {
    unsigned char* const ws_ = lws(p);
    const int tid = ltid();
    float* sc = lds; float* red = lds + 3 * 1024;
    for (int i = tid; i < 3 * 1024; i += NWG_THREADS) { const int r = i >> 10, k = i & 1023; const float c = r < 2 ? p.in[1][r * 1024 + k] : p.in[3][k]; sc[i] = c * sigmoidf_(c); }
    __syncthreads();
    const int kg = tid >> 6, cl = tid & 63;
    for (int it = blockIdx.x; it < 2 * 96; it += gridDim.x) {
        const int l = it / 96, j = (it % 96) * 64 + cl;
        const float* w = p.in[4] + (size_t)l * 1024 * 6144;
        float a0 = 0.f, a1 = 0.f, a2 = 0.f;
        for (int k = kg * 128; k < kg * 128 + 128; ++k) { const float wv = w[(size_t)k * 6144 + j]; a0 += sc[k] * wv; a1 += sc[1024 + k] * wv; a2 += sc[2048 + k] * wv; }
        red[(kg * 3 + 0) * 64 + cl] = a0; red[(kg * 3 + 1) * 64 + cl] = a1; red[(kg * 3 + 2) * 64 + cl] = a2;
        __syncthreads();
        if (tid < 192) {
            const int r = tid >> 6; float s = p.in[5][l * 6144 + j];
            for (int g = 0; g < 8; ++g) s += red[(g * 3 + r) * 64 + cl];
            ((float*)(ws_ + WS_MOD))[((size_t)l * 3 + r) * 6144 + j] = s;
        }
        __syncthreads();
    }
}
DI void sincos_d(double a, float& c, float& s) {
    const double TWO_PI = 6.283185307179586476925;
    a -= TWO_PI * rint(a / TWO_PI);
    const double a2 = a * a; double ts = a, tc = 1.0, ss = a, cs = 1.0;
    for (int i = 1; i <= 15; ++i) { tc *= -a2 / ((2 * i - 1) * (2 * i)); cs += tc; ts *= -a2 / ((2 * i) * (2 * i + 1)); ss += ts; }
    c = (float)cs; s = (float)ss;
}
DI void phase_tables(const Params& p) {
    unsigned char* const ws_ = lws(p);
    const int tid = ltid();
    const int gt = blockIdx.x * NWG_THREADS + tid, ng = gridDim.x * NWG_THREADS;
    float* rope = (float*)(ws_ + WS_ROPE);
    for (int i = gt; i < 256 * 8 + 64 * 8 + 256 * 16 + 64 * 16; i += ng) {
        int pos, f, nf; float* dst;
        if (i < 2048) { pos = i / 8; f = i % 8; nf = 8; dst = rope + ROPE_MROW + i * 2; }
        else if (i < 2560) { const int q = i - 2048; pos = q / 8; f = q % 8; nf = 8; dst = rope + ROPE_MCOL + q * 2; }
        else if (i < 2560 + 4096) { const int q = i - 2560; pos = q / 16; f = q % 16; nf = 16; dst = rope + ROPE_DROW + q * 2; }
        else { const int q = i - 6656; pos = q / 16; f = q % 16; nf = 16; dst = rope + ROPE_DCOL + q * 2; }
        const float inv = powf(10000.0f, -(float)f / (float)nf);
        const float ang = (float)pos * inv;
        float c, s; sincos_d((double)ang, c, s); dst[0] = c; dst[1] = s;
    }
    float* lam = (float*)(ws_ + WS_LAM);
    if (gt < 2) {
        const int l = gt; float s1 = 0.f, s2 = 0.f;
        for (int i = 0; i < 64; ++i) { s1 += p.in[12][l * 64 + i] * p.in[13][l * 64 + i]; s2 += p.in[14][l * 64 + i] * p.in[15][l * 64 + i]; }
        const float li = l == 0 ? 0.2f : (float)(0.8 - 0.6 * 0.74081822068171786607);
        lam[l] = expf(s1) - expf(s2) + li; lam[2 + l] = li;
    }
    if (gt >= 64 && gt < 64 + 16) {
        const int q = gt - 64; const float* r = p.in[7] + (size_t)q * 15 * 31; float m = r[0];
        for (int i = 1; i < 15 * 31; ++i) m = fmaxf(m, r[i]);
        lam[4 + q] = m * LOG2E;
    }
    float* bias = (float*)(ws_ + WS_BIAS);
    for (int i = gt; i < 2 * 8 * 15 * 4 * 1024; i += ng) {
        const int reg = i & 15, lane = (i >> 4) & 63, cg = (i >> 10) & 1, qh = (i >> 11) & 1; const int q = i >> 12; const int ro = q % 15, lh = q / 15;
        const int n = lane & 31, hh = lane >> 5, kcl = (reg & 3) + 8 * (reg >> 2) + 4 * hh;
        const int c = qh * 32 + n, kc = cg * 32 + kcl;
        int cs = c - 8; cs = cs < 0 ? 0 : (cs > 48 ? 48 : cs);
        float v = -1e30f;
        if (kc >= cs && kc < cs + 16) v = p.in[7][((size_t)lh * 15 + ro) * 31 + (kc - c + 15)] * LOG2E;
        bias[i] = v;
    }
}

DI void ln_stats16(const f32x4 (&v)[4], float& mu, float& rstd) {
    float s = 0.f;
#pragma unroll
    for (int i = 0; i < 4; ++i) s += (v[i][0] + v[i][1]) + (v[i][2] + v[i][3]);
    mu = wave_sum(s) * (1.f / 1024.f);
    float q = 0.f;
#pragma unroll
    for (int i = 0; i < 4; ++i) { const f32x4 d = v[i] - mu; q += (d[0] * d[0] + d[1] * d[1]) + (d[2] * d[2] + d[3] * d[3]); }
    rstd = rsqrtf(wave_sum(q) * (1.f / 1024.f) + EPS);
}
DI void phase_lnmod1(const Params& p, int layer) {
    unsigned char* const ws_ = lws(p);
    const int tid = ltid();
    const int lane = tid & 63;
    const float* mod = (const float*)(ws_ + WS_MOD) + (size_t)layer * 3 * 6144;
    bf16* H = (bf16*)(ws_ + WS_H);
    for (int row = gwave(tid); row < MROWS; row += nwaves()) {
        const float* xr = x_src_row(p.in[0], p.in[2], (const float*)(ws_ + WS_X), layer, row);
        f32x4 v[4];
#pragma unroll
        for (int i = 0; i < 4; ++i) v[i] = *(const f32x4*)(xr + i * 256 + lane * 4);
        float mu, rstd; ln_stats16(v, mu, rstd);
        const float* mr = mod + (size_t)mod_row_of(row) * 6144;
#pragma unroll
        for (int i = 0; i < 4; ++i) {
            const int c = i * 256 + lane * 4;
            const f32x4 sh = *(const f32x4*)(mr + c), sc = *(const f32x4*)(mr + 1024 + c);
            const f32x4 y = (v[i] - mu) * rstd * (sc + 1.f) + sh;
            if (FP8_INPROJ && FP8_GATE) *(unsigned*)((unsigned char*)H + (size_t)row * D + c) = pk4_fp8(y[0], y[1], y[2], y[3]);
            else { u32x2 o; o.x = pk2(y[0], y[1]); o.y = pk2(y[2], y[3]); *(u32x2*)(H + (size_t)row * D + c) = o; }
        }
    }
}

struct RowMapId { DI int operator()(int tm) const { return tm * 32; } };
struct RowMapCtx { DI int operator()(int tm) const { return (tm >> 3) * TPB + (tm & 7) * 32; } };
struct RowMapOff { int off; DI int operator()(int tm) const { return off + tm * 32; } };
template <class Epi, class BSel, class RowMap = RowMapId, bool FP8 = false>
DI void sgemm_phase(const bf16* A, int lda, const bf16* Bt, int ldb, int M, int N, int K, const Epi& E, const BSel& bsel, const RowMap& rmap = RowMap(), const int* gidx = nullptr) {
    const int tid = ltid();
    const int lane = tid & 63, r = lane & 31, h = lane >> 5;
    const int tnn = N / 32, nt = (M / 32) * tnn, nch = K / 64;
    for (int t = gwave(tid); t < nt; t += nwaves()) {
        const int tm = t / tnn, tn = t % tnn;
        const int row0 = rmap(tm);
        const bf16* Ab = A + (size_t)(gidx ? gidx[row0 + r] : row0 + r) * lda + 32 * h;
        const bf16* Bb = Bt + bsel(row0) + (size_t)(tn * 32 + r) * ldb + 32 * h;
        f32x16 acc;
#pragma unroll
        for (int q = 0; q < 16; ++q) acc[q] = 0.f;
        i32x8 a[4][2], b[4][2];
#define SG_LD8(dst_, ptr_) do { const u32x4 x_ = *(const u32x4*)(ptr_), y_ = *(const u32x4*)((ptr_) + 8); \
            dst_ = (i32x8){(int)x_[0], (int)x_[1], (int)x_[2], (int)x_[3], (int)y_[0], (int)y_[1], (int)y_[2], (int)y_[3]}; } while (0)
#define SG_LO(v_) __builtin_bit_cast(bf16x8, __builtin_shufflevector(v_, v_, 0, 1, 2, 3))
#define SG_HI(v_) __builtin_bit_cast(bf16x8, __builtin_shufflevector(v_, v_, 4, 5, 6, 7))
#define SG_LOAD(slot_, ch_) do { const int c_ = (ch_) < nch ? (ch_) : nch - 1; _Pragma("unroll") for (int s_ = 0; s_ < 2; ++s_) { \
            SG_LD8(a[slot_][s_], Ab + c_ * 64 + s_ * 16); SG_LD8(b[slot_][s_], Bb + c_ * 64 + s_ * 16); } } while (0)
#define SG_MMA(slot_) do { _Pragma("unroll") for (int s_ = 0; s_ < 2; ++s_) { if constexpr (FP8) acc = MFMA8(b[slot_][s_], a[slot_][s_], acc, 0, 0); \
            else { acc = MFMA32(SG_LO(b[slot_][s_]), SG_LO(a[slot_][s_]), acc); acc = MFMA32(SG_HI(b[slot_][s_]), SG_HI(a[slot_][s_]), acc); } } } while (0)
        SG_LOAD(0, 0); SG_LOAD(1, 1); SG_LOAD(2, 2); SG_LOAD(3, 3);
#pragma unroll 1
        for (int c = 0; c < nch; c += 4) {
            SG_MMA(0); SG_LOAD(0, c + 4);
            if (c + 1 < nch) { SG_MMA(1); SG_LOAD(1, c + 5); }
            if (c + 2 < nch) { SG_MMA(2); SG_LOAD(2, c + 6); }
            if (c + 3 < nch) { SG_MMA(3); SG_LOAD(3, c + 7); }
        }
#undef SG_LOAD
#undef SG_MMA
#undef SG_LD8
#undef SG_LO
#undef SG_HI
        if constexpr (Epi::PAIR) {
#pragma unroll
            for (int g = 0; g < 2; ++g) {
                const f32x4 v0 = {acc[4 * g], acc[4 * g + 1], acc[4 * g + 2], acc[4 * g + 3]};
                const f32x4 v1 = {acc[4 * g + 8], acc[4 * g + 9], acc[4 * g + 10], acc[4 * g + 11]};
                E.store_pair(row0 + r, tn * 16 + 8 * g + 4 * h, v0, v1);
            }
        } else {
#pragma unroll
            for (int g = 0; g < 4; ++g) {
                const f32x4 v = {acc[4 * g], acc[4 * g + 1], acc[4 * g + 2], acc[4 * g + 3]};
                E.store4(row0 + r, tn * 32 + 8 * g + 4 * h, v);
            }
        }
    }
}
struct BSelNone { DI size_t operator()(int) const { return 0; } };
struct BSelMoe { size_t estride; DI size_t operator()(int s) const { const int e = s < NSLOT_L ? s / (NB * CAP_L) : (s - NSLOT_L) / (NB * CAP_C); return (size_t)e * estride; } };

struct EpiStoreBf16 { static constexpr bool PAIR = false, BATCH = false; bf16* C; int ldc; float sc; DI void store4(int r, int c, f32x4 v) const { v *= sc; u32x2 o; o.x = pk2(v[0], v[1]); o.y = pk2(v[2], v[3]); *(u32x2*)(C + (size_t)r * ldc + c) = o; } };
struct EpiGate { static constexpr bool PAIR = false, BATCH = true; bf16* G; const float* bias; float sc;
    struct Pre { f32x4 b; };
    DI Pre load(int, int c) const { Pre p; p.b = *(const f32x4*)(bias + c); return p; }
    DI void apply(int r, int c, f32x4 v, const Pre& p) const { v = v * sc + p.b; u32x2 o; o.x = pk2(sigmoidf_(v[0]), sigmoidf_(v[1])); o.y = pk2(sigmoidf_(v[2]), sigmoidf_(v[3])); *(u32x2*)(G + (size_t)r * 3072 + c) = o; }
    DI void store4(int r, int c, f32x4 v) const { apply(r, c, v, load(r, c)); } };
template <int I> struct EpiMerge { static constexpr bool PAIR = false, BATCH = true; const bf16* G; bf16* Mp  ; bf16* Mb;
    struct Pre { u32x2 g; u32x2 m; };
    DI Pre load(int r, int c) const { Pre p; p.g = *(const u32x2*)(G + (size_t)r * 3072 + I * 1024 + c); if (I > 0) p.m = *(const u32x2*)(Mp + (size_t)r * D + c); else p.m = (u32x2){0u, 0u}; return p; }
    DI void apply(int r, int c, f32x4 v, const Pre& p) const {
        f32x4 m = {lo_f(p.g.x) * v[0], hi_f(p.g.x) * v[1], lo_f(p.g.y) * v[2], hi_f(p.g.y) * v[3]};
        if (I > 0) m += (f32x4){lo_f(p.m.x), hi_f(p.m.x), lo_f(p.m.y), hi_f(p.m.y)};
        u32x2 o; o.x = pk2(m[0], m[1]); o.y = pk2(m[2], m[3]);
        *(u32x2*)((I < 2 ? Mp : Mb) + (size_t)r * D + c) = o; }
    DI void store4(int r, int c, f32x4 v) const { apply(r, c, v, load(r, c)); } };
struct EpiOut { static constexpr bool PAIR = false, BATCH = true; const float* xin; const float* cin; int layer; const float* mod; float* X;
    struct Pre { f32x4 g1, xo; };
    DI Pre load(int r, int c) const { Pre p; p.g1 = *(const f32x4*)(mod + (size_t)mod_row_of(r) * 6144 + 2048 + c); p.xo = *(const f32x4*)(x_src_row(xin, cin, X, layer, r) + c); return p; }
    DI void apply(int r, int c, f32x4 v, const Pre& p) const { *(f32x4*)(X + (size_t)r * D + c) = p.xo * ALPHA + p.g1 * v; }
    DI void store4(int r, int c, f32x4 v) const { apply(r, c, v, load(r, c)); } };
struct EpiAct { static constexpr bool PAIR = true; unsigned char* Act;
    DI void store_pair(int r, int c, f32x4 g, f32x4 u) const {
        float a[4];
#pragma unroll
        for (int i = 0; i < 4; ++i) { const float gg = g[i] * (1.f / W1_SCALE), uu = u[i] * (1.f / W1_SCALE); a[i] = fminf(fmaxf(gg * sigmoidf_(gg) * uu * ACT_SCALE, -440.f), 440.f); }
        *(unsigned*)(Act + (size_t)r * FF + c) = pk4_fp8(a[0], a[1], a[2], a[3]); } };
struct EpiDown { static constexpr bool PAIR = false, BATCH = true; bf16* Y; const float* w;
    struct Pre { float g; };
    DI Pre load(int r, int) const { Pre p; p.g = w[r]; return p; }
    DI void apply(int r, int c, f32x4 v, const Pre& p) const { const float g = p.g * (1.f / (W2_SCALE * ACT_SCALE)); u32x2 o; o.x = pk2(v[0] * g, v[1] * g); o.y = pk2(v[2] * g, v[3] * g); *(u32x2*)(Y + (size_t)r * D + c) = o; }
    DI void store4(int r, int c, f32x4 v) const { apply(r, c, v, load(r, c)); } };

DI void kmax_update(unsigned* slot, float n2half, int tid) {
    float n2 = n2half + __shfl_xor(n2half, 32, tid);
    n2 = wave_max(n2);
    if ((tid & 63) == 0) atomicMax(slot, __float_as_uint(n2));
}
DI void phase_prep1(const Params& p, int layer) {
    unsigned char* const ws_ = lws(p);
    const int tid = ltid();
    const int lane = tid & 63, n = lane & 31, hh = lane >> 5;
    const bf16* Z = (const bf16*)(ws_ + R_Z);
    unsigned* kmax = (unsigned*)(ws_ + WS_KMAX) + layer * 48;
    const float* rope = (const float*)(ws_ + WS_ROPE);
    for (int it = gwave(tid); it < NKG * 19; it += nwaves()) {
        const int kg = it / 19, sub = it - kg * 19, part = sub < 8 ? 0 : (sub < 16 ? 1 : (sub < 18 ? 2 : 3));
        const int b = kg / KGPB, kgl = kg - b * KGPB;
        const int row = kg * 32 + n, t = kgl * 32 + n;
        const bool lat = t >= CTX; const int tl = t - CTX, gr = tl >> 6, gc = tl & 63;
        const bf16* zr = Z + (size_t)row * ZLD;
        if (part == 0) {
            const int h = sub;
            bf16* Q = (bf16*)(ws_ + R_QNA) + (size_t)row * 512 + h * 64 + hh * 32;
            const float qs = 0.125f * LOG2E;
            bf16x8 qv[4], kv[4], vv[4];
#pragma unroll
            for (int i = 0; i < 4; ++i) qv[i] = *(const bf16x8*)(zr + ZO_AQ + h * 64 + hh * 32 + i * 8);
#pragma unroll
            for (int ks = 0; ks < 4; ++ks) kv[ks] = *(const bf16x8*)(zr + ZO_AK + h * 64 + ks * 16 + 8 * hh);
#pragma unroll
            for (int s = 0; s < 2; ++s)
#pragma unroll
                for (int dvt = 0; dvt < 2; ++dvt) {
#pragma unroll
                    for (int j = 0; j < 8; ++j) { const int key = 16 * s + 8 * (j >> 2) + 4 * hh + (j & 3); vv[s * 2 + dvt][j] = (short)Z[(size_t)(kg * 32 + key) * ZLD + ZO_AV + h * 64 + dvt * 32 + n]; }
                }
#pragma unroll
            for (int i = 0; i < 4; ++i) *(bf16x8*)(Q + i * 8) = scale8(qv[i], qs);
            {
                bf16* Kf = (bf16*)(ws_ + R_KFNA) + ((size_t)(b * 8 + h) * KGPB + kgl) * 2048 + lane * 8;
                float n2 = 0.f;
#pragma unroll
                for (int ks = 0; ks < 4; ++ks) { n2 += sumsq8p(kv[ks]); *(bf16x8*)(Kf + ks * 512) = kv[ks]; }
                kmax_update(kmax + 0 * 16 + b * 8 + h, n2, tid);
                bf16* Vf = (bf16*)(ws_ + R_VFNA) + ((size_t)(b * 8 + h) * KGPB + kgl) * 2048 + lane * 8;
#pragma unroll
                for (int q = 0; q < 4; ++q) *(bf16x8*)(Vf + q * 512) = vv[q];
            }
        } else if (part == 1) {
            const float* rt = hh == 0 ? rope + ROPE_DROW + (size_t)gr * 32 : rope + ROPE_DCOL + (size_t)gc * 32;
            float* qn = (float*)(ws_ + WS_QN);
            { const int qk = (sub - 8) >> 2, sp = ((sub - 8) & 3) * 2;
                bf16x8 raw[2][4];
#pragma unroll
                for (int u = 0; u < 2; ++u)
#pragma unroll
                    for (int i = 0; i < 4; ++i) raw[u][i] = *(const bf16x8*)(zr + (qk ? ZO_DK : ZO_DQ) + (sp + u) * 64 + 32 * hh + i * 8);
                float rc[16], rs[16];
                if (lat) {
#pragma unroll
                    for (int i = 0; i < 16; ++i) { rc[i] = rt[i * 2]; rs[i] = rt[i * 2 + 1]; }
                }
#pragma unroll
                for (int u = 0; u < 2; ++u) { const int s = sp + u;
                    float f[32];
#pragma unroll
                    for (int i = 0; i < 4; ++i) { float t8[8]; unpack8(raw[u][i], t8);
#pragma unroll
                        for (int j = 0; j < 8; ++j) f[i * 8 + j] = t8[j]; }
                    if (lat) {
#pragma unroll
                        for (int i = 0; i < 16; ++i) { const float c = rc[i], sn = rs[i], a = f[i], bb = f[16 + i]; f[i] = a * c - bb * sn; f[16 + i] = a * sn + bb * c; }
                    }
                    float n2 = 0.f;
#pragma unroll
                    for (int i = 0; i < 32; ++i) { f[i] *= SQC_D; n2 += f[i] * f[i]; }
                    const u32x4 p0 = pk16_fp8(f), p1 = pk16_fp8(f + 16);
                    if (qk == 0) {
                        unsigned char* Q = ws_ + R_QD + (size_t)row * 512 + s * 64 + 32 * hh;
                        *(u32x4*)Q = p0; *(u32x4*)(Q + 16) = p1;
                        const float nt = n2 + __shfl_xor(n2, 32);
                        if (hh == 0) qn[(size_t)row * 8 + s] = sqrtf(nt);
                    } else {
                        unsigned char* Kf = ws_ + R_KFD + ((size_t)(b * 8 + s) * KGPB + kgl) * 2048 + lane * 16;
                        *(u32x4*)Kf = p0; *(u32x4*)(Kf + 1024) = p1;
                        kmax_update(kmax + 1 * 16 + b * 8 + s, n2, tid);
                    }
                } }
        } else if (part == 2) {
            const int kg2 = kg >> 1, kg2l = kgl >> 1;
            { const int hq = sub - 16;
                const int h4 = (kg & 1) * 2 + hq;
                unsigned char* Vf = ws_ + R_VFD + ((size_t)(b * 4 + h4) * (KGPB / 2) + kg2l) * 8192 + lane * 16;
#pragma unroll 1
                for (int dvt = 0; dvt < 4; ++dvt) {
                    float f[32];
#pragma unroll
                    for (int j = 0; j < 32; ++j) f[j] = bf2f(Z[(size_t)(kg2 * 64 + kappa(hh, j)) * ZLD + ZO_DV + h4 * 128 + dvt * 32 + n]);
                    *(u32x4*)(Vf + dvt * 2048) = pk16_fp8(f); *(u32x4*)(Vf + dvt * 2048 + 1024) = pk16_fp8(f + 16);
                }
            }
        } else {
            float sq = 0.f, sk = 0.f;
#pragma unroll
            for (int i = 0; i < 16; ++i) sq += sumsq8p(*(const bf16x8*)(zr + ZO_CQ + hh * 128 + i * 8));
#pragma unroll
            for (int i = 0; i < 8; ++i) sk += sumsq8p(*(const bf16x8*)(zr + ZO_CKV + hh * 64 + i * 8));
            sq += __shfl_xor(sq, 32); sk += __shfl_xor(sk, 32);
            float* ir = (float*)(ws_ + WS_INVRMS) + (size_t)row * 2;
            if (hh == 0) { ir[0] = rsqrtf(sq * (1.f / 256.f) + EPS); ir[1] = rsqrtf(sk * (1.f / 128.f) + EPS); }
            float x1[8], x2[8];
            unpack8(*(const bf16x8*)(zr + ZO_KR + hh * 16), x1); unpack8(*(const bf16x8*)(zr + ZO_KR + hh * 16 + 8), x2);
            if (lat) {
                const float* tb = hh == 0 ? rope + ROPE_MROW + (size_t)gr * 16 : rope + ROPE_MCOL + (size_t)gc * 16;
#pragma unroll
                for (int j = 0; j < 8; ++j) { const float c = tb[j * 2], s = tb[j * 2 + 1], a = x1[j], bb = x2[j]; x1[j] = a * c - bb * s; x2[j] = a * s + bb * c; }
            }
            float* kr = (float*)(ws_ + WS_KROPE) + (size_t)row * 32 + hh * 16;
#pragma unroll
            for (int j = 0; j < 8; ++j) { kr[j] = x1[j]; kr[8 + j] = x2[j]; }
        }
    }
}

DI void phase_prep2(const Params& p, int layer) {
    unsigned char* const ws_ = lws(p);
    const int tid = ltid();
    const int lane = tid & 63, n = lane & 31, hh = lane >> 5;
    const bf16* QR = (const bf16*)(ws_ + R_QRAW); const bf16* KV = (const bf16*)(ws_ + R_KVRAW);
    const float* IR = (const float*)(ws_ + WS_INVRMS); const float* KR = (const float*)(ws_ + WS_KROPE);
    unsigned* kmax = (unsigned*)(ws_ + WS_KMAX) + layer * 48 + 2 * 16;
    const float* rope = (const float*)(ws_ + WS_ROPE);
    for (int it = gwave(tid); it < NKG * 16; it += nwaves()) {
        const int kg = it >> 4, sub = it & 15, part = sub < 4 ? 0 : (sub < 12 ? 1 : 2);
        const int b = kg / KGPB, kgl = kg - b * KGPB;
        const int row = kg * 32 + n, t = kgl * 32 + n;
        const bool lat = t >= CTX; const int tl = t - CTX, gr = tl >> 6, gc = tl & 63;
        if (part == 0) {
            const float qs = IR[(size_t)row * 2] * SQC_M;
            const float* rr = rope + ROPE_MROW + (size_t)gr * 16; const float* rc = rope + ROPE_MCOL + (size_t)gc * 16;
            float* qn = (float*)(ws_ + WS_QN) + (size_t)MROWS * 8;
            { const int hq = sub;
                const int h = hh * 4 + hq;
                const bf16* src = QR + (size_t)row * 768 + h * 96; unsigned char* dst = ws_ + R_QMLA + (size_t)row * 1024 + h * 128;
                float f[96];
#pragma unroll
                for (int i = 0; i < 12; ++i) { float t8[8]; unpack8(*(const bf16x8*)(src + i * 8), t8);
#pragma unroll
                    for (int j = 0; j < 8; ++j) f[i * 8 + j] = t8[j]; }
                if (lat) {
#pragma unroll
                    for (int j = 0; j < 8; ++j) {
                        const float c0 = rr[j * 2], s0 = rr[j * 2 + 1], c1 = rc[j * 2], s1 = rc[j * 2 + 1];
                        const float a = f[64 + j], bb = f[72 + j], c = f[80 + j], d = f[88 + j];
                        f[64 + j] = a * c0 - bb * s0; f[72 + j] = a * s0 + bb * c0; f[80 + j] = c * c1 - d * s1; f[88 + j] = c * s1 + d * c1;
                    }
                }
                float n2 = 0.f;
#pragma unroll
                for (int i = 0; i < 96; ++i) { f[i] *= qs; n2 += f[i] * f[i]; }
#pragma unroll
                for (int i = 0; i < 6; ++i) *(u32x4*)(dst + i * 16) = pk16_fp8(f + i * 16);
                *(u32x4*)(dst + 96) = (u32x4){0u, 0u, 0u, 0u}; *(u32x4*)(dst + 112) = (u32x4){0u, 0u, 0u, 0u};
                qn[(size_t)row * 8 + h] = sqrtf(n2);
            }
        } else if (part == 1) {
            const float ks_ = IR[(size_t)row * 2 + 1] * SQC_M;
            float fr[32]; float nr = 0.f;
#pragma unroll
            for (int i = 0; i < 32; ++i) { fr[i] = hh == 0 ? KR[(size_t)row * 32 + i] * SQC_M : 0.f; nr += fr[i] * fr[i]; }
            const u32x4 r0 = pk16_fp8(fr), r1 = pk16_fp8(fr + 16);
            { const int h = sub - 4;
                unsigned char* Kf = ws_ + R_KFMLA + ((size_t)(b * 8 + h) * KGPB + kgl) * 4096 + lane * 16;
                float f[32]; float n2 = nr;
#pragma unroll
                for (int i = 0; i < 4; ++i) { float t8[8]; unpack8(*(const bf16x8*)(KV + (size_t)row * 1024 + h * 128 + 32 * hh + i * 8), t8);
#pragma unroll
                    for (int j = 0; j < 8; ++j) { f[i * 8 + j] = t8[j] * ks_; n2 += f[i * 8 + j] * f[i * 8 + j]; } }
                *(u32x4*)Kf = pk16_fp8(f); *(u32x4*)(Kf + 1024) = pk16_fp8(f + 16);
                *(u32x4*)(Kf + 2048) = r0; *(u32x4*)(Kf + 3072) = r1;
                kmax_update(kmax + b * 8 + h, n2, tid);
            }
        } else {
            const int kg2 = kg >> 1, kg2l = kgl >> 1;
            float sc[32];
#pragma unroll
            for (int j = 0; j < 32; ++j) sc[j] = IR[(size_t)(kg2 * 64 + kappa(hh, j)) * 2 + 1];
            { const int hq = sub - 12;
                const int h = (kg & 1) * 4 + hq;
                unsigned char* Vf = ws_ + R_VFMLA + ((size_t)(b * 8 + h) * (KGPB / 2) + kg2l) * 4096 + lane * 16;
#pragma unroll 1
                for (int dvt = 0; dvt < 2; ++dvt) {
                    float f[32];
#pragma unroll
                    for (int j = 0; j < 32; ++j) f[j] = bf2f(KV[(size_t)(kg2 * 64 + kappa(hh, j)) * 1024 + h * 128 + 64 + dvt * 32 + n]) * sc[j];
                    *(u32x4*)(Vf + dvt * 2048) = pk16_fp8(f); *(u32x4*)(Vf + dvt * 2048 + 1024) = pk16_fp8(f + 16);
                }
            }
        }
    }
}

template <int DQK, int DV, bool NA>
DI void attn_wave(const bf16* Q  , const bf16* Kf, const bf16* Vf, int kg0, int kg1, float kmax2,
                  bf16* O  ,
                  const float* bias  , float bmax, int gr, int qh) {
    const int tid = ltid();
    constexpr int NKS = DQK / 16, NDT = DV / 32, KSTR = NKS * 512, VSTR = 2 * NDT * 512;
    const int lane = tid & 63, hh = lane >> 5;
    bf16x8 qf[NKS]; float qn = 0.f;
#pragma unroll
    for (int ks = 0; ks < NKS; ++ks) { qf[ks] = *(const bf16x8*)(Q + ks * 16 + 8 * hh); qn += sumsq8p(qf[ks]); }
    qn += __shfl_xor(qn, 32);
    const float m = sqrtf(qn) * sqrtf(kmax2) * 1.0001f + (NA ? fmaxf(bmax, 0.f) : 0.f);
    f32x16 cinit;
#pragma unroll
    for (int i = 0; i < 16; ++i) cinit[i] = -m;
    f32x16 o[NDT];
#pragma unroll
    for (int d = 0; d < NDT; ++d)
#pragma unroll
        for (int i = 0; i < 16; ++i) o[d][i] = 0.f;
    float lsum = 0.f;
    int rs = 0;
    if (NA) { rs = gr - 4; rs = rs < 0 ? 0 : (rs > 248 ? 248 : rs); }
    const int nsteps = NA ? 24 : (kg1 - kg0);
    auto kg_of = [&](int st) -> int { if (!NA) return kg0 + st; return st < 8 ? st : 8 + (rs + ((st - 8) >> 1)) * 2 + ((st - 8) & 1); };
    bf16x8 kf[NKS], vf[2 * NDT];
    { const int kg = kg_of(0);
#pragma unroll
      for (int ks = 0; ks < NKS; ++ks) kf[ks] = *(const bf16x8*)(Kf + (size_t)kg * KSTR + ks * 512 + lane * 8);
#pragma unroll
      for (int i = 0; i < 2 * NDT; ++i) vf[i] = *(const bf16x8*)(Vf + (size_t)kg * VSTR + i * 512 + lane * 8); }
    f32x4 bc[4];
#pragma unroll
    for (int q = 0; q < 4; ++q) bc[q] = (f32x4){0.f, 0.f, 0.f, 0.f};
#pragma unroll 1
    for (int st = 0; st < nsteps; ++st) {
        bf16x8 kn[NKS], vn[2 * NDT]; f32x4 bn[4];
        { const int sn = st + 1 < nsteps ? st + 1 : st; const int kg = kg_of(sn);
#pragma unroll
          for (int ks = 0; ks < NKS; ++ks) kn[ks] = *(const bf16x8*)(Kf + (size_t)kg * KSTR + ks * 512 + lane * 8);
#pragma unroll
          for (int i = 0; i < 2 * NDT; ++i) vn[i] = *(const bf16x8*)(Vf + (size_t)kg * VSTR + i * 512 + lane * 8);
          if (NA && sn >= 8) {
              const int i = (sn - 8) >> 1, cg = (sn - 8) & 1, ro = rs + i - gr + 7;
              const float* bt = bias + ((size_t)(ro * 2 + qh) * 2 + cg) * 1024 + lane * 16;
#pragma unroll
              for (int q = 0; q < 4; ++q) bn[q] = *(const f32x4*)(bt + q * 4);
          } else {
#pragma unroll
              for (int q = 0; q < 4; ++q) bn[q] = (f32x4){0.f, 0.f, 0.f, 0.f};
          } }
        f32x16 s = cinit;
        if (NA && st >= 8) {
#pragma unroll
            for (int q = 0; q < 4; ++q) { s[4 * q] += bc[q][0]; s[4 * q + 1] += bc[q][1]; s[4 * q + 2] += bc[q][2]; s[4 * q + 3] += bc[q][3]; }
        }
#pragma unroll
        for (int ks = 0; ks < NKS; ++ks) s = MFMA32(kf[ks], qf[ks], s);
        unsigned pp[8];
#pragma unroll
        for (int i = 0; i < 8; ++i) { const float p0 = __builtin_amdgcn_exp2f(s[2 * i]), p1 = __builtin_amdgcn_exp2f(s[2 * i + 1]); lsum += p0 + p1; pp[i] = pk2(p0, p1); }
        const u32x4 u0 = {pp[0], pp[1], pp[2], pp[3]}, u1 = {pp[4], pp[5], pp[6], pp[7]};
        const bf16x8 pf0 = __builtin_bit_cast(bf16x8, u0), pf1 = __builtin_bit_cast(bf16x8, u1);
#pragma unroll
        for (int d = 0; d < NDT; ++d) { o[d] = MFMA32(vf[d], pf0, o[d]); o[d] = MFMA32(vf[NDT + d], pf1, o[d]); }
#pragma unroll
        for (int ks = 0; ks < NKS; ++ks) kf[ks] = kn[ks];
#pragma unroll
        for (int i = 0; i < 2 * NDT; ++i) vf[i] = vn[i];
#pragma unroll
        for (int q = 0; q < 4; ++q) bc[q] = bn[q];
    }
    lsum += __shfl_xor(lsum, 32);
    const float inv = 1.f / lsum;
#pragma unroll
    for (int d = 0; d < NDT; ++d)
#pragma unroll
        for (int g = 0; g < 4; ++g) {
            u32x2 w; w.x = pk2(o[d][4 * g] * inv, o[d][4 * g + 1] * inv); w.y = pk2(o[d][4 * g + 2] * inv, o[d][4 * g + 3] * inv);
            *(u32x2*)(O + d * 32 + 8 * g + 4 * hh) = w;
        }
}


#define LAS3 __attribute__((address_space(3)))
template <int DQK, int DV, int SKG>
DI void attn_block(LAS3 unsigned char* lds, const bf16* Q, const bf16* Kf, const bf16* Vf, int nst, float kmax2, bf16* O, int tid) {
    constexpr int NKS = DQK / 16, NDT = DV / 32, KCH = NKS, VCH = 2 * NDT, SCH = SKG * (KCH + VCH), CPW = SCH / 8, SBYTES = SCH * 1024;
    static_assert(SCH % 8 == 0 && 3 * SBYTES <= 131072, "stage geometry");
    const int lane = tid & 63, hh = lane >> 5, w = __builtin_amdgcn_readfirstlane(tid >> 6);
    bf16x8 qf[NKS]; float qn = 0.f;
#pragma unroll
    for (int ks = 0; ks < NKS; ++ks) { qf[ks] = *(const bf16x8*)(Q + ks * 16 + 8 * hh); qn += sumsq8p(qf[ks]); }
    qn += __shfl_xor(qn, 32);
    const float m = sqrtf(qn) * sqrtf(kmax2) * 1.0001f;
    f32x16 cinit;
#pragma unroll
    for (int i = 0; i < 16; ++i) cinit[i] = -m;
    f32x16 o[NDT];
#pragma unroll
    for (int d = 0; d < NDT; ++d)
#pragma unroll
        for (int i = 0; i < 16; ++i) o[d][i] = 0.f;
    float lsum = 0.f;
#define ATT_ISSUE(st_, buf_) do { _Pragma("unroll") for (int i_ = 0; i_ < CPW; ++i_) { const int c_ = w * CPW + i_; \
        const bf16* src_ = c_ < SKG * KCH ? Kf + ((size_t)(st_) * (SKG * KCH) + c_) * 512 : Vf + ((size_t)(st_) * (SKG * VCH) + (c_ - SKG * KCH)) * 512; \
        __builtin_amdgcn_global_load_lds((const unsigned*)(src_ + lane * 8), (LAS3 unsigned*)(lds + (buf_) * SBYTES + c_ * 1024), 16, 0, 0); } } while (0)
    ATT_ISSUE(0, 0);
    if (nst > 1) ATT_ISSUE(1, 1);
    int buf = 0;
    for (int st = 0; st < nst; ++st) {
        if (st + 1 < nst) { if (CPW == 5) asm volatile("s_waitcnt vmcnt(5)" ::: "memory"); else if (CPW == 3) asm volatile("s_waitcnt vmcnt(3)" ::: "memory"); else asm volatile("s_waitcnt vmcnt(2)" ::: "memory"); }
        else asm volatile("s_waitcnt vmcnt(0)" ::: "memory");
        __builtin_amdgcn_s_barrier();
        asm volatile("" ::: "memory");
        if (st + 2 < nst) { const int nb = buf >= 1 ? buf - 1 : 2; ATT_ISSUE(st + 2, nb); }
        LAS3 const unsigned char* sb = lds + buf * SBYTES + lane * 16;
        bf16x8 kf[NKS];
#pragma unroll
        for (int ks = 0; ks < NKS; ++ks) kf[ks] = *(LAS3 const bf16x8*)(sb + ks * 1024);
#pragma unroll
        for (int g = 0; g < SKG; ++g) {
            bf16x8 vf[VCH], kn[NKS];
#pragma unroll
            for (int i = 0; i < VCH; ++i) vf[i] = *(LAS3 const bf16x8*)(sb + (SKG * KCH + g * VCH + i) * 1024);
            if (g + 1 < SKG) {
#pragma unroll
                for (int ks = 0; ks < NKS; ++ks) kn[ks] = *(LAS3 const bf16x8*)(sb + ((g + 1) * KCH + ks) * 1024);
            }
            asm volatile("" ::: "memory");
            f32x16 s = cinit;
#pragma unroll
            for (int ks = 0; ks < NKS; ++ks) s = MFMA32(kf[ks], qf[ks], s);
            unsigned pp[8];
#pragma unroll
            for (int i = 0; i < 8; ++i) { const float p0 = __builtin_amdgcn_exp2f(s[2 * i]), p1 = __builtin_amdgcn_exp2f(s[2 * i + 1]); lsum += p0 + p1; pp[i] = pk2(p0, p1); }
            const u32x4 u0 = {pp[0], pp[1], pp[2], pp[3]}, u1 = {pp[4], pp[5], pp[6], pp[7]};
            const bf16x8 pf0 = __builtin_bit_cast(bf16x8, u0), pf1 = __builtin_bit_cast(bf16x8, u1);
#pragma unroll
            for (int d = 0; d < NDT; ++d) { o[d] = MFMA32(vf[d], pf0, o[d]); o[d] = MFMA32(vf[NDT + d], pf1, o[d]); }
            if (g + 1 < SKG) {
#pragma unroll
                for (int ks = 0; ks < NKS; ++ks) kf[ks] = kn[ks];
            }
        }
        buf = buf == 2 ? 0 : buf + 1;
    }
#undef ATT_ISSUE
    lsum += __shfl_xor(lsum, 32);
    const float inv = 1.f / lsum;
#pragma unroll
    for (int d = 0; d < NDT; ++d)
#pragma unroll
        for (int g = 0; g < 4; ++g) {
            u32x2 wv; wv.x = pk2(o[d][4 * g] * inv, o[d][4 * g + 1] * inv); wv.y = pk2(o[d][4 * g + 2] * inv, o[d][4 * g + 3] * inv);
            *(u32x2*)(O + d * 32 + 8 * g + 4 * hh) = wv;
        }
    asm volatile("" ::: "memory");
    __builtin_amdgcn_s_barrier();
    asm volatile("" ::: "memory");
}


template <int NC, int NDT, bool VARB = true, bool ROT = true>
DI void attn_block8(LAS3 unsigned char* lds, const unsigned char* Q  , float qnorm, const unsigned char* Kf, const unsigned char* Vf, int nst, float kmax2,
                    bf16* O, int tid) {
    constexpr int KSB = 4 * NC * 2048, VSB = 2 * NDT * 2048, SBYTES = KSB + VSB, SCH = SBYTES / 1024, CPW = SCH / 8;
    static_assert(SCH == 24 && CPW == 3, "stage geometry");
    const int lane = tid & 63, hh = lane >> 5, w = __builtin_amdgcn_readfirstlane(tid >> 6);
    i32x8 qf[NC];
#pragma unroll
    for (int c = 0; c < NC; ++c) { const u32x4 a = *(const u32x4*)(Q + c * 64 + 32 * hh), b = *(const u32x4*)(Q + c * 64 + 32 * hh + 16);
        qf[c] = (i32x8){(int)a[0], (int)a[1], (int)a[2], (int)a[3], (int)b[0], (int)b[1], (int)b[2], (int)b[3]}; }
    const float csb = qnorm * sqrtf(kmax2) * 1.13f + 0.2f;
    f32x16 cinit;
    f32x16 o[NDT];
#pragma unroll
    for (int d = 0; d < NDT; ++d)
#pragma unroll
        for (int i = 0; i < 16; ++i) o[d][i] = 0.f;
    f32x16 lacc;
#pragma unroll
    for (int i = 0; i < 16; ++i) lacc[i] = 0.f;
    i32x8 ones8;
    asm volatile("v_mov_b32 %0, 0x38383838\n\tv_mov_b32 %1, 0x38383838\n\tv_mov_b32 %2, 0x38383838\n\tv_mov_b32 %3, 0x38383838\n\tv_mov_b32 %4, 0x38383838\n\tv_mov_b32 %5, 0x38383838\n\tv_mov_b32 %6, 0x38383838\n\tv_mov_b32 %7, 0x38383838"
                 : "=v"(ones8[0]), "=v"(ones8[1]), "=v"(ones8[2]), "=v"(ones8[3]), "=v"(ones8[4]), "=v"(ones8[5]), "=v"(ones8[6]), "=v"(ones8[7]));
#define ATT_ISSUE8(st_, buf_) do { _Pragma("unroll") for (int i_ = 0; i_ < CPW; ++i_) { const int c_ = w * CPW + i_; \
        const unsigned char* src_ = c_ < KSB / 1024 ? Kf + (size_t)(st_) * KSB + c_ * 1024 : Vf + (size_t)(st_) * VSB + (c_ - KSB / 1024) * 1024; \
        __builtin_amdgcn_global_load_lds((const unsigned*)(src_ + lane * 16), (LAS3 unsigned*)(lds + (buf_) * SBYTES + c_ * 1024), 16, 0, 0); } } while (0)
#define LD_FRAG8(dst_, off_) do { const u32x4 a_ = *(LAS3 const u32x4*)(sb + (off_)), b_ = *(LAS3 const u32x4*)(sb + (off_) + 1024); \
        dst_ = (i32x8){(int)a_[0], (int)a_[1], (int)a_[2], (int)a_[3], (int)b_[0], (int)b_[1], (int)b_[2], (int)b_[3]}; } while (0)
#define ATT_QK8X(kf_, s0, s1) do { s0 = cinit; s1 = cinit; \
        _Pragma("unroll") for (int c = 0; c < NC; ++c) { s0 = MFMA8(kf_[0][c], qf[c], s0, 0, 0); s1 = MFMA8(kf_[1][c], qf[c], s1, 0, 0); } } while (0)
#define ATT_QK8(kf_) ATT_QK8X(kf_, s0, s1)
#define CL8(x_) __builtin_amdgcn_fmed3f((x_), 0.f, 123.f)
#define PK4_U8(a_, b_, c_, d_) __builtin_amdgcn_cvt_pk_u8_f32(CL8(d_), 3, __builtin_amdgcn_cvt_pk_u8_f32(CL8(c_), 2, __builtin_amdgcn_cvt_pk_u8_f32(CL8(b_), 1, __builtin_amdgcn_cvt_pk_u8_f32(CL8(a_), 0, 0u))))
#define ATT_PV8(vf_) ATT_PV8X(vf_, s0, s1)
#define ATT_PV8X(vf_, s0, s1) do { i32x8 pf; \
        _Pragma("unroll") for (int q = 0; q < 4; ++q) pf[q] = (int)PK4_U8(s0[4 * q], s0[4 * q + 1], s0[4 * q + 2], s0[4 * q + 3]); \
        _Pragma("unroll") for (int q = 0; q < 4; ++q) pf[4 + q] = (int)PK4_U8(s1[4 * q], s1[4 * q + 1], s1[4 * q + 2], s1[4 * q + 3]); \
        lacc = MFMA8(ones8, pf, lacc, 0, 1); \
        _Pragma("unroll") for (int d = 0; d < NDT; ++d) o[d] = MFMA8(vf_[d], pf, o[d], 0, 1); } while (0)
    ATT_ISSUE8(0, 0);
    if (nst > 1) ATT_ISSUE8(1, 1);
    {
        if (nst > 1) asm volatile("s_waitcnt vmcnt(3)" ::: "memory"); else asm volatile("s_waitcnt vmcnt(0)" ::: "memory");
        __builtin_amdgcn_s_barrier();
        asm volatile("" ::: "memory");
        LAS3 const unsigned char* sb = lds + lane * 16;
        float emax = -1e30f;
#pragma unroll
        for (int t = 0; t < 4; ++t) {
            f32x16 sz;
#pragma unroll
            for (int i = 0; i < 16; ++i) sz[i] = 0.f;
#pragma unroll
            for (int c = 0; c < NC; ++c) { i32x8 kf_; LD_FRAG8(kf_, (t * NC + c) * 2048); sz = MFMA8(kf_, qf[c], sz, 0, 0); }
#pragma unroll
            for (int i = 0; i < 16; ++i) emax = fmaxf(emax, sz[i]);
        }
        emax = fmaxf(emax, __shfl_xor(emax, 32));
        const float m = fminf(csb, emax + 64.f) - 118.f;
#pragma unroll
        for (int i = 0; i < 16; ++i) cinit[i] = -m;
    }
    int sl = 0;
    for (int st = 0; st < nst; st += 2) {
        asm volatile("s_waitcnt vmcnt(0)" ::: "memory");
        __builtin_amdgcn_s_barrier();
        asm volatile("" ::: "memory");
        if (st + 2 < nst) { ATT_ISSUE8(st + 2, (sl ^ 2)); ATT_ISSUE8(st + 3, (sl ^ 2) + 1); }
        if constexpr (ROT) {
            LAS3 const unsigned char* b0 = lds + sl * SBYTES + lane * 16; LAS3 const unsigned char* b1 = b0 + SBYTES;
#define LD_FRAGB(dst_, base_, off_) do { const u32x4 a_ = *(LAS3 const u32x4*)((base_) + (off_)), b_ = *(LAS3 const u32x4*)((base_) + (off_) + 1024); \
            dst_ = (i32x8){(int)a_[0], (int)a_[1], (int)a_[2], (int)a_[3], (int)b_[0], (int)b_[1], (int)b_[2], (int)b_[3]}; } while (0)
#define LDK_(dst_, base_, tp_) do { _Pragma("unroll") for (int t = 0; t < 2; ++t) _Pragma("unroll") for (int c = 0; c < NC; ++c) LD_FRAGB(dst_[t][c], base_, ((2 * (tp_) + t) * NC + c) * 2048); } while (0)
#define LDV_(dst_, base_, tp_) do { _Pragma("unroll") for (int d = 0; d < NDT; ++d) LD_FRAGB(dst_[d], base_, KSB + ((tp_) * NDT + d) * 2048); } while (0)
            i32x8 ka[2][NC], kb[2][NC], vx[NDT], vy[NDT];
            f32x16 s0, s1, t0, t1;
            LDK_(ka, b0, 0); LDV_(vx, b0, 0);
            asm volatile("" ::: "memory");
            ATT_QK8X(ka, s0, s1);
            LDK_(kb, b0, 1);
            asm volatile("" ::: "memory");
            ATT_QK8X(kb, t0, t1);
            if constexpr (NDT <= 2) { LDV_(vy, b0, 1); asm volatile("" ::: "memory"); }
            ATT_PV8X(vx, s0, s1);
            if constexpr (NDT > 2) { LDV_(vy, b0, 1); }
            LDK_(ka, b1, 0);
            asm volatile("" ::: "memory");
            ATT_QK8X(ka, s0, s1);
            ATT_PV8X(vy, t0, t1);
            LDK_(kb, b1, 1); LDV_(vx, b1, 0);
            asm volatile("" ::: "memory");
            ATT_QK8X(kb, t0, t1);
            ATT_PV8X(vx, s0, s1);
            LDV_(vy, b1, 1);
            asm volatile("" ::: "memory");
            ATT_PV8X(vy, t0, t1);
#undef LD_FRAGB
#undef LDK_
#undef LDV_
        } else {
#pragma unroll
        for (int half = 0; half < 2; ++half) {
        LAS3 const unsigned char* sb = lds + (sl + half) * SBYTES + lane * 16;
        i32x8 kA[2][NC], kB[2][NC], vA[NDT], vB[NDT];
        f32x16 s0, s1;
#pragma unroll
        for (int t = 0; t < 2; ++t)
#pragma unroll
            for (int c = 0; c < NC; ++c) LD_FRAG8(kA[t][c], (t * NC + c) * 2048);
#pragma unroll
        for (int d = 0; d < NDT; ++d) LD_FRAG8(vA[d], KSB + d * 2048);
        asm volatile("" ::: "memory");
        ATT_QK8(kA);
#pragma unroll
        for (int t = 0; t < 2; ++t)
#pragma unroll
            for (int c = 0; c < NC; ++c) LD_FRAG8(kB[t][c], ((2 + t) * NC + c) * 2048);
        asm volatile("" ::: "memory");
        if constexpr (NDT <= 2) {
            f32x16 t0, t1;
            ATT_QK8X(kB, t0, t1);
#pragma unroll
            for (int d = 0; d < NDT; ++d) LD_FRAG8(vB[d], KSB + (NDT + d) * 2048);
            asm volatile("" ::: "memory");
            ATT_PV8(vA);
            ATT_PV8X(vB, t0, t1);
        } else if constexpr (VARB) {
            f32x16 t0, t1;
            ATT_QK8X(kB, t0, t1);
            ATT_PV8(vA);
#pragma unroll
            for (int d = 0; d < NDT; ++d) LD_FRAG8(vB[d], KSB + (NDT + d) * 2048);
            asm volatile("" ::: "memory");
            ATT_PV8X(vB, t0, t1);
        } else {
        ATT_PV8(vA);
#pragma unroll
        for (int d = 0; d < NDT; ++d) LD_FRAG8(vB[d], KSB + (NDT + d) * 2048);
        asm volatile("" ::: "memory");
        ATT_QK8(kB);
        ATT_PV8(vB);
        }
        }
        }
        sl ^= 2;
    }
#undef ATT_ISSUE8
#undef LD_FRAG8
#undef ATT_QK8
#undef ATT_QK8X
#undef ATT_PV8X
#undef ATT_PV8
#undef PK4_U8
#undef CL8
    const float lsum_ = lacc[0];
    const bool bad_ = !(lsum_ > 0.f) || !(lsum_ < 3.0e38f);
    const float inv = bad_ ? 0.f : 1.f / lsum_;

#pragma unroll
    for (int d = 0; d < NDT; ++d)
#pragma unroll
        for (int g = 0; g < 4; ++g) {
            u32x2 wv; wv.x = pk2(o[d][4 * g] * inv, o[d][4 * g + 1] * inv); wv.y = pk2(o[d][4 * g + 2] * inv, o[d][4 * g + 3] * inv);
            *(u32x2*)(O + d * 32 + 8 * g + 4 * hh) = wv;
        }
    asm volatile("" ::: "memory");
    __builtin_amdgcn_s_barrier();
    asm volatile("" ::: "memory");
}

DI void phase_attn(const Params& p, int layer, unsigned char* ldsg) {
    LAS3 unsigned char* lds = (LAS3 unsigned char*)ldsg;
    {   unsigned char* const ws_ = lws(p); const int tid = ltid(); const int w = tid >> 6, n = tid & 31;
        const unsigned* kmax = (const unsigned*)(ws_ + WS_KMAX) + layer * 48; const float* qn = (const float*)(ws_ + WS_QN) + (size_t)MROWS * 8;
        for (int k = 0; k * (int)gridDim.x + (int)blockIdx.x < 1024; ++k) {
            const int it = k * gridDim.x + blockIdx.x; int combo = it >> 6, qt = it & 63;
            if (gridDim.x == 256) { const int x = blockIdx.x & 7, r = blockIdx.x >> 3; combo = x * 2 + (k >> 1); qt = (k & 1) * 32 + r; }
            const int b = combo >> 3, hd = combo & 7;
            const int row = b * TPB + CTX + qt * 256 + w * 32 + n;
            attn_block8<2, 2, true>(lds, ws_ + R_QMLA + (size_t)row * 1024 + hd * 128, qn[(size_t)row * 8 + hd],
                ws_ + R_KFMLA + (size_t)(b * 8 + hd) * KGPB * 4096, ws_ + R_VFMLA + (size_t)(b * 8 + hd) * (KGPB / 2) * 4096,
                KGPB / 4, __uint_as_float(kmax[32 + b * 8 + hd]), (bf16*)(ws_ + R_YA) + (size_t)row * 1536 + 512 + hd * 64, tid);
        }
        for (int it = blockIdx.x; it < 16; it += gridDim.x) {
            const int b = it >> 3, hd = it & 7; const int row = b * TPB + w * 32 + n;
            attn_block8<2, 2, true>(lds, ws_ + R_QMLA + (size_t)row * 1024 + hd * 128, qn[(size_t)row * 8 + hd],
                ws_ + R_KFMLA + (size_t)(b * 8 + hd) * KGPB * 4096, ws_ + R_VFMLA + (size_t)(b * 8 + hd) * (KGPB / 2) * 4096,
                2, __uint_as_float(kmax[32 + b * 8 + hd]), (bf16*)(ws_ + R_YA) + (size_t)row * 1536 + 512 + hd * 64, tid);
        }
    }
    {   unsigned char* const ws_ = lws(p); const int tid = ltid(); const int w = tid >> 6, n = tid & 31;
        const unsigned* kmax = (const unsigned*)(ws_ + WS_KMAX) + layer * 48; const float* qn = (const float*)(ws_ + WS_QN);
        for (int k = 0; k * (int)gridDim.x + (int)blockIdx.x < 1024; ++k) {
            const int it = k * gridDim.x + blockIdx.x; int combo = it >> 6, qt = it & 63;
            if (gridDim.x == 256) { const int x = blockIdx.x & 7, r = blockIdx.x >> 3; combo = x * 2 + (k >> 1); qt = (k & 1) * 32 + r; }
            const int b = combo >> 3, hd = combo & 7;
            const int row = b * TPB + CTX + qt * 256 + w * 32 + n;
            attn_block8<1, 4, true>(lds, ws_ + R_QD + (size_t)row * 512 + hd * 64, qn[(size_t)row * 8 + hd],
                ws_ + R_KFD + (size_t)(b * 8 + hd) * KGPB * 2048, ws_ + R_VFD + (size_t)(b * 4 + (hd >> 1)) * (KGPB / 2) * 8192,
                KGPB / 4, __uint_as_float(kmax[16 + b * 8 + hd]), (bf16*)(ws_ + R_OD) + (size_t)row * 1024 + hd * 128, tid);
        }
        for (int it = blockIdx.x; it < 16; it += gridDim.x) {
            const int b = it >> 3, hd = it & 7; const int row = b * TPB + w * 32 + n;
            attn_block8<1, 4, true>(lds, ws_ + R_QD + (size_t)row * 512 + hd * 64, qn[(size_t)row * 8 + hd],
                ws_ + R_KFD + (size_t)(b * 8 + hd) * KGPB * 2048, ws_ + R_VFD + (size_t)(b * 4 + (hd >> 1)) * (KGPB / 2) * 8192,
                2, __uint_as_float(kmax[16 + b * 8 + hd]), (bf16*)(ws_ + R_OD) + (size_t)row * 1024 + hd * 128, tid);
        }
    }
    {   unsigned char* const ws_ = lws(p); const int tid = ltid(); const int w = tid >> 6, n = tid & 31;
        const unsigned* kmax = (const unsigned*)(ws_ + WS_KMAX) + layer * 48; const float* lamv = (const float*)(ws_ + WS_LAM);
        unsigned* ctr = (unsigned*)(ws_ + WS_CTL) + 8 + layer;
        volatile LAS3 int* nxt = (volatile LAS3 int*)ldsg;
        int par = 0;
        for (int it = blockIdx.x; it < 1024; ) {
            unsigned got = 0u;
            if (tid == 0) got = __hip_atomic_fetch_add(ctr, 1u, __ATOMIC_RELAXED, __HIP_MEMORY_SCOPE_AGENT);
            const int b = it >> 9, hd = (it >> 6) & 7, qt = it & 63;
            const int gr = qt * 4 + (w >> 1), qh = w & 1;
            const int row = b * TPB + CTX + gr * 64 + qh * 32 + n;
            attn_wave<64, 64, true>((const bf16*)(ws_ + R_QNA) + (size_t)row * 512 + hd * 64,
                (const bf16*)(ws_ + R_KFNA) + (size_t)(b * 8 + hd) * KGPB * 2048, (const bf16*)(ws_ + R_VFNA) + (size_t)(b * 8 + hd) * KGPB * 2048,
                0, 0, __uint_as_float(kmax[b * 8 + hd]), (bf16*)(ws_ + R_YA) + (size_t)row * 1536 + hd * 64,
                (const float*)(ws_ + WS_BIAS) + (size_t)(layer * 8 + hd) * 15 * 4 * 1024, lamv[4 + layer * 8 + hd], gr, qh);
            if (tid == 0) nxt[par] = (int)gridDim.x + (int)got;
            __syncthreads();
            it = nxt[par];
            par ^= 1;
        }
    }
    {   unsigned char* const ws_ = lws(p); const int tid = ltid(); const int w = tid >> 6, n = tid & 31;
        const unsigned* kmax = (const unsigned*)(ws_ + WS_KMAX) + layer * 48;
        for (int it = blockIdx.x; it < 16; it += gridDim.x) {
            const int b = it >> 3, hd = it & 7; const int row = b * TPB + w * 32 + n;
            attn_wave<64, 64, false>((const bf16*)(ws_ + R_QNA) + (size_t)row * 512 + hd * 64,
                (const bf16*)(ws_ + R_KFNA) + (size_t)(b * 8 + hd) * KGPB * 2048, (const bf16*)(ws_ + R_VFNA) + (size_t)(b * 8 + hd) * KGPB * 2048,
                0, 8, __uint_as_float(kmax[b * 8 + hd]), (bf16*)(ws_ + R_YA) + (size_t)row * 1536 + hd * 64, nullptr, 0.f, 0, 0);
        }
    }
}

DI void phase_diffcomb(const Params& p, int layer) {
    unsigned char* const ws_ = lws(p);
    const int tid = ltid();
    const int lane = tid & 63;
    const float* lamv = (const float*)(ws_ + WS_LAM); const float lam = lamv[layer], li = lamv[2 + layer];
    const float* gsub = p.in[16] + layer * 128;
    const bf16* OD = (const bf16*)(ws_ + R_OD); bf16* YC = (bf16*)(ws_ + R_YA) + 1024;
    const int h4 = lane >> 4, d0 = (lane & 15) * 8;
    for (int row = gwave(tid); row < MROWS; row += nwaves()) {
        float a[8], b2[8], y[8];
        unpack8(*(const bf16x8*)(OD + (size_t)row * 1024 + (2 * h4) * 128 + d0), a);
        unpack8(*(const bf16x8*)(OD + (size_t)row * 1024 + (2 * h4 + 1) * 128 + d0), b2);
        float ss = 0.f;
#pragma unroll
        for (int j = 0; j < 8; ++j) { y[j] = a[j] - lam * b2[j]; ss += y[j] * y[j]; }
#pragma unroll
        for (int o = 8; o >= 1; o >>= 1) ss += __shfl_xor(ss, o);
        const float r = rsqrtf(ss * (1.f / 128.f) + EPS) * (1.f - li);
#pragma unroll
        for (int j = 0; j < 8; ++j) y[j] = y[j] * r * gsub[d0 + j];
        *(bf16x8*)(YC + (size_t)row * 1536 + h4 * 128 + d0) = pack8(y);
    }
}

DI void phase_ln1_router(const Params& p, int layer, float* lds  ) {
    unsigned char* const ws_ = lws(p);
    const int tid = ltid();
    const int lane = tid & 63;
    const float* wr = p.in[25] + (size_t)layer * 1024 * 16;
    for (int i = tid; i < 16384; i += NWG_THREADS) { const int k = i >> 4, e = i & 15; lds[e * 1024 + k] = wr[i]; }
    __syncthreads();
    const float* mod = (const float*)(ws_ + WS_MOD) + (size_t)layer * 3 * 6144;
    const float* g1 = p.in[23] + layer * 1024; const float* b1 = p.in[24] + layer * 1024;
    float* X = (float*)(ws_ + WS_X); bf16* H = (bf16*)(ws_ + WS_H);
    float* affL = (float*)(ws_ + WS_AFF); float* affC = affL + 2 * 16 * 16384;
    for (int row = gwave(tid); row < MROWS; row += nwaves()) {
        float* xr = X + (size_t)row * D;
        f32x4 v[4];
#pragma unroll
        for (int i = 0; i < 4; ++i) v[i] = *(const f32x4*)(xr + i * 256 + lane * 4);
        float mu, rstd; ln_stats16(v, mu, rstd);
#pragma unroll
        for (int i = 0; i < 4; ++i) { const int c = i * 256 + lane * 4; v[i] = (v[i] - mu) * rstd * *(const f32x4*)(g1 + c) + *(const f32x4*)(b1 + c); }
        ln_stats16(v, mu, rstd);
        const float* mr = mod + (size_t)mod_row_of(row) * 6144;
        float lg[16];
#pragma unroll
        for (int i = 0; i < 4; ++i) {
            const int c = i * 256 + lane * 4;
            const f32x4 sh = *(const f32x4*)(mr + 3072 + c), sc = *(const f32x4*)(mr + 4096 + c);
            const f32x4 y = (v[i] - mu) * rstd * (sc + 1.f) + sh;
            *(unsigned*)((unsigned char*)H + (size_t)row * D + c) = pk4_fp8(y[0], y[1], y[2], y[3]);
            v[i] = y;
        }
#pragma unroll
        for (int e = 0; e < 16; ++e) {
            float a = 0.f;
#pragma unroll
            for (int i = 0; i < 4; ++i) { const f32x4 w = *(const f32x4*)(lds + e * 1024 + i * 256 + lane * 4); a += (v[i][0] * w[0] + v[i][1] * w[1]) + (v[i][2] * w[2] + v[i][3] * w[3]); }
            lg[e] = a;
            asm volatile("" : "+v"(lg[e]));
        }
        float r8[8], r4[4], r2[2], r1;
        { const bool hi = (lane & 32) != 0;
#pragma unroll
          for (int j = 0; j < 8; ++j) { const float keep = hi ? lg[8 + j] : lg[j], send = hi ? lg[j] : lg[8 + j]; r8[j] = keep + __shfl_xor(send, 32); } }
        { const bool hi = (lane & 16) != 0;
#pragma unroll
          for (int j = 0; j < 4; ++j) { const float keep = hi ? r8[4 + j] : r8[j], send = hi ? r8[j] : r8[4 + j]; r4[j] = keep + __shfl_xor(send, 16); } }
        { const bool hi = (lane & 8) != 0;
#pragma unroll
          for (int j = 0; j < 2; ++j) { const float keep = hi ? r4[2 + j] : r4[j], send = hi ? r4[j] : r4[2 + j]; r2[j] = keep + __shfl_xor(send, 8); } }
        { const bool hi = (lane & 4) != 0; const float keep = hi ? r2[1] : r2[0], send = hi ? r2[0] : r2[1]; r1 = keep + __shfl_xor(send, 4); }
        r1 += __shfl_xor(r1, 2); r1 += __shfl_xor(r1, 1);
        float mx = r1;
        mx = fmaxf(mx, __shfl_xor(mx, 4)); mx = fmaxf(mx, __shfl_xor(mx, 8)); mx = fmaxf(mx, __shfl_xor(mx, 16)); mx = fmaxf(mx, __shfl_xor(mx, 32));
        const float pe = expf(r1 - mx);
        float se = pe;
        se += __shfl_xor(se, 4); se += __shfl_xor(se, 8); se += __shfl_xor(se, 16); se += __shfl_xor(se, 32);
        const float mine = pe / se;
        const int eidx = ((lane >> 5) & 1) * 8 + ((lane >> 4) & 1) * 4 + ((lane >> 3) & 1) * 2 + ((lane >> 2) & 1);
        const int b = row / TPB, t = row - b * TPB;
        if ((lane & 3) == 0) { if (t < CTX) affC[(size_t)(b * 16 + eidx) * 256 + t] = mine; else affL[(size_t)(b * 16 + eidx) * 16384 + (t - CTX)] = mine; }
    }
}

DI void phase_topk(const Params& p, unsigned* lds  ) {
    unsigned char* const ws_ = lws(p);
    const int tid = ltid(), lane = tid & 63, wv = tid >> 6;
    unsigned* vals = lds; unsigned* hist = lds + 16384 + 512; unsigned* misc = hist + 256; unsigned* wsum = misc + 32;
    const float* affL = (const float*)(ws_ + WS_AFF); const float* affC = affL + 2 * 16 * 16384;
    int* selrow = (int*)(ws_ + WS_SELROW); float* selw = (float*)(ws_ + WS_SELW); int* slotof = (int*)(ws_ + WS_SLOTOF);
#define VPAD(i_) ((i_) + ((i_) >> 5))
    for (int pr = blockIdx.x; pr < 64; pr += gridDim.x) {
        const bool isc = pr >= 32; const int q = pr & 31, b = q >> 4, e = q & 15;
        const int n = isc ? 256 : 16384, k = isc ? CAP_C : CAP_L;
        const float* src = isc ? affC + (size_t)q * 256 : affL + (size_t)q * 16384;
        const int slotbase = isc ? NSLOT_L + (e * 2 + b) * CAP_C : (e * 2 + b) * CAP_L;
        const int rowbase = b * TPB + (isc ? 0 : CTX);
        __syncthreads();
        for (int i = tid; i < n; i += NWG_THREADS) vals[VPAD(i)] = __float_as_uint(src[i]);
        unsigned prefix = 0, mask = 0; int kk = k;
        for (int pass = 3; pass >= 0; --pass) {
            if (tid < 256) hist[tid] = 0;
            __syncthreads();
            for (int i = tid; i < n; i += NWG_THREADS) { const unsigned v = vals[VPAD(i)]; if ((v & mask) == prefix) atomicAdd(&hist[(v >> (8 * pass)) & 255], 1u); }
            __syncthreads();
            if (wv == 0) {
                const int c0 = (int)hist[4 * lane], c1 = (int)hist[4 * lane + 1], c2 = (int)hist[4 * lane + 2], c3 = (int)hist[4 * lane + 3];
                const int sl = c0 + c1 + c2 + c3;
                int suf = sl;
#pragma unroll
                for (int o = 1; o < 64; o <<= 1) { const int y = __shfl_down(suf, o); if (lane + o < 64) suf += y; }
                const int above = suf - sl;
                if (above < kk && kk <= suf) {
                    int cum = above, bin = 4 * lane + 3;
                    if (cum + c3 < kk) { cum += c3; bin = 4 * lane + 2; if (cum + c2 < kk) { cum += c2; bin = 4 * lane + 1; if (cum + c1 < kk) { cum += c1; bin = 4 * lane; } } }
                    misc[0] = (unsigned)bin; misc[1] = (unsigned)(kk - cum);
                }
            }
            __syncthreads();
            prefix |= misc[0] << (8 * pass); mask |= 0xffu << (8 * pass); kk = (int)misc[1];
        }
        const unsigned T = prefix;
        const int i0 = tid * 32;
        int gt = 0, eq = 0;
        if (i0 < n) for (int i = 0; i < 32; ++i) { const unsigned v = vals[tid * 33 + i]; gt += v > T; eq += v == T; }
        int x = eq;
#pragma unroll
        for (int o = 1; o < 64; o <<= 1) { const int y = __shfl_up(x, o); if (lane >= o) x += y; }
        if (lane == 63) wsum[wv] = (unsigned)x;
        __syncthreads();
        int eqbase = x - eq; for (int w2 = 0; w2 < wv; ++w2) eqbase += (int)wsum[w2];
        int take = kk - eqbase; take = take < 0 ? 0 : (take > eq ? eq : take);
        const int sel = gt + take;
        x = sel;
#pragma unroll
        for (int o = 1; o < 64; o <<= 1) { const int y = __shfl_up(x, o); if (lane >= o) x += y; }
        if (lane == 63) wsum[8 + wv] = (unsigned)x;
        __syncthreads();
        int pos = x - sel; for (int w2 = 0; w2 < wv; ++w2) pos += (int)wsum[8 + w2];
        if (i0 < n) {
            int eqc = 0;
            int* so = slotof + (size_t)e * MROWS + rowbase + i0;
            for (int i = 0; i < 32; ++i) {
                const unsigned v = vals[tid * 33 + i]; bool s = v > T;
                if (v == T) { s = eqc < take; ++eqc; }
                if (s) { selrow[slotbase + pos] = rowbase + i0 + i; selw[slotbase + pos] = __uint_as_float(v); so[i] = slotbase + pos; ++pos; }
                else so[i] = -1;
            }
        }
    }
#undef VPAD
}

DI void phase_gather(const Params& p) {
    unsigned char* const ws_ = lws(p);
    const int tid = ltid();
    const int lane = tid & 63;
    const int* selrow = (const int*)(ws_ + WS_SELROW); const bf16* H = (const bf16*)(ws_ + WS_H); unsigned char* XS = ws_ + R_XSEL;
    for (int c = gwave(tid); c < NSLOT / 32; c += nwaves()) {
        const int myrow = selrow[c * 32 + (lane & 31)];
#pragma unroll 4
        for (int j = 0; j < 32; ++j) {
            const int row = __builtin_amdgcn_readlane(myrow, j);
            float f[16];
            { float t8[8]; unpack8(*(const bf16x8*)(H + (size_t)row * D + lane * 16), t8);
#pragma unroll
              for (int q = 0; q < 8; ++q) f[q] = t8[q];
              unpack8(*(const bf16x8*)(H + (size_t)row * D + lane * 16 + 8), t8);
#pragma unroll
              for (int q = 0; q < 8; ++q) f[8 + q] = t8[q]; }
            *(u32x4*)(XS + (size_t)(c * 32 + j) * D + lane * 16) = pk16_fp8(f);
        }
    }
}

DI void phase_combine_ln2(const Params& p, int layer, float* lds  ) {
    unsigned char* const ws_ = lws(p);
    const int tid = ltid();
    const int lane = tid & 63;
    {   const float* mod = (const float*)(ws_ + WS_MOD) + (size_t)layer * 3 * 6144;
        const float* g1 = p.in[23] + layer * 1024; const float* b1 = p.in[24] + layer * 1024;
        const float* g2w = p.in[29] + layer * 1024; const float* b2w = p.in[30] + layer * 1024;
        for (int i = tid; i < 1024; i += NWG_THREADS) {
            lds[i] = g1[i]; lds[1024 + i] = b1[i]; lds[2048 + i] = g2w[i]; lds[3072 + i] = b2w[i];
#pragma unroll
            for (int r = 0; r < 3; ++r) {
                lds[(4 + r) * 1024 + i] = mod[r * 6144 + 5120 + i];
                if (layer == 0) { lds[(7 + r) * 1024 + i] = mod[3 * 6144 + r * 6144 + i]; lds[(10 + r) * 1024 + i] = mod[3 * 6144 + r * 6144 + 1024 + i]; }
            }
        }
        __syncthreads();
    }
    float* X = (float*)(ws_ + WS_X); const bf16* Y = (const bf16*)(ws_ + R_XSEL); const int* slotof = (const int*)(ws_ + WS_SLOTOF);
    unsigned char* H8 = ws_ + WS_H;
    const int nw = nwaves();
#define C18_SIDX(r_) slotof[(size_t)(lane & 15) * MROWS + ((r_) < MROWS ? (r_) : MROWS - 1)]
    int ra = gwave(tid);
    int sa = C18_SIDX(ra), sb = C18_SIDX(ra + nw);
#pragma unroll 1
    for (; ra < MROWS; ra += 2 * nw) {
        const int rb = ra + nw;
        const int rbc = rb < MROWS ? rb : ra;
        unsigned ma = (unsigned)__builtin_amdgcn_ballot_w64(sa >= 0) & 0xFFFFu, mb = (unsigned)__builtin_amdgcn_ballot_w64(sb >= 0) & 0xFFFFu;
        int qa[4], qb[4]; float wa[4], wb[4];
#pragma unroll
        for (int j = 0; j < 4; ++j) {
            { const bool h = ma != 0u; const int e = h ? __builtin_ctz(ma) : 0; const int q = __builtin_amdgcn_readlane(sa, e); qa[j] = h ? q : 0; wa[j] = h ? 1.f : 0.f; ma &= ma - 1u; }
            { const bool h = mb != 0u; const int e = h ? __builtin_ctz(mb) : 0; const int q = __builtin_amdgcn_readlane(sb, e); qb[j] = h ? q : 0; wb[j] = h ? 1.f : 0.f; mb &= mb - 1u; }
        }
        u32x2 ua[4][4], ub[4][4]; f32x4 va[4], vb[4];
#pragma unroll
        for (int j = 0; j < 4; ++j)
#pragma unroll
            for (int i = 0; i < 4; ++i) { ua[j][i] = *(const u32x2*)(Y + (size_t)qa[j] * D + i * 256 + lane * 4); ub[j][i] = *(const u32x2*)(Y + (size_t)qb[j] * D + i * 256 + lane * 4); }
#pragma unroll
        for (int i = 0; i < 4; ++i) { va[i] = *(const f32x4*)(X + (size_t)ra * D + i * 256 + lane * 4); vb[i] = *(const f32x4*)(X + (size_t)rbc * D + i * 256 + lane * 4); }
        const int na = C18_SIDX(ra + 2 * nw), nb = C18_SIDX(rb + 2 * nw);
        f32x4 fa[4], fb[4];
#pragma unroll
        for (int i = 0; i < 4; ++i) { fa[i] = (f32x4){0.f, 0.f, 0.f, 0.f}; fb[i] = fa[i]; }
#pragma unroll
        for (int j = 0; j < 4; ++j)
#pragma unroll
            for (int i = 0; i < 4; ++i) {
                fa[i][0] += wa[j] * lo_f(ua[j][i].x); fa[i][1] += wa[j] * hi_f(ua[j][i].x); fa[i][2] += wa[j] * lo_f(ua[j][i].y); fa[i][3] += wa[j] * hi_f(ua[j][i].y);
                fb[i][0] += wb[j] * lo_f(ub[j][i].x); fb[i][1] += wb[j] * hi_f(ub[j][i].x); fb[i][2] += wb[j] * lo_f(ub[j][i].y); fb[i][3] += wb[j] * hi_f(ub[j][i].y);
            }
        while (ma) {
            const int s = __builtin_amdgcn_readlane(sa, __builtin_ctz(ma)); ma &= ma - 1u;
#pragma unroll
            for (int i = 0; i < 4; ++i) { const u32x2 u = *(const u32x2*)(Y + (size_t)s * D + i * 256 + lane * 4); fa[i][0] += lo_f(u.x); fa[i][1] += hi_f(u.x); fa[i][2] += lo_f(u.y); fa[i][3] += hi_f(u.y); }
        }
        while (mb) {
            const int s = __builtin_amdgcn_readlane(sb, __builtin_ctz(mb)); mb &= mb - 1u;
#pragma unroll
            for (int i = 0; i < 4; ++i) { const u32x2 u = *(const u32x2*)(Y + (size_t)s * D + i * 256 + lane * 4); fb[i][0] += lo_f(u.x); fb[i][1] += hi_f(u.x); fb[i][2] += lo_f(u.y); fb[i][3] += hi_f(u.y); }
        }
#define C18_TAIL(row_, v, f) do { \
            const int b_ = (row_) / TPB, t_ = (row_) - b_ * TPB; const int mrow_ = t_ < CTX ? 2 : b_; \
            if ((row_) < MROWS && !(layer == 1 && t_ < CTX)) {       \
                float mu, rstd; ln_stats16(v, mu, rstd); \
                _Pragma("unroll") for (int i = 0; i < 4; ++i) { const int c = i * 256 + lane * 4; \
                    const f32x4 x1 = (v[i] - mu) * rstd * *(const f32x4*)(lds + c) + *(const f32x4*)(lds + 1024 + c);        \
                    v[i] = x1 * ALPHA + *(const f32x4*)(lds + (4 + mrow_) * 1024 + c) * f[i]; } \
                ln_stats16(v, mu, rstd); \
                _Pragma("unroll") for (int i = 0; i < 4; ++i) { const int c = i * 256 + lane * 4; \
                    v[i] = (v[i] - mu) * rstd * *(const f32x4*)(lds + 2048 + c) + *(const f32x4*)(lds + 3072 + c); \
                    if (layer == 1) *(f32x4*)(p.out + ((size_t)b_ * SEQ + (t_ - CTX)) * D + c) = v[i]; \
                    else *(f32x4*)(X + (size_t)(row_) * D + c) = v[i]; } \
                if (layer == 0) {         \
                    ln_stats16(v, mu, rstd); \
                    _Pragma("unroll") for (int i = 0; i < 4; ++i) { const int c = i * 256 + lane * 4; \
                        const f32x4 sh = *(const f32x4*)(lds + (7 + mrow_) * 1024 + c), sc = *(const f32x4*)(lds + (10 + mrow_) * 1024 + c); \
                        const f32x4 y = (v[i] - mu) * rstd * (sc + 1.f) + sh; \
                        *(unsigned*)(H8 + (size_t)(row_) * D + c) = pk4_fp8(y[0], y[1], y[2], y[3]); } } } } while (0)
        C18_TAIL(ra, va, fa);
        C18_TAIL(rb, vb, fb);
#undef C18_TAIL
        sa = na; sb = nb;
    }
#undef C18_SIDX
    __syncthreads();
}


namespace pg8 {
#define PG8_LAS __attribute__((address_space(3)))
constexpr int BM = 256, BK = 64, HALF = 128, HTB = HALF * BK * 2, STAGE_BYTES = 8 * HTB, NXCD = 8, WGM = 8;
__host__ __device__ __forceinline__ int lds_byte(int r, int c) { const int st = (r >> 4) * 2 + (c >> 5), rr = r & 15, cc = c & 31, ob = rr * 64 + cc * 2; return st * 1024 + (ob ^ (((ob >> 9) & 1) << 5)); }
__host__ __device__ __forceinline__ void stage_rc(int b, int& R, int& C) { const int st = b / 1024, sb = b % 1024, swz = sb ^ (((sb >> 9) & 1) << 5); R = (st >> 1) * 16 + swz / 64; C = (st & 1) * 32 + (swz % 64) / 2; }
struct Unit { int pm, pn; };
struct Gemm { const bf16* A; const bf16* Bt; int lda, ldb, K; };
struct StaticOrder {
    int nM, nN, nwg, G, c;
    __device__ void init(int nM_, int nN_, int G_, int c_) { nM = nM_; nN = nN_; nwg = nM * nN; G = G_; c = c_; }
    __device__ bool next(int i, Unit& u) const {
        const long L = (long)i * G + c; if (L >= nwg) return false;
        int wgid = (int)L; { const int q = nwg / NXCD, r = nwg % NXCD, xcd = wgid % NXCD, off = wgid / NXCD; wgid = (xcd < r ? xcd * (q + 1) : r * (q + 1) + (xcd - r) * q) + off; }
        const int nig = WGM * nN, gid = wgid / nig, fm = gid * WGM, gsz = (nM - fm) < WGM ? (nM - fm) : WGM;
        u.pm = fm + ((wgid % nig) % gsz); u.pn = (wgid % nig) / gsz; return true;
    }
};
struct NoHook { static constexpr bool ENABLED = false; };
template <class Epi, class Sched, bool FP8 = false, class Hook = NoHook, bool GATHER = false>
__device__ __forceinline__ void gemm_phase(PG8_LAS unsigned char* lds, const Gemm g, const Sched& S, const Epi& E, int tid, const Hook& H = Hook(), const int* gidx = nullptr) {
    const int wid = __builtin_amdgcn_readfirstlane(tid >> 6), lane = tid & 63, wr = wid >> 2, wc = wid & 3, fr = lane & 15, fq = lane >> 4;
    const int K = g.K, nt = K / BK;
    unsigned voffA[2], voffB[2];
    int gR[2]; unsigned gC[2];
#pragma unroll
    for (int i = 0; i < 2; ++i) { int R, C; stage_rc(tid * 16 + i * 8192, R, C); voffA[i] = (unsigned)(R * g.lda + C) * 2u; voffB[i] = (unsigned)(R * g.ldb + C) * 2u; gR[i] = R; gC[i] = (unsigned)C * 2u; }
    const size_t kstep = (size_t)(BK * 2);
    const size_t hstepA = GATHER ? 0 : (size_t)HALF * g.lda * 2, hstepB = (size_t)HALF * g.ldb * 2, tstepA = 2 * hstepA, tstepB = 2 * hstepB;
    unsigned gvc[2][2], gvn[2][2], gv2[2][2];
    const int gsrc = ((lane >> 5) & 1) * HALF + (((wid + 8 * ((lane >> 4) & 1)) >> 1) * 16) + (lane & 15);
#define PG8_GDMA(pm_) __builtin_amdgcn_global_load_lds((const unsigned*)(gidx + (pm_) * BM + gsrc), (PG8_LAS unsigned*)(lds + STAGE_BYTES + ldsw / 4), 4, 0, 0)
#define PG8_GREAD(h_, i_) ((unsigned)*(const PG8_LAS int*)(lds + STAGE_BYTES + ldsw / 4 + (((h_) * 2 + (i_)) * 16 + (lane >> 2)) * 4) * (unsigned)(g.lda * 2) + gC[i_])
    const unsigned ldsw = (unsigned)wid * 1024u;
    const int aoff = lds_byte(wr * 64 + fr, fq * 8), boff = lds_byte(wc * 32 + fr, fq * 8);
#define PG8_SA(b, h) (((b) * 2 + (h)) * HTB)
#define PG8_SB(b, h) ((4 + (b) * 2 + (h)) * HTB)
#define PG8_STAGE(bufoff, gbase, voff) do { _Pragma("unroll") for (int _i = 0; _i < 2; ++_i) \
        __builtin_amdgcn_global_load_lds((const unsigned*)((const char*)(gbase) + (voff)[_i]), (PG8_LAS unsigned*)(lds + (bufoff) + ldsw + _i * 8192), 16, 0, 0); } while (0)
#define PG8_STAGE_A(bufoff, gbase, h_, NX) do { if constexpr (GATHER) { if (NX) PG8_STAGE(bufoff, gbase, gv2[h_]); else PG8_STAGE(bufoff, gbase, gvc[h_]); } \
        else PG8_STAGE(bufoff, (gbase) + (h_) * hstepA, voffA); } while (0)
#define PG8_LD2(dst_, off_) do { const u32x4 x_ = *(const PG8_LAS u32x4*)(lds + (off_)), y_ = *(const PG8_LAS u32x4*)(lds + (off_) + 1024); \
        dst_ = (i32x8){(int)x_[0], (int)x_[1], (int)x_[2], (int)x_[3], (int)y_[0], (int)y_[1], (int)y_[2], (int)y_[3]}; } while (0)
#define PG8_LDA(dst, b, h) do { if constexpr (FP8) { _Pragma("unroll") for (int m = 0; m < 4; ++m) PG8_LD2(dst##8[m], PG8_SA(b, h) + aoff + m * 2048); } \
        else { _Pragma("unroll") for (int m = 0; m < 4; ++m) _Pragma("unroll") for (int k = 0; k < 2; ++k) dst[m][k] = *(const PG8_LAS bf16x8*)(lds + PG8_SA(b, h) + aoff + m * 2048 + k * 1024); } } while (0)
#define PG8_LDB(dst, b, h) do { if constexpr (FP8) { _Pragma("unroll") for (int n = 0; n < 2; ++n) PG8_LD2(dst##8[n], PG8_SB(b, h) + boff + n * 2048); } \
        else { _Pragma("unroll") for (int n = 0; n < 2; ++n) _Pragma("unroll") for (int k = 0; k < 2; ++k) dst[n][k] = *(const PG8_LAS bf16x8*)(lds + PG8_SB(b, h) + boff + n * 2048 + k * 1024); } } while (0)
#define PG8_MMA(ai, bj, At, Bt) do { __builtin_amdgcn_s_setprio(1); _Pragma("unroll") for (int m = 0; m < 4; ++m) _Pragma("unroll") for (int n = 0; n < 2; ++n) { \
        if constexpr (FP8) asm volatile("v_mfma_scale_f32_16x16x128_f8f6f4 %0, %1, %2, %0, %3, %3 op_sel_hi:[0,0,0]" : "+v"(acc[ai][bj][m][n]) : "v"(Bt##8[n]), "v"(At##8[m]), "v"(sc1)); \
        else { _Pragma("unroll") for (int k = 0; k < 2; ++k) acc[ai][bj][m][n] = __builtin_amdgcn_mfma_f32_16x16x32_bf16(Bt[n][k], At[m][k], acc[ai][bj][m][n], 0, 0, 0); } } \
        __builtin_amdgcn_s_setprio(0); } while (0)
#define PG8_WAIT_V(n) asm volatile("s_waitcnt vmcnt(" #n ")" ::: "memory")
#define PG8_WAIT_L(n) asm volatile("s_waitcnt lgkmcnt(" #n ")" ::: "memory")
#define PG8_BAR __builtin_amdgcn_s_barrier()
#define PG8_SCHED __builtin_amdgcn_sched_barrier(0)
    Unit cur, nxt; int ui = 0;
    if (!S.next(0, cur)) return;
    int sc1 = 0x7f7f7f7f; asm volatile("" : "+v"(sc1));
    f32x4 acc[2][2][4][2];
#pragma unroll
    for (int a = 0; a < 2; ++a)
#pragma unroll
        for (int b = 0; b < 2; ++b)
#pragma unroll
            for (int m = 0; m < 4; ++m)
#pragma unroll
                for (int n = 0; n < 2; ++n) acc[a][b][m][n] = (f32x4){0.f, 0.f, 0.f, 0.f};
    bf16x8 At[4][2], B0[2][2], B1[2][2];
    i32x8 At8[4], B08[2], B18[2];
    const char* cA = (const char*)g.A + (size_t)cur.pm * tstepA; const char* cB = (const char*)g.Bt + (size_t)cur.pn * tstepB;
    if constexpr (GATHER) {
        PG8_GDMA(cur.pm); PG8_WAIT_V(0);
#pragma unroll
        for (int h = 0; h < 2; ++h)
#pragma unroll
            for (int i = 0; i < 2; ++i) { gvc[h][i] = PG8_GREAD(h, i); gvn[h][i] = gvc[h][i]; }
        PG8_WAIT_L(0);
    }
    PG8_STAGE(PG8_SB(0, 0), cB, voffB); PG8_STAGE_A(PG8_SA(0, 0), cA, 0, false); PG8_STAGE(PG8_SB(0, 1), cB + hstepB, voffB); PG8_STAGE_A(PG8_SA(0, 1), cA, 1, false);
    if (wr == 1) PG8_BAR;
    PG8_WAIT_V(4); PG8_BAR;
    PG8_STAGE(PG8_SB(1, 0), cB + kstep, voffB); PG8_STAGE_A(PG8_SA(1, 0), cA + kstep, 0, false); PG8_STAGE(PG8_SB(1, 1), cB + hstepB + kstep, voffB);
    PG8_WAIT_V(6); PG8_BAR;
    for (;;) {
        const bool has_next = S.next(ui + 1, nxt);
        if constexpr (GATHER) PG8_GDMA(has_next ? nxt.pm : cur.pm);
        const char* nA = has_next ? (const char*)g.A + (size_t)nxt.pm * tstepA : cA; const char* nB = has_next ? (const char*)g.Bt + (size_t)nxt.pn * tstepB : cB;
        for (int t = 0; t < nt; t += 2) {
            if constexpr (Hook::ENABLED) { if (t == 8 || t == 16) H(acc, cur, t >> 3, wr, wc, fr, fq); }
            const bool last = (t == nt - 2);
            const char* a1 = cA + (size_t)(t + 1) * kstep;
            const char* a2 = last ? nA : cA + (size_t)(t + 2) * kstep; const char* b2 = last ? nB : cB + (size_t)(t + 2) * kstep;
            const char* a3 = a2 + kstep; const char* b3 = b2 + kstep;
            if constexpr (GATHER) {
#pragma unroll
                for (int h = 0; h < 2; ++h)
#pragma unroll
                    for (int i = 0; i < 2; ++i) { gvn[h][i] = PG8_GREAD(h, i); gv2[h][i] = last ? gvn[h][i] : gvc[h][i]; }
            }
            PG8_LDB(B0, 0, 0); PG8_SCHED; PG8_LDA(At, 0, 0); PG8_STAGE_A(PG8_SA(1, 1), a1, 1, false);
            PG8_WAIT_L(8); PG8_BAR; PG8_WAIT_L(0); PG8_MMA(0, 0, At, B0); PG8_BAR; PG8_SCHED;
            PG8_LDB(B1, 0, 1); PG8_STAGE(PG8_SB(0, 0), b2, voffB);
            PG8_BAR; PG8_WAIT_L(0); PG8_MMA(0, 1, At, B1); PG8_BAR;
            PG8_LDA(At, 0, 1); PG8_STAGE_A(PG8_SA(0, 0), a2, 0, true);
            PG8_BAR; PG8_WAIT_L(0); PG8_MMA(1, 0, At, B0); PG8_BAR; PG8_SCHED;
            PG8_STAGE(PG8_SB(0, 1), b2 + hstepB, voffB);
            PG8_WAIT_V(6); PG8_BAR; PG8_MMA(1, 1, At, B1); PG8_BAR;
            PG8_LDB(B0, 1, 0); PG8_SCHED; PG8_LDA(At, 1, 0); PG8_STAGE_A(PG8_SA(0, 1), a2, 1, true);
            PG8_WAIT_L(8); PG8_BAR; PG8_WAIT_L(0); PG8_MMA(0, 0, At, B0); PG8_BAR; PG8_SCHED;
            PG8_LDB(B1, 1, 1); PG8_STAGE(PG8_SB(1, 0), b3, voffB);
            PG8_BAR; PG8_WAIT_L(0); PG8_MMA(0, 1, At, B1); PG8_BAR;
            PG8_LDA(At, 1, 1); PG8_STAGE_A(PG8_SA(1, 0), a3, 0, true);
            PG8_BAR; PG8_WAIT_L(0); PG8_MMA(1, 0, At, B0); PG8_BAR; PG8_SCHED;
            PG8_STAGE(PG8_SB(1, 1), b3 + hstepB, voffB);
            PG8_WAIT_V(6); PG8_BAR; PG8_MMA(1, 1, At, B1); PG8_BAR;
        }
        if constexpr (FP8) asm volatile("s_nop 15\n\ts_nop 15" ::: "memory");
        E(acc, cur, wr, wc, fr, fq);
        if (!has_next) break;
#pragma unroll
        for (int a = 0; a < 2; ++a)
#pragma unroll
            for (int b = 0; b < 2; ++b)
#pragma unroll
                for (int m = 0; m < 4; ++m)
#pragma unroll
                    for (int n = 0; n < 2; ++n) acc[a][b][m][n] = (f32x4){0.f, 0.f, 0.f, 0.f};
        cur = nxt; cA = nA; cB = nB; ++ui;
        if constexpr (GATHER) {
#pragma unroll
            for (int h = 0; h < 2; ++h)
#pragma unroll
                for (int i = 0; i < 2; ++i) gvc[h][i] = gvn[h][i];
        }
    }
    PG8_WAIT_V(0);
    if (wr == 0) PG8_BAR;
    PG8_BAR;
#undef PG8_SA
#undef PG8_SB
#undef PG8_STAGE
#undef PG8_STAGE_A
#undef PG8_GDMA
#undef PG8_GREAD
#undef PG8_LDA
#undef PG8_LD2
#undef PG8_LDB
#undef PG8_MMA
#undef PG8_WAIT_V
#undef PG8_WAIT_L
#undef PG8_BAR
#undef PG8_SCHED
}
struct LatOrder : StaticOrder { __device__ bool next(int i, Unit& u) const { if (!StaticOrder::next(i, u)) return false; u.pm += 1 + (u.pm >= 64 ? 1 : 0); return true; } };
struct MoeOrder : StaticOrder { __device__ bool next(int i, Unit& u) const { if (!StaticOrder::next(i, u)) return false; u.pn += (u.pm >> 4) * nN; return true; } };
template <class F> struct EpiAdapt { F f; int nN_local;
    __device__ __forceinline__ void operator()(const f32x4 (&acc)[2][2][4][2], const Unit& u, int wr, int wc, int fr, int fq) const {
        const int pnl = nN_local > 0 ? u.pn % nN_local : u.pn;
        const int row0 = u.pm * BM + wr * 64 + fr, col0 = pnl * BM + wc * 32 + 4 * fq;
        if constexpr (F::BATCH) {
#pragma unroll
            for (int ai = 0; ai < 2; ++ai)
#pragma unroll
                for (int mp = 0; mp < 2; ++mp) {
                    typename F::Pre pre[2][2][2];
#pragma unroll
                    for (int mm = 0; mm < 2; ++mm)
#pragma unroll
                        for (int bj = 0; bj < 2; ++bj)
#pragma unroll
                            for (int n = 0; n < 2; ++n) pre[mm][bj][n] = f.load(row0 + ai * HALF + (2 * mp + mm) * 16, col0 + bj * HALF + n * 16);
#pragma unroll
                    for (int mm = 0; mm < 2; ++mm)
#pragma unroll
                        for (int bj = 0; bj < 2; ++bj)
#pragma unroll
                            for (int n = 0; n < 2; ++n) f.apply(row0 + ai * HALF + (2 * mp + mm) * 16, col0 + bj * HALF + n * 16, acc[ai][bj][2 * mp + mm][n], pre[mm][bj][n]);
                }
        } else {
#pragma unroll
        for (int ai = 0; ai < 2; ++ai)
#pragma unroll
            for (int m = 0; m < 4; ++m)
#pragma unroll
                for (int bj = 0; bj < 2; ++bj)
#pragma unroll
                    for (int n = 0; n < 2; ++n) f.store4(row0 + ai * HALF + m * 16, col0 + bj * HALF + n * 16, acc[ai][bj][m][n]);
        }
    }
};
template <class F> struct EpiAdaptPair { F f; int nN_local;
    __device__ __forceinline__ void operator()(const f32x4 (&acc)[2][2][4][2], const Unit& u, int wr, int wc, int fr, int fq) const {
        const int pnl = u.pn % nN_local;
        const int row0 = u.pm * BM + wr * 64 + fr;
#pragma unroll
        for (int ai = 0; ai < 2; ++ai)
#pragma unroll
            for (int m = 0; m < 4; ++m)
#pragma unroll
                for (int bj = 0; bj < 2; ++bj) f.store_pair(row0 + ai * HALF + m * 16, (pnl * 8 + bj * 4 + wc) * 16 + 4 * fq, acc[ai][bj][m][0], acc[ai][bj][m][1]);
    }
};
}

DI f32x4 gate4(u32x2 g) { const float t = 9.094947e-13f; return (f32x4){fmaxf(lo_f(g.x), t), fmaxf(hi_f(g.x), t), fmaxf(lo_f(g.y), t), fmaxf(hi_f(g.y), t)}; }
struct MergeHook { static constexpr bool ENABLED = true; const bf16* G;
    DI void operator()(f32x4 (&acc)[2][2][4][2], const pg8::Unit& u, int seg, int wr, int wc, int fr, int fq) const {
        const int row0 = u.pm * 256 + wr * 64 + fr, col0 = u.pn * 256 + wc * 32 + 4 * fq;
#pragma unroll
        for (int ai = 0; ai < 2; ++ai)
#pragma unroll
            for (int mp = 0; mp < 2; ++mp) {
                u32x2 ga[2][2][2], gb[2][2][2];
#pragma unroll
                for (int mm = 0; mm < 2; ++mm)
#pragma unroll
                    for (int bj = 0; bj < 2; ++bj)
#pragma unroll
                        for (int n = 0; n < 2; ++n) { const bf16* gp = G + (size_t)(row0 + ai * 128 + (2 * mp + mm) * 16) * 3072 + (seg - 1) * 1024 + col0 + bj * 128 + n * 16;
                            ga[mm][bj][n] = *(const u32x2*)gp; gb[mm][bj][n] = *(const u32x2*)(gp + 1024); }
#pragma unroll
                for (int mm = 0; mm < 2; ++mm)
#pragma unroll
                    for (int bj = 0; bj < 2; ++bj)
#pragma unroll
                        for (int n = 0; n < 2; ++n) { const f32x4 a = gate4(ga[mm][bj][n]), b = gate4(gb[mm][bj][n]);
                            const f32x4 r = {a[0] * __builtin_amdgcn_rcpf(b[0]), a[1] * __builtin_amdgcn_rcpf(b[1]), a[2] * __builtin_amdgcn_rcpf(b[2]), a[3] * __builtin_amdgcn_rcpf(b[3])};
                            acc[ai][bj][2 * mp + mm][n] *= r; }
            }
    }
};
struct EpiMergeFinal { static constexpr bool PAIR = false, BATCH = true; const bf16* G; bf16* Mb;
    struct Pre { u32x2 g; };
    DI Pre load(int r, int c) const { Pre p; p.g = *(const u32x2*)(G + (size_t)r * 3072 + 2048 + c); return p; }
    DI void apply(int r, int c, f32x4 v, const Pre& p) const { const f32x4 m = v * gate4(p.g); u32x2 o; o.x = pk2(m[0], m[1]); o.y = pk2(m[2], m[3]); *(u32x2*)(Mb + (size_t)r * D + c) = o; }
    DI void store4(int r, int c, f32x4 v) const { apply(r, c, v, load(r, c)); } };

template <bool FP8 = false, class F>
DI void dense_gemm(const bf16* A, int lda, const bf16* Bt, int ldb, int N, int K, const F& f, unsigned char* lds, bool do_ctx = true) {
    const int tid = ltid();
    if (do_ctx) sgemm_phase<F, BSelNone, RowMapCtx, FP8>(A, lda, Bt, ldb, 512, N, K, f, BSelNone(), RowMapCtx());
    pg8::Gemm g{A, Bt, lda, ldb, K}; pg8::LatOrder S; S.init(128, N / 256, (int)gridDim.x, (int)blockIdx.x);
    pg8::EpiAdapt<F> E{f, 0};
    pg8::gemm_phase<pg8::EpiAdapt<F>, pg8::LatOrder, FP8>((PG8_LAS unsigned char*)lds, g, S, E, tid);
}

#define XB_TMO      128
#define XB_XCNT(j)  (256  + 64 * (j))
#define XB_XSUB(j)  (1280 + 64 * (j))
#define XB_XGEN(j)  (2304 + 64 * (j))
#define XB_TOP      3328
#define XB_TOPGEN   3392
#define XCD_BAR_WORDS 3456
#define XB_SPIN_CAP (1u << 18)
#define LAS __attribute__((address_space(3)))

__device__ __forceinline__ unsigned xb_ld(unsigned* p)              { return __hip_atomic_load(p, __ATOMIC_RELAXED, __HIP_MEMORY_SCOPE_AGENT); }
__device__ __forceinline__ unsigned xb_add(unsigned* p, unsigned v) { return __hip_atomic_fetch_add(p, v, __ATOMIC_RELAXED, __HIP_MEMORY_SCOPE_AGENT); }
__device__ __forceinline__ unsigned xb_xcc_id() { return (unsigned)__builtin_amdgcn_s_getreg((3 << 11) | 20) & 0xFu; }
#define XB_SPIN(cond, bar) do { unsigned _sp = 0; while (cond) { __builtin_amdgcn_s_sleep(1); \
    if ((++_sp & 255u) == 0u) { if (xb_ld(&(bar)[XB_TMO])) break; if (_sp > XB_SPIN_CAP) { atomicAdd(&(bar)[XB_TMO], 1u); break; } } } } while (0)

struct XcdBarrier {
    unsigned* bar; unsigned x;
    volatile LAS unsigned* st;
};

__device__ __forceinline__ XcdBarrier xcd_barrier_post(unsigned* bar, volatile LAS unsigned* st) {
    XcdBarrier b; b.bar = bar; b.x = xb_xcc_id(); b.st = st;
    if (threadIdx.x == 0) (void)xb_add(&bar[XB_XCNT(b.x)], 1u);
    return b;
}
__device__ __forceinline__ void xcd_barrier_complete(unsigned* bar, unsigned x, unsigned& nloc, unsigned& nx) {
    const unsigned G = gridDim.x * gridDim.y * gridDim.z;
    unsigned sum, cnt, mine, sp = 0u;
    for (;;) {
        sum = 0u; cnt = 0u; mine = 0u;
#pragma unroll
        for (unsigned j = 0; j < 16; ++j) { const unsigned c = xb_ld(&bar[XB_XCNT(j)]); sum += c; cnt += (c > 0u) ? 1u : 0u; mine = (j == x) ? c : mine; }
        if (sum == G) break;
        __builtin_amdgcn_s_sleep(1);
        if ((++sp & 255u) == 0u) { if (xb_ld(&bar[XB_TMO])) break; if (sp > XB_SPIN_CAP) { atomicAdd(&bar[XB_TMO], 1u); break; } }
    }
    nloc = mine > 0u ? mine : 1u; nx = cnt > 0u ? cnt : 1u;
}

__device__ __forceinline__ void xcd_barrier(const XcdBarrier& b) {
    asm volatile("s_waitcnt vmcnt(0)" ::: "memory");
    __syncthreads();
    if (threadIdx.x == 0) {
        unsigned* bar = b.bar;
        __builtin_amdgcn_s_waitcnt(0);
        unsigned nloc = b.st[0], nx = b.st[1];
        if (nloc == 0u) { xcd_barrier_complete(bar, b.x, nloc, nx); b.st[0] = nloc; b.st[1] = nx; }
        const unsigned old = xb_add(&bar[XB_XSUB(b.x)], 1u);
        const unsigned gen = old / nloc;
        if (old + 1u == (gen + 1u) * nloc) {
            __builtin_amdgcn_fence(__ATOMIC_RELEASE, "agent");
            asm volatile("s_waitcnt vmcnt(0)" ::: "memory");
            const unsigned og = xb_add(&bar[XB_TOP], 1u);
            const unsigned tg = og / nx;
            if (og + 1u == (tg + 1u) * nx) xb_add(&bar[XB_TOPGEN], 1u);
            else XB_SPIN(xb_ld(&bar[XB_TOPGEN]) == tg, bar);
            __builtin_amdgcn_fence(__ATOMIC_ACQUIRE, "agent");
            xb_add(&bar[XB_XGEN(b.x)], 1u);
            asm volatile("s_waitcnt vmcnt(0)" ::: "memory");
        } else {
            XB_SPIN(xb_ld(&bar[XB_XGEN(b.x)]) == gen, bar);
            __builtin_amdgcn_fence(__ATOMIC_ACQUIRE, "agent");
            asm volatile("s_waitcnt vmcnt(0)" ::: "memory");
        }
    }
    __syncthreads();
}


__device__ __forceinline__ void xcd_barrier_fill(const XcdBarrier& b, const Params& p, unsigned char* ldsb, int flayer) {
    asm volatile("s_waitcnt vmcnt(0)" ::: "memory");
    __syncthreads();
    unsigned gen = 0u;
    if (threadIdx.x == 0) {
        unsigned* bar = b.bar;
        __builtin_amdgcn_s_waitcnt(0);
        unsigned nloc = b.st[0], nx = b.st[1];
        if (nloc == 0u) { xcd_barrier_complete(bar, b.x, nloc, nx); b.st[0] = nloc; b.st[1] = nx; }
        const unsigned old = xb_add(&bar[XB_XSUB(b.x)], 1u);
        gen = old / nloc;
        if (old + 1u == (gen + 1u) * nloc) {
            __builtin_amdgcn_fence(__ATOMIC_RELEASE, "agent");
            asm volatile("s_waitcnt vmcnt(0)" ::: "memory");
            const unsigned og = xb_add(&bar[XB_TOP], 1u);
            const unsigned tg = og / nx;
            if (og + 1u == (tg + 1u) * nx) xb_add(&bar[XB_TOPGEN], 1u);
            else XB_SPIN(xb_ld(&bar[XB_TOPGEN]) == tg, bar);
            __builtin_amdgcn_fence(__ATOMIC_ACQUIRE, "agent");
            xb_add(&bar[XB_XGEN(b.x)], 1u);
            asm volatile("s_waitcnt vmcnt(0)" ::: "memory");
            b.st[2] = 0u;
        } else {
            b.st[2] = (old - gen * nloc) * 2u < nloc ? 2u : 1u;
        }
    }
    __syncthreads();
    const unsigned mode = b.st[2];
    if (mode == 2u) {
        unsigned char* ws_ = lws(p); unsigned* cctr = (unsigned*)(ws_ + WS_CTL) + 10 + flayer;
        const int tid = ltid();
        for (;;) {
            __syncthreads();
            if (threadIdx.x == 0) {
                unsigned* bar = b.bar; const unsigned nloc = b.st[0];
                const bool rel = xb_ld(&bar[XB_XGEN(b.x)]) != gen;
                const bool allhere = xb_ld(&bar[XB_XSUB(b.x)]) >= (gen + 1u) * nloc;
                int g = -1;
                if (!rel && !allhere) g = (int)__hip_atomic_fetch_add(cctr, 8u, __ATOMIC_RELAXED, __HIP_MEMORY_SCOPE_AGENT);
                b.st[3] = (unsigned)g;
            }
            __syncthreads();
            const int g0 = (int)b.st[3];
            if (g0 < 0 || g0 >= MOE_TILES) break;
            cvt_moe_tile(p, ws_, flayer, g0 + (tid >> 6), (float*)ldsb, tid);
        }
    }
    if (threadIdx.x == 0 && mode != 0u) {
        unsigned* bar = b.bar;
        XB_SPIN(xb_ld(&bar[XB_XGEN(b.x)]) == gen, bar);
        __builtin_amdgcn_fence(__ATOMIC_ACQUIRE, "agent");
        asm volatile("s_waitcnt vmcnt(0)" ::: "memory");
    }
    __syncthreads();
}

template <int PH> DI void run_phase(const Params& p, int layer, unsigned char* lds) {
    unsigned char* const ws_ = lws(p);
    const bf16* H = (const bf16*)(ws_ + WS_H);
    if constexpr (PH == 0) { phase_cvt(p, (float*)lds, 0, 8, blockIdx.x * 8, gridDim.x * 8, true); phase_cvt(p, (float*)lds, 56, 64, blockIdx.x * 8, gridDim.x * 8, false); }
    if constexpr (PH == 1) { phase_mod(p, (float*)lds); }
    if constexpr (PH == 2) { phase_tables(p); }
    if constexpr (PH == 3) { if (layer == 0) phase_lnmod1(p, layer); }
    if constexpr (PH == 4) {
        if (FP8_INPROJ) { EpiStoreBf16 E{(bf16*)(ws_ + R_Z), ZLD, 1.f / WD_SCALE}; dense_gemm<true>(H, 512, (const bf16*)(ws_ + WS_BT_IN + (size_t)layer * ZLD * 1024), 512, ZLD, 512, E, lds); }
        else { EpiStoreBf16 E{(bf16*)(ws_ + R_Z), ZLD, 1.f}; dense_gemm(H, D, (const bf16*)(ws_ + WS_BT_IN) + (size_t)layer * ZLD * 1024, 1024, ZLD, 1024, E, lds); } }
    if constexpr (PH == 5) { phase_prep1(p, layer); }
    if constexpr (PH == 6) { EpiStoreBf16 E{(bf16*)(ws_ + R_QRAW), 768, 1.f}; dense_gemm((const bf16*)(ws_ + R_Z) + ZO_CQ, ZLD, (const bf16*)(ws_ + WS_BT_UQ) + (size_t)layer * 768 * 256, 256, 768, 256, E, lds);
              EpiStoreBf16 E2{(bf16*)(ws_ + R_KVRAW), 1024, 1.f}; dense_gemm((const bf16*)(ws_ + R_Z) + ZO_CKV, ZLD, (const bf16*)(ws_ + WS_BT_UKV) + (size_t)layer * 1024 * 256, 256, 1024, 256, E2, lds); }
    if constexpr (PH == 7) { phase_prep2(p, layer); }
    if constexpr (PH == 8) { phase_attn(p, layer, lds); }
    if constexpr (PH == 9) { phase_diffcomb(p, layer);
        if (FP8_GATE) { EpiGate E{(bf16*)(ws_ + R_G), p.in[21] + layer * 3072, 1.f / WD_SCALE}; dense_gemm<true>(H, 512, (const bf16*)(ws_ + WS_BT_GATE + (size_t)layer * 3072 * 1024), 512, 3072, 512, E, lds, layer == 0); }
        else { EpiGate E{(bf16*)(ws_ + R_G), p.in[21] + layer * 3072, 1.f}; dense_gemm(H, D, (const bf16*)(ws_ + WS_BT_GATE) + (size_t)layer * 3072 * 1024, 1024, 3072, 1024, E, lds, layer == 0); } }
    if constexpr (PH == 11) { const bf16* G = (const bf16*)(ws_ + R_G); bf16* Mp = (bf16*)(ws_ + R_M32); bf16* Mb = (bf16*)(ws_ + R_M);
               const bf16* Y = (const bf16*)(ws_ + R_YA); const bf16* Bb = (const bf16*)(ws_ + WS_BT_BR) + (size_t)layer * 1024 * 1536;
               if (layer == 0) {
                   { EpiMerge<0> E{G, Mp, Mb}; sgemm_phase(Y, 1536, Bb, 1536, 512, 1024, 512, E, BSelNone(), RowMapCtx()); }
                   { EpiMerge<1> E{G, Mp, Mb}; sgemm_phase(Y + 512, 1536, Bb + 512, 1536, 512, 1024, 512, E, BSelNone(), RowMapCtx()); }
                   { EpiMerge<2> E{G, Mp, Mb}; sgemm_phase(Y + 1024, 1536, Bb + 1024, 1536, 512, 1024, 512, E, BSelNone(), RowMapCtx()); } }
               const int tid = ltid(); pg8::Gemm g{Y, Bb, 1536, 1536, 1536}; pg8::LatOrder S; S.init(128, 4, (int)gridDim.x, (int)blockIdx.x);
               EpiMergeFinal EF{G, Mb}; pg8::EpiAdapt<EpiMergeFinal> E{EF, 0}; MergeHook H{G};
               pg8::gemm_phase<pg8::EpiAdapt<EpiMergeFinal>, pg8::LatOrder, false, MergeHook>((PG8_LAS unsigned char*)lds, g, S, E, tid, H); }
    if constexpr (PH == 12) { EpiOut E{p.in[0], p.in[2], layer, (const float*)(ws_ + WS_MOD) + (size_t)layer * 3 * 6144, (float*)(ws_ + WS_X)};
               dense_gemm((const bf16*)(ws_ + R_M), D, (const bf16*)(ws_ + WS_BT_OUT) + (size_t)layer * 1024 * 1024, 1024, 1024, 1024, E, lds, layer == 0); }
    if constexpr (PH == 13) { phase_ln1_router(p, layer, (float*)lds); }
    if constexpr (PH == 14) {
        phase_topk(p, (unsigned*)lds); __syncthreads();
        {
            unsigned* cctr = (unsigned*)(ws_ + WS_CTL) + 10 + layer; const int tid = ltid();
            volatile LAS unsigned* slot = (volatile LAS unsigned*)(lds + 8 * 64 * 65 * 4  ) + 2;
            unsigned pend = 0u; if (tid == 0) pend = __hip_atomic_fetch_add(cctr, 8u, __ATOMIC_RELAXED, __HIP_MEMORY_SCOPE_AGENT);
            int par = 0;
            for (;;) {
                unsigned nxt = 0u;
                if (tid == 0) { slot[par] = pend; nxt = __hip_atomic_fetch_add(cctr, 8u, __ATOMIC_RELAXED, __HIP_MEMORY_SCOPE_AGENT); }
                __syncthreads();
                const int g0 = (int)slot[par]; par ^= 1;
                if (g0 >= MOE_TILES) break;
                cvt_moe_tile(p, ws_, layer, g0 + (tid >> 6), (float*)lds, tid);
                pend = nxt;
            }
            __syncthreads();
        } }
    if constexpr (PH == 15) { phase_gather(p); }
    if constexpr (PH == 16) { EpiAct E{ws_ + R_ACT}; BSelMoe bs{(size_t)5632 * 512};
               const bf16* A = (const bf16*)(ws_ + WS_H); const bf16* Bt = (const bf16*)(ws_ + WS_BT_M1 + (size_t)layer * NE * 5632 * 1024); const int* selrow = (const int*)(ws_ + WS_SELROW);
               if (layer == 0) sgemm_phase<EpiAct, BSelMoe, RowMapOff, true>(A, 512, Bt, 512, NSLOT - NSLOT_L, 5632, 512, E, bs, RowMapOff{NSLOT_L}, selrow);
               const int tid = ltid(); pg8::Gemm g{A, Bt, 512, 512, 512}; pg8::MoeOrder S; S.init(256, 22, (int)gridDim.x, (int)blockIdx.x); pg8::EpiAdaptPair<EpiAct> EA{E, 22};
               pg8::gemm_phase<pg8::EpiAdaptPair<EpiAct>, pg8::MoeOrder, true, pg8::NoHook, true>((PG8_LAS unsigned char*)lds, g, S, EA, tid, pg8::NoHook(), selrow); }
    if constexpr (PH == 17) { EpiDown E{(bf16*)(ws_ + R_XSEL), (const float*)(ws_ + WS_SELW)}; BSelMoe bs{(size_t)1024 * (FF / 2)};
               const bf16* A = (const bf16*)(ws_ + R_ACT); const bf16* Bt = (const bf16*)(ws_ + WS_BT_M2 + (size_t)layer * NE * 1024 * FF);
               if (layer == 0) sgemm_phase<EpiDown, BSelMoe, RowMapOff, true>(A, FF / 2, Bt, FF / 2, NSLOT - NSLOT_L, 1024, FF / 2, E, bs, RowMapOff{NSLOT_L});
               const int tid = ltid(); pg8::Gemm g{A, Bt, FF / 2, FF / 2, FF / 2}; pg8::MoeOrder S; S.init(256, 4, (int)gridDim.x, (int)blockIdx.x); pg8::EpiAdapt<EpiDown> EA{E, 4};
               pg8::gemm_phase<pg8::EpiAdapt<EpiDown>, pg8::MoeOrder, true>((PG8_LAS unsigned char*)lds, g, S, EA, tid); }
    if constexpr (PH == 18) { phase_combine_ln2(p, layer, (float*)lds); }
}

#define GRID_BAR() do { unsigned char* w_ = lws(p); XcdBarrier b_; b_.bar = (unsigned*)(w_ + WS_CTL); b_.x = xb_xcc_id(); b_.st = xbw; xcd_barrier(b_); } while (0)
#define GRID_BAR_F(fl) do { unsigned char* w_ = lws(p); XcdBarrier b_; b_.bar = (unsigned*)(w_ + WS_CTL); b_.x = xb_xcc_id(); b_.st = xbw; xcd_barrier_fill(b_, p, lds, fl); } while (0)
constexpr int LDS_MAIN = 8 * 64 * 65 * 4  , LDS_BYTES = LDS_MAIN + 16;
__global__ void __launch_bounds__(NWG_THREADS, 2) k_mega(Params p) {
    extern __shared__ __attribute__((aligned(16))) unsigned char lds[];
    volatile LAS unsigned* xbw = (volatile LAS unsigned*)(lds + LDS_MAIN);
    if (threadIdx.x == 0) { xbw[0] = 0u; xbw[1] = 0u; xbw[2] = 0u; xbw[3] = 0u; }
    __syncthreads();
    (void)xcd_barrier_post((unsigned*)(p.ws + WS_CTL), xbw);
    run_phase<0>(p, 0, lds); run_phase<1>(p, 0, lds); run_phase<2>(p, 0, lds);
    GRID_BAR_F(0);
#define LAYER_BODY(l) do { \
        run_phase<3>(p, l, lds); GRID_BAR(); \
        run_phase<4>(p, l, lds); GRID_BAR_F(l); \
        run_phase<5>(p, l, lds); \
        run_phase<6>(p, l, lds); GRID_BAR_F(l); \
        run_phase<7>(p, l, lds); GRID_BAR(); \
        run_phase<8>(p, l, lds); GRID_BAR_F(l); \
        run_phase<9>(p, l, lds); GRID_BAR_F(l); \
        run_phase<11>(p, l, lds); GRID_BAR_F(l); \
        run_phase<12>(p, l, lds); GRID_BAR_F(l); \
        run_phase<13>(p, l, lds); GRID_BAR_F(l); \
        run_phase<14>(p, l, lds); GRID_BAR(); \
        run_phase<16>(p, l, lds); if ((l) == 0) GRID_BAR_F(1); else GRID_BAR(); \
        run_phase<17>(p, l, lds); if ((l) == 0) GRID_BAR_F(1); else GRID_BAR(); \
        run_phase<18>(p, l, lds); \
    } while (0)
    LAYER_BODY(0);
    LAYER_BODY(1);
#undef LAYER_BODY
}

extern "C" void kernel_launch(void* const* d_in, const int* in_sizes, int n_in, void* d_out, int out_size, void* d_ws, size_t ws_size, hipStream_t stream) {
    if (n_in != 31 || ws_size < WS_TOTAL) { fprintf(stderr, "kernel_launch: need 31 inputs and %zu bytes of workspace (got %d, %zu)\n", (size_t)WS_TOTAL, n_in, ws_size); return; }
    static int grid = 0;
    if (!grid) {
        int dev = 0, cus = 0, per_cu = 0;
        (void)hipGetDevice(&dev);
        (void)hipDeviceGetAttribute(&cus, hipDeviceAttributeMultiprocessorCount, dev);
        (void)hipFuncSetAttribute((const void*)k_mega, hipFuncAttributeMaxDynamicSharedMemorySize, LDS_BYTES);
        (void)hipOccupancyMaxActiveBlocksPerMultiprocessor(&per_cu, (const void*)k_mega, NWG_THREADS, LDS_BYTES);
        if (per_cu < 1) { fprintf(stderr, "kernel_launch: occupancy query reports %d blocks per CU\n", per_cu); per_cu = 1; }
        grid = cus * 1;
        if (grid <= 0) grid = 256;
    }
    Params p; memset(&p, 0, sizeof(p));
    for (int i = 0; i < 31; ++i) p.in[i] = (const float*)d_in[i];
    p.out = (float*)d_out; p.ws = (unsigned char*)d_ws;
    (void)hipMemsetAsync(d_ws, 0, 65536, stream);
    hipLaunchKernelGGL(k_mega, dim3(grid), dim3(NWG_THREADS), LDS_BYTES, stream, p);
}
```

```cpp
#include <hip/hip_runtime.h>
#include <stdint.h>
#include <stdio.h>
#include <string.h>

typedef unsigned short bf16;
typedef short bf16x8 __attribute__((ext_vector_type(8)));
typedef float f32x2 __attribute__((ext_vector_type(2)));
typedef float f32x4 __attribute__((ext_vector_type(4)));
typedef float f32x16 __attribute__((ext_vector_type(16)));
typedef unsigned u32x2 __attribute__((ext_vector_type(2)));
typedef unsigned u32x4 __attribute__((ext_vector_type(4)));
typedef __bf16 bf16x2_t __attribute__((ext_vector_type(2)));
#define DI __device__ __forceinline__
#define MFMA32(a, b, c) __builtin_amdgcn_mfma_f32_32x32x16_bf16((a), (b), (c), 0, 0, 0)

constexpr int D = 1024, NB = 2, SEQ = 16384, CTX = 256, TPB = SEQ + CTX  , MROWS = NB * TPB  ;
constexpr int GRID_W = 64, KGPB = TPB / 32  , NKG = MROWS / 32  ;
constexpr int IN_DIM = 3488, ZLD = 3584;
constexpr int ZO_AQ = 0, ZO_AK = 512, ZO_AV = 1024, ZO_CQ = 1536, ZO_CKV = 1792, ZO_KR = 1920, ZO_DQ = 1952, ZO_DK = 2464, ZO_DV = 2976;
constexpr int NE = 16, FF = 2816, CAP_L = 2048, CAP_C = 32, NSLOT_L = NE * NB * CAP_L  , NSLOT = NSLOT_L + NE * NB * CAP_C  ;
constexpr float LOG2E = 1.4426950408889634f;
constexpr float ALPHA = 1.4142135623730951f;
constexpr float EPS = 1e-6f;
constexpr int NWG_THREADS = 512;

constexpr size_t al256(size_t x) { return (x + 255) & ~(size_t)255; }
constexpr size_t WS_CTL = 0;
constexpr size_t WS_KMAX = 16384;
constexpr size_t WS_MOD = 65536;
constexpr size_t WS_ROPE = WS_MOD + al256(2 * 3 * 6144 * 4);
constexpr size_t ROPE_MROW = 0, ROPE_MCOL = 256 * 16, ROPE_DROW = ROPE_MCOL + 64 * 16, ROPE_DCOL = ROPE_DROW + 256 * 32, ROPE_FLOATS = ROPE_DCOL + 64 * 32;
constexpr size_t WS_LAM = WS_ROPE + al256(ROPE_FLOATS * 4);
constexpr size_t WS_BIAS = WS_LAM + 256;
constexpr size_t BIAS_TILE = 64 * 16;
constexpr size_t WS_BT_IN = WS_BIAS + al256((size_t)2 * 8 * 15 * 4 * BIAS_TILE * 4);
constexpr size_t WS_BT_GATE = WS_BT_IN + (size_t)2 * ZLD * 1024 * 2;
constexpr size_t WS_BT_BR = WS_BT_GATE + (size_t)2 * 3072 * 1024 * 2;
constexpr size_t WS_BT_OUT = WS_BT_BR + (size_t)2 * 3 * 1024 * 512 * 2;
constexpr size_t WS_BT_UQ = WS_BT_OUT + (size_t)2 * 1024 * 1024 * 2;
constexpr size_t WS_BT_UKV = WS_BT_UQ + (size_t)2 * 768 * 256 * 2;
constexpr size_t WS_BT_M1 = WS_BT_UKV + (size_t)2 * 1024 * 256 * 2;
constexpr size_t WS_BT_M2 = WS_BT_M1 + (size_t)2 * NE * 5632 * 1024;
constexpr size_t WS_X = WS_BT_M2 + (size_t)2 * NE * 1024 * FF;
constexpr size_t WS_H = WS_X + (size_t)MROWS * D * 4;
constexpr size_t WS_INVRMS = WS_H + (size_t)MROWS * D * 2;
constexpr size_t WS_KROPE = WS_INVRMS + al256((size_t)MROWS * 2 * 4);
constexpr size_t WS_AFF = WS_KROPE + (size_t)MROWS * 32 * 4;
constexpr size_t WS_SELROW = WS_AFF + (size_t)(2 * 16 * 16384 + 2 * 16 * 256) * 4;
constexpr size_t WS_SELW = WS_SELROW + (size_t)NSLOT * 4;
constexpr size_t WS_SLOTOF = WS_SELW + (size_t)NSLOT * 4;
constexpr size_t WS_QN = WS_SLOTOF + (size_t)MROWS * 16 * 4;
constexpr size_t WS_R1 = WS_QN + (size_t)2 * MROWS * 8 * 4;
constexpr size_t SZ512 = (size_t)MROWS * 512 * 2, SZ768 = (size_t)MROWS * 768 * 2, SZ1024 = (size_t)MROWS * 1024 * 2;
constexpr size_t R_Z = WS_R1;
constexpr size_t R_QNA = R_Z + (size_t)MROWS * ZLD * 2, R_KFNA = R_QNA + SZ512, R_VFNA = R_KFNA + SZ512, R_QD = R_VFNA + SZ512, R_KFD = R_QD + SZ512, R_VFD = R_KFD + SZ512;
constexpr size_t R_QRAW = R_VFD + SZ512, R_KVRAW = R_QRAW + SZ768, R_END = R_KVRAW + SZ1024;
constexpr size_t R_QMLA = WS_R1, R_KFMLA = R_QMLA + SZ768, R_VFMLA = R_KFMLA + SZ768, R_OD = R_VFMLA + SZ512;
static_assert(R_OD + SZ1024 <= R_QNA, "alias map");
constexpr size_t R_G = R_END;
constexpr size_t R_M32 = R_QNA, R_M = R_M32 + (size_t)MROWS * D * 4;
static_assert(R_M + SZ1024 <= R_QRAW, "alias map");
constexpr size_t R_YA = R_QRAW, R_YB = R_YA + SZ512, R_YC = R_YB + SZ512;
static_assert(R_YC + SZ512 <= R_END, "alias map");
constexpr size_t R_XSEL = WS_R1, R_ACT = R_XSEL + (size_t)NSLOT * D * 2;
static_assert(R_ACT + (size_t)NSLOT * FF * 2 <= R_END, "alias map");
constexpr size_t WS_TOTAL = R_G + (size_t)MROWS * 3072 * 2;

struct Params { const float* in[31]; float* out; unsigned char* ws; };

DI float bf2f(bf16 v) { return __uint_as_float((unsigned)v << 16); }
DI unsigned pk2(float a, float b) { f32x2 v = {a, b}; bf16x2_t r = __builtin_convertvector(v, bf16x2_t); return __builtin_bit_cast(unsigned, r); }
DI bf16 f2bf(float a) { return (bf16)(pk2(a, 0.f) & 0xffffu); }
DI float lo_f(unsigned u) { return __uint_as_float(u << 16); }
DI float hi_f(unsigned u) { return __uint_as_float(u & 0xffff0000u); }
DI float wave_sum(float v) {
#pragma unroll
    for (int o = 32; o >= 1; o >>= 1) v += __shfl_xor(v, o);
    return v;
}
DI float wave_max(float v) {
#pragma unroll
    for (int o = 32; o >= 1; o >>= 1) v = fmaxf(v, __shfl_xor(v, o));
    return v;
}
DI int ltid() { int t = threadIdx.x; asm volatile("" : "+v"(t)); return t; }
DI unsigned char* lws(const Params& p) {
    const unsigned long long w = (unsigned long long)p.ws; unsigned lo, hi;
    asm volatile("v_mov_b32 %0, %2\n\tv_mov_b32 %1, %3" : "=v"(lo), "=v"(hi) : "s"((unsigned)w), "s"((unsigned)(w >> 32)));
    lo = __builtin_amdgcn_readfirstlane(lo); hi = __builtin_amdgcn_readfirstlane(hi);
    typedef __attribute__((address_space(1))) unsigned char* gptr_t;
    return (unsigned char*)(gptr_t)(((unsigned long long)hi << 32) | lo);
}
DI int gwave(int tid) { return blockIdx.x * 8 + (tid >> 6); }
DI int nwaves() { return gridDim.x * 8; }
DI float sigmoidf_(float x) { return __builtin_amdgcn_rcpf(1.f + __builtin_amdgcn_exp2f(-x * LOG2E)); }

DI bf16x8 scale8(bf16x8 v, float s) {
    u32x4 u = __builtin_bit_cast(u32x4, v), o;
#pragma unroll
    for (int i = 0; i < 4; ++i) o[i] = pk2(lo_f(u[i]) * s, hi_f(u[i]) * s);
    return __builtin_bit_cast(bf16x8, o);
}
DI void unpack8(bf16x8 v, float (&f)[8]) { const u32x4 u = __builtin_bit_cast(u32x4, v);
#pragma unroll
    for (int i = 0; i < 4; ++i) { f[2 * i] = lo_f(u[i]); f[2 * i + 1] = hi_f(u[i]); } }
DI bf16x8 pack8(const float (&f)[8]) { u32x4 o;
#pragma unroll
    for (int i = 0; i < 4; ++i) o[i] = pk2(f[2 * i], f[2 * i + 1]);
    return __builtin_bit_cast(bf16x8, o); }
DI float sumsq8(const float (&f)[8]) { float s = 0.f;
#pragma unroll
    for (int i = 0; i < 8; ++i) s += f[i] * f[i];
    return s; }
DI float sumsq8p(bf16x8 v) { float f[8]; unpack8(v, f); return sumsq8(f); }


typedef int i32x8 __attribute__((ext_vector_type(8)));
DI unsigned pk4_fp8(float a, float b, float c, float d) { int w = __float_as_int(a); w = __builtin_amdgcn_cvt_pk_fp8_f32(a, b, w, false); w = __builtin_amdgcn_cvt_pk_fp8_f32(c, d, w, true); return (unsigned)w; }
DI unsigned pk4_bf8(float a, float b, float c, float d) { int w = __float_as_int(a); w = __builtin_amdgcn_cvt_pk_bf8_f32(a, b, w, false); w = __builtin_amdgcn_cvt_pk_bf8_f32(c, d, w, true); return (unsigned)w; }
DI u32x4 pk16_fp8(const float* f) { u32x4 o;
#pragma unroll
    for (int i = 0; i < 4; ++i) o[i] = pk4_fp8(f[4 * i], f[4 * i + 1], f[4 * i + 2], f[4 * i + 3]);
    return o; }
DI i32x8 cat8(bf16x8 a, bf16x8 b) { const u32x4 x = __builtin_bit_cast(u32x4, a), y = __builtin_bit_cast(u32x4, b); return (i32x8){(int)x[0], (int)x[1], (int)x[2], (int)x[3], (int)y[0], (int)y[1], (int)y[2], (int)y[3]}; }
#define MFMA8(a, b, c, fa, fb) __builtin_amdgcn_mfma_scale_f32_32x32x64_f8f6f4((a), (b), (c), (fa), (fb), 0, 0x7f7f7f7f, 0, 0x7f7f7f7f)
DI int kappa(int h, int j) { return (j >> 4) * 32 + (j & 3) + 8 * ((j & 15) >> 2) + 4 * h; }
constexpr bool FP8_INPROJ = true, FP8_GATE = true;
constexpr float WD_SCALE = 32.f;
constexpr float W1_SCALE = 32.f, W2_SCALE = 64.f, ACT_SCALE = 4.f;
constexpr float SQC_D = 2.f * 0.42466090014400953f;
constexpr float SQC_M = 2.f * 0.38372760731440503f;

DI int mod_row_of(int row) { const int b = row / TPB, t = row - b * TPB; return t < CTX ? 2 : b; }
DI const float* x_src_row(const float* xin, const float* cin, const float* xbuf, int layer, int row) {
    if (layer > 0) return xbuf + (size_t)row * D;
    const int b = row / TPB, t = row - b * TPB;
    return t < CTX ? cin + ((size_t)b * CTX + t) * D : xin + ((size_t)b * SEQ + (t - CTX)) * D;
}

struct CvtJob { const float* src; bf16* dst; const float* scale; int K, N, ld_dst, nmul, nadd, fp8  ; float wscale; };
DI bool get_job(const Params& p, unsigned char* ws_, int j, CvtJob& J) {
    const int l = j / 56, r = j % 56;
    if (l >= 2) return false;
    J.scale = nullptr; J.nmul = 1; J.nadd = 0; J.fp8 = 0; J.wscale = 1.f;
    if (r == 0) { J.src = p.in[6] + (size_t)l * 1024 * IN_DIM; J.K = 1024; J.N = IN_DIM;
        if (FP8_INPROJ) { J.dst = (bf16*)(ws_ + WS_BT_IN + (size_t)l * ZLD * 1024); J.ld_dst = 1024; J.fp8 = 3; J.wscale = WD_SCALE; }
        else { J.dst = (bf16*)(ws_ + WS_BT_IN) + (size_t)l * ZLD * 1024; J.ld_dst = 1024; } }
    else if (r == 1) { J.src = p.in[20] + (size_t)l * 1024 * 3072; J.K = 1024; J.N = 3072;
        if (FP8_GATE) { J.dst = (bf16*)(ws_ + WS_BT_GATE + (size_t)l * 3072 * 1024); J.ld_dst = 1024; J.fp8 = 3; J.wscale = WD_SCALE; }
        else { J.dst = (bf16*)(ws_ + WS_BT_GATE) + (size_t)l * 3072 * 1024; J.ld_dst = 1024; } }
    else if (r <= 4) { J.src = p.in[17 + (r - 2)] + (size_t)l * 512 * 1024; J.dst = (bf16*)(ws_ + WS_BT_BR) + (size_t)l * 1024 * 1536 + (r - 2) * 512; J.K = 512; J.N = 1024; J.ld_dst = 1536; }
    else if (r == 5) { J.src = p.in[22] + (size_t)l * 1024 * 1024; J.dst = (bf16*)(ws_ + WS_BT_OUT) + (size_t)l * 1024 * 1024; J.K = 1024; J.N = 1024; J.ld_dst = 1024; }
    else if (r == 6) { J.src = p.in[10] + (size_t)l * 256 * 768; J.dst = (bf16*)(ws_ + WS_BT_UQ) + (size_t)l * 768 * 256; J.K = 256; J.N = 768; J.ld_dst = 256; J.scale = p.in[8] + l * 256; }
    else if (r == 7) { J.src = p.in[11] + (size_t)l * 128 * 1024; J.dst = (bf16*)(ws_ + WS_BT_UKV) + (size_t)l * 1024 * 256; J.K = 128; J.N = 1024; J.ld_dst = 256; J.scale = p.in[9] + l * 128; }
    else {
        const int q = r - 8, e = q / 3, w = q % 3;
        unsigned char* m1 = ws_ + WS_BT_M1 + ((size_t)l * NE + e) * 5632 * 1024; unsigned char* m2 = ws_ + WS_BT_M2 + ((size_t)l * NE + e) * 1024 * FF;
        if (w == 0) { J.src = p.in[26] + ((size_t)l * NE + e) * 1024 * FF; J.dst = (bf16*)m1; J.K = 1024; J.N = FF; J.ld_dst = 1024; J.fp8 = 1; J.wscale = W1_SCALE; }
        else if (w == 1) { J.src = p.in[27] + ((size_t)l * NE + e) * 1024 * FF; J.dst = (bf16*)m1; J.K = 1024; J.N = FF; J.ld_dst = 1024; J.fp8 = 2; J.wscale = W1_SCALE; }
        else { J.src = p.in[28] + ((size_t)l * NE + e) * FF * 1024; J.dst = (bf16*)m2; J.K = FF; J.N = 1024; J.ld_dst = FF; J.fp8 = 3; J.wscale = W2_SCALE; }
    }
    return true;
}
DI void cvt_tile(const CvtJob& J, int t, int tn, float* lw, int lane) {
    const int k0 = (t / tn) * 64, n0 = (t % tn) * 64;
    const int r4 = lane >> 4, c4 = (lane & 15) * 4;
    f32x4 v[16];
    const bool full = n0 + 64 <= J.N;
#pragma unroll
    for (int i = 0; i < 16; ++i) {
        const float* sp = J.src + (size_t)(k0 + i * 4 + r4) * J.N + n0 + c4;
        if (full || n0 + c4 + 3 < J.N) v[i] = __builtin_nontemporal_load((const f32x4*)sp); else v[i] = (f32x4){0.f, 0.f, 0.f, 0.f};
    }
    if (J.scale) {
#pragma unroll
        for (int i = 0; i < 16; ++i) v[i] *= J.scale[k0 + i * 4 + r4];
    }
#pragma unroll
    for (int i = 0; i < 16; ++i) { float* d = lw + (i * 4 + r4) * 65 + c4; d[0] = v[i][0]; d[1] = v[i][1]; d[2] = v[i][2]; d[3] = v[i][3]; }
    asm volatile("s_waitcnt lgkmcnt(0)" ::: "memory");
    const int g = lane & 7, ns = lane >> 3;
#pragma unroll
    for (int nb = 0; nb < 8; ++nb) {
        const int nn = nb * 8 + ns;
        float f[8];
#pragma unroll
        for (int q = 0; q < 8; ++q) f[q] = lw[(g * 8 + q) * 65 + nn];
        if (n0 + nn < J.N) {
            if (J.fp8 == 0) *(bf16x8*)(J.dst + (size_t)((n0 + nn) * J.nmul + J.nadd) * J.ld_dst + k0 + g * 8) = pack8(f);
            else {
                const int nsrc = n0 + nn, nrow = J.fp8 == 3 ? nsrc : (nsrc >> 4) * 32 + (J.fp8 == 2 ? 16 : 0) + (nsrc & 15);
                u32x2 o; o.x = pk4_fp8(f[0] * J.wscale, f[1] * J.wscale, f[2] * J.wscale, f[3] * J.wscale); o.y = pk4_fp8(f[4] * J.wscale, f[5] * J.wscale, f[6] * J.wscale, f[7] * J.wscale);
                __builtin_nontemporal_store(o, (u32x2*)((unsigned char*)J.dst + (size_t)nrow * J.ld_dst + k0 + g * 8));
            }
        }
    }
    asm volatile("s_waitcnt lgkmcnt(0)" ::: "memory");
}
constexpr int MOE_TILES = 48 * 704;
DI void cvt_moe_tile(const Params& p, unsigned char* ws_, int layer, int G, float* lds, int tid) {
    if (G < MOE_TILES) { CvtJob J; get_job(p, ws_, layer * 56 + 8 + G / 704, J); cvt_tile(J, G % 704, (J.N + 63) / 64, lds + (tid >> 6) * (64 * 65), tid & 63); }
}
DI void phase_cvt(const Params& p, float* lds  , int j0, int j1, int wv0, int wvn, bool fills) {
    unsigned char* const ws_ = lws(p);
    const int tid = ltid();
    if (fills) for (int l = 0; l < 2; ++l) {
        bf16* bi = FP8_INPROJ ? (bf16*)(ws_ + WS_BT_IN + (size_t)l * ZLD * 1024 + (size_t)IN_DIM * 1024) : (bf16*)(ws_ + WS_BT_IN) + (size_t)l * ZLD * 1024 + (size_t)IN_DIM * 1024;
        for (int i = blockIdx.x * NWG_THREADS + tid; i < (ZLD - IN_DIM) * (FP8_INPROJ ? 512 : 1024); i += gridDim.x * NWG_THREADS) bi[i] = 0;
        bf16* bk = (bf16*)(ws_ + WS_BT_UKV) + (size_t)l * 1024 * 256;
        for (int i = blockIdx.x * NWG_THREADS + tid; i < 1024 * 128; i += gridDim.x * NWG_THREADS) bk[(size_t)(i >> 7) * 256 + 128 + (i & 127)] = 0;
    }
    const int lane = tid & 63;
    float* lw = lds + (tid >> 6) * (64 * 65);
    int gbase = 0;
    for (int j = j0; j < j1; ++j) {
        CvtJob J; get_job(p, ws_, j, J);
        const int tk = J.K / 64, tn = (J.N + 63) / 64, nt = tk * tn;
        int t0 = (wv0 + (tid >> 6) - gbase) % wvn; if (t0 < 0) t0 += wvn;
        gbase = (gbase + nt) % wvn;
        for (int t = t0; t < nt; t += wvn) cvt_tile(J, t, tn, lw, lane);
    }
    __syncthreads();
}

DI void phase_mod(const Params& p, float* lds) {
    unsigned char* const ws_ = lws(p);
    const int tid = ltid();
    float* sc = lds; float* red = lds + 3 * 1024;
    for (int i = tid; i < 3 * 1024; i += NWG_THREADS) { const int r = i >> 10, k = i & 1023; const float c = r < 2 ? p.in[1][r * 1024 + k] : p.in[3][k]; sc[i] = c * sigmoidf_(c); }
    __syncthreads();
    const int kg = tid >> 6, cl = tid & 63;
    for (int it = blockIdx.x; it < 2 * 96; it += gridDim.x) {
        const int l = it / 96, j = (it % 96) * 64 + cl;
        const float* w = p.in[4] + (size_t)l * 1024 * 6144;
        float a0 = 0.f, a1 = 0.f, a2 = 0.f;
        for (int k = kg * 128; k < kg * 128 + 128; ++k) { const float wv = w[(size_t)k * 6144 + j]; a0 += sc[k] * wv; a1 += sc[1024 + k] * wv; a2 += sc[2048 + k] * wv; }
        red[(kg * 3 + 0) * 64 + cl] = a0; red[(kg * 3 + 1) * 64 + cl] = a1; red[(kg * 3 + 2) * 64 + cl] = a2;
        __syncthreads();
        if (tid < 192) {
            const int r = tid >> 6; float s = p.in[5][l * 6144 + j];
            for (int g = 0; g < 8; ++g) s += red[(g * 3 + r) * 64 + cl];
            ((float*)(ws_ + WS_MOD))[((size_t)l * 3 + r) * 6144 + j] = s;
        }
        __syncthreads();
    }
}
DI void sincos_d(double a, float& c, float& s) {
    const double TWO_PI = 6.283185307179586476925;
    a -= TWO_PI * rint(a / TWO_PI);
    const double a2 = a * a; double ts = a, tc = 1.0, ss = a, cs = 1.0;
    for (int i = 1; i <= 15; ++i) { tc *= -a2 / ((2 * i - 1) * (2 * i)); cs += tc; ts *= -a2 / ((2 * i) * (2 * i + 1)); ss += ts; }
    c = (float)cs; s = (float)ss;
}
DI void phase_tables(const Params& p) {
    unsigned char* const ws_ = lws(p);
    const int tid = ltid();
    const int gt = blockIdx.x * NWG_THREADS + tid, ng = gridDim.x * NWG_THREADS;
    float* rope = (float*)(ws_ + WS_ROPE);
    for (int i = gt; i < 256 * 8 + 64 * 8 + 256 * 16 + 64 * 16; i += ng) {
        int pos, f, nf; float* dst;
        if (i < 2048) { pos = i / 8; f = i % 8; nf = 8; dst = rope + ROPE_MROW + i * 2; }
        else if (i < 2560) { const int q = i - 2048; pos = q / 8; f = q % 8; nf = 8; dst = rope + ROPE_MCOL + q * 2; }
        else if (i < 2560 + 4096) { const int q = i - 2560; pos = q / 16; f = q % 16; nf = 16; dst = rope + ROPE_DROW + q * 2; }
        else { const int q = i - 6656; pos = q / 16; f = q % 16; nf = 16; dst = rope + ROPE_DCOL + q * 2; }
        const float inv = powf(10000.0f, -(float)f / (float)nf);
        const float ang = (float)pos * inv;
        float c, s; sincos_d((double)ang, c, s); dst[0] = c; dst[1] = s;
    }
    float* lam = (float*)(ws_ + WS_LAM);
    if (gt < 2) {
        const int l = gt; float s1 = 0.f, s2 = 0.f;
        for (int i = 0; i < 64; ++i) { s1 += p.in[12][l * 64 + i] * p.in[13][l * 64 + i]; s2 += p.in[14][l * 64 + i] * p.in[15][l * 64 + i]; }
        const float li = l == 0 ? 0.2f : (float)(0.8 - 0.6 * 0.74081822068171786607);
        lam[l] = expf(s1) - expf(s2) + li; lam[2 + l] = li;
    }
    if (gt >= 64 && gt < 64 + 16) {
        const int q = gt - 64; const float* r = p.in[7] + (size_t)q * 15 * 31; float m = r[0];
        for (int i = 1; i < 15 * 31; ++i) m = fmaxf(m, r[i]);
        lam[4 + q] = m * LOG2E;
    }
    float* bias = (float*)(ws_ + WS_BIAS);
    for (int i = gt; i < 2 * 8 * 15 * 4 * 1024; i += ng) {
        const int reg = i & 15, lane = (i >> 4) & 63, cg = (i >> 10) & 1, qh = (i >> 11) & 1; const int q = i >> 12; const int ro = q % 15, lh = q / 15;
        const int n = lane & 31, hh = lane >> 5, kcl = (reg & 3) + 8 * (reg >> 2) + 4 * hh;
        const int c = qh * 32 + n, kc = cg * 32 + kcl;
        int cs = c - 8; cs = cs < 0 ? 0 : (cs > 48 ? 48 : cs);
        float v = -1e30f;
        if (kc >= cs && kc < cs + 16) v = p.in[7][((size_t)lh * 15 + ro) * 31 + (kc - c + 15)] * LOG2E;
        bias[i] = v;
    }
}

DI void ln_stats16(const f32x4 (&v)[4], float& mu, float& rstd) {
    float s = 0.f;
#pragma unroll
    for (int i = 0; i < 4; ++i) s += (v[i][0] + v[i][1]) + (v[i][2] + v[i][3]);
    mu = wave_sum(s) * (1.f / 1024.f);
    float q = 0.f;
#pragma unroll
    for (int i = 0; i < 4; ++i) { const f32x4 d = v[i] - mu; q += (d[0] * d[0] + d[1] * d[1]) + (d[2] * d[2] + d[3] * d[3]); }
    rstd = rsqrtf(wave_sum(q) * (1.f / 1024.f) + EPS);
}
DI void phase_lnmod1(const Params& p, int layer) {
    unsigned char* const ws_ = lws(p);
    const int tid = ltid();
    const int lane = tid & 63;
    const float* mod = (const float*)(ws_ + WS_MOD) + (size_t)layer * 3 * 6144;
    bf16* H = (bf16*)(ws_ + WS_H);
    for (int row = gwave(tid); row < MROWS; row += nwaves()) {
        const float* xr = x_src_row(p.in[0], p.in[2], (const float*)(ws_ + WS_X), layer, row);
        f32x4 v[4];
#pragma unroll
        for (int i = 0; i < 4; ++i) v[i] = *(const f32x4*)(xr + i * 256 + lane * 4);
        float mu, rstd; ln_stats16(v, mu, rstd);
        const float* mr = mod + (size_t)mod_row_of(row) * 6144;
#pragma unroll
        for (int i = 0; i < 4; ++i) {
            const int c = i * 256 + lane * 4;
            const f32x4 sh = *(const f32x4*)(mr + c), sc = *(const f32x4*)(mr + 1024 + c);
            const f32x4 y = (v[i] - mu) * rstd * (sc + 1.f) + sh;
            if (FP8_INPROJ && FP8_GATE) *(unsigned*)((unsigned char*)H + (size_t)row * D + c) = pk4_fp8(y[0], y[1], y[2], y[3]);
            else { u32x2 o; o.x = pk2(y[0], y[1]); o.y = pk2(y[2], y[3]); *(u32x2*)(H + (size_t)row * D + c) = o; }
        }
    }
}

struct RowMapId { DI int operator()(int tm) const { return tm * 32; } };
struct RowMapCtx { DI int operator()(int tm) const { return (tm >> 3) * TPB + (tm & 7) * 32; } };
struct RowMapOff { int off; DI int operator()(int tm) const { return off + tm * 32; } };
template <class Epi, class BSel, class RowMap = RowMapId, bool FP8 = false>
DI void sgemm_phase(const bf16* A, int lda, const bf16* Bt, int ldb, int M, int N, int K, const Epi& E, const BSel& bsel, const RowMap& rmap = RowMap(), const int* gidx = nullptr) {
    const int tid = ltid();
    const int lane = tid & 63, r = lane & 31, h = lane >> 5;
    const int tnn = N / 32, nt = (M / 32) * tnn, nch = K / 64;
    for (int t = gwave(tid); t < nt; t += nwaves()) {
        const int tm = t / tnn, tn = t % tnn;
        const int row0 = rmap(tm);
        const bf16* Ab = A + (size_t)(gidx ? gidx[row0 + r] : row0 + r) * lda + 32 * h;
        const bf16* Bb = Bt + bsel(row0) + (size_t)(tn * 32 + r) * ldb + 32 * h;
        f32x16 acc;
#pragma unroll
        for (int q = 0; q < 16; ++q) acc[q] = 0.f;
        i32x8 a[4][2], b[4][2];
#define SG_LD8(dst_, ptr_) do { const u32x4 x_ = *(const u32x4*)(ptr_), y_ = *(const u32x4*)((ptr_) + 8); \
            dst_ = (i32x8){(int)x_[0], (int)x_[1], (int)x_[2], (int)x_[3], (int)y_[0], (int)y_[1], (int)y_[2], (int)y_[3]}; } while (0)
#define SG_LO(v_) __builtin_bit_cast(bf16x8, __builtin_shufflevector(v_, v_, 0, 1, 2, 3))
#define SG_HI(v_) __builtin_bit_cast(bf16x8, __builtin_shufflevector(v_, v_, 4, 5, 6, 7))
#define SG_LOAD(slot_, ch_) do { const int c_ = (ch_) < nch ? (ch_) : nch - 1; _Pragma("unroll") for (int s_ = 0; s_ < 2; ++s_) { \
            SG_LD8(a[slot_][s_], Ab + c_ * 64 + s_ * 16); SG_LD8(b[slot_][s_], Bb + c_ * 64 + s_ * 16); } } while (0)
#define SG_MMA(slot_) do { _Pragma("unroll") for (int s_ = 0; s_ < 2; ++s_) { if constexpr (FP8) acc = MFMA8(b[slot_][s_], a[slot_][s_], acc, 0, 0); \
            else { acc = MFMA32(SG_LO(b[slot_][s_]), SG_LO(a[slot_][s_]), acc); acc = MFMA32(SG_HI(b[slot_][s_]), SG_HI(a[slot_][s_]), acc); } } } while (0)
        SG_LOAD(0, 0); SG_LOAD(1, 1); SG_LOAD(2, 2); SG_LOAD(3, 3);
#pragma unroll 1
        for (int c = 0; c < nch; c += 4) {
            SG_MMA(0); SG_LOAD(0, c + 4);
            if (c + 1 < nch) { SG_MMA(1); SG_LOAD(1, c + 5); }
            if (c + 2 < nch) { SG_MMA(2); SG_LOAD(2, c + 6); }
            if (c + 3 < nch) { SG_MMA(3); SG_LOAD(3, c + 7); }
        }
#undef SG_LOAD
#undef SG_MMA
#undef SG_LD8
#undef SG_LO
#undef SG_HI
        if constexpr (Epi::PAIR) {
#pragma unroll
            for (int g = 0; g < 2; ++g) {
                const f32x4 v0 = {acc[4 * g], acc[4 * g + 1], acc[4 * g + 2], acc[4 * g + 3]};
                const f32x4 v1 = {acc[4 * g + 8], acc[4 * g + 9], acc[4 * g + 10], acc[4 * g + 11]};
                E.store_pair(row0 + r, tn * 16 + 8 * g + 4 * h, v0, v1);
            }
        } else {
#pragma unroll
            for (int g = 0; g < 4; ++g) {
                const f32x4 v = {acc[4 * g], acc[4 * g + 1], acc[4 * g + 2], acc[4 * g + 3]};
                E.store4(row0 + r, tn * 32 + 8 * g + 4 * h, v);
            }
        }
    }
}
struct BSelNone { DI size_t operator()(int) const { return 0; } };
struct BSelMoe { size_t estride; DI size_t operator()(int s) const { const int e = s < NSLOT_L ? s / (NB * CAP_L) : (s - NSLOT_L) / (NB * CAP_C); return (size_t)e * estride; } };

struct EpiStoreBf16 { static constexpr bool PAIR = false, BATCH = false; bf16* C; int ldc; float sc; DI void store4(int r, int c, f32x4 v) const { v *= sc; u32x2 o; o.x = pk2(v[0], v[1]); o.y = pk2(v[2], v[3]); *(u32x2*)(C + (size_t)r * ldc + c) = o; } };
struct EpiGate { static constexpr bool PAIR = false, BATCH = true; bf16* G; const float* bias; float sc;
    struct Pre { f32x4 b; };
    DI Pre load(int, int c) const { Pre p; p.b = *(const f32x4*)(bias + c); return p; }
    DI void apply(int r, int c, f32x4 v, const Pre& p) const { v = v * sc + p.b; u32x2 o; o.x = pk2(sigmoidf_(v[0]), sigmoidf_(v[1])); o.y = pk2(sigmoidf_(v[2]), sigmoidf_(v[3])); *(u32x2*)(G + (size_t)r * 3072 + c) = o; }
    DI void store4(int r, int c, f32x4 v) const { apply(r, c, v, load(r, c)); } };
template <int I> struct EpiMerge { static constexpr bool PAIR = false, BATCH = true; const bf16* G; bf16* Mp  ; bf16* Mb;
    struct Pre { u32x2 g; u32x2 m; };
    DI Pre load(int r, int c) const { Pre p; p.g = *(const u32x2*)(G + (size_t)r * 3072 + I * 1024 + c); if (I > 0) p.m = *(const u32x2*)(Mp + (size_t)r * D + c); else p.m = (u32x2){0u, 0u}; return p; }
    DI void apply(int r, int c, f32x4 v, const Pre& p) const {
        f32x4 m = {lo_f(p.g.x) * v[0], hi_f(p.g.x) * v[1], lo_f(p.g.y) * v[2], hi_f(p.g.y) * v[3]};
        if (I > 0) m += (f32x4){lo_f(p.m.x), hi_f(p.m.x), lo_f(p.m.y), hi_f(p.m.y)};
        u32x2 o; o.x = pk2(m[0], m[1]); o.y = pk2(m[2], m[3]);
        *(u32x2*)((I < 2 ? Mp : Mb) + (size_t)r * D + c) = o; }
    DI void store4(int r, int c, f32x4 v) const { apply(r, c, v, load(r, c)); } };
struct EpiOut { static constexpr bool PAIR = false, BATCH = true; const float* xin; const float* cin; int layer; const float* mod; float* X;
    struct Pre { f32x4 g1, xo; };
    DI Pre load(int r, int c) const { Pre p; p.g1 = *(const f32x4*)(mod + (size_t)mod_row_of(r) * 6144 + 2048 + c); p.xo = *(const f32x4*)(x_src_row(xin, cin, X, layer, r) + c); return p; }
    DI void apply(int r, int c, f32x4 v, const Pre& p) const { *(f32x4*)(X + (size_t)r * D + c) = p.xo * ALPHA + p.g1 * v; }
    DI void store4(int r, int c, f32x4 v) const { apply(r, c, v, load(r, c)); } };
struct EpiAct { static constexpr bool PAIR = true; unsigned char* Act;
    DI void store_pair(int r, int c, f32x4 g, f32x4 u) const {
        float a[4];
#pragma unroll
        for (int i = 0; i < 4; ++i) { const float gg = g[i] * (1.f / W1_SCALE), uu = u[i] * (1.f / W1_SCALE); a[i] = fminf(fmaxf(gg * sigmoidf_(gg) * uu * ACT_SCALE, -440.f), 440.f); }
        *(unsigned*)(Act + (size_t)r * FF + c) = pk4_fp8(a[0], a[1], a[2], a[3]); } };
struct EpiDown { static constexpr bool PAIR = false, BATCH = true; bf16* Y; const float* w;
    struct Pre { float g; };
    DI Pre load(int r, int) const { Pre p; p.g = w[r]; return p; }
    DI void apply(int r, int c, f32x4 v, const Pre& p) const { const float g = p.g * (1.f / (W2_SCALE * ACT_SCALE)); u32x2 o; o.x = pk2(v[0] * g, v[1] * g); o.y = pk2(v[2] * g, v[3] * g); *(u32x2*)(Y + (size_t)r * D + c) = o; }
    DI void store4(int r, int c, f32x4 v) const { apply(r, c, v, load(r, c)); } };

DI void kmax_update(unsigned* slot, float n2half, int tid) {
    float n2 = n2half + __shfl_xor(n2half, 32, tid);
    n2 = wave_max(n2);
    if ((tid & 63) == 0) atomicMax(slot, __float_as_uint(n2));
}
DI void phase_prep1(const Params& p, int layer) {
    unsigned char* const ws_ = lws(p);
    const int tid = ltid();
    const int lane = tid & 63, n = lane & 31, hh = lane >> 5;
    const bf16* Z = (const bf16*)(ws_ + R_Z);
    unsigned* kmax = (unsigned*)(ws_ + WS_KMAX) + layer * 48;
    const float* rope = (const float*)(ws_ + WS_ROPE);
    for (int it = gwave(tid); it < NKG * 19; it += nwaves()) {
        const int kg = it / 19, sub = it - kg * 19, part = sub < 8 ? 0 : (sub < 16 ? 1 : (sub < 18 ? 2 : 3));
        const int b = kg / KGPB, kgl = kg - b * KGPB;
        const int row = kg * 32 + n, t = kgl * 32 + n;
        const bool lat = t >= CTX; const int tl = t - CTX, gr = tl >> 6, gc = tl & 63;
        const bf16* zr = Z + (size_t)row * ZLD;
        if (part == 0) {
            const int h = sub;
            bf16* Q = (bf16*)(ws_ + R_QNA) + (size_t)row * 512 + h * 64 + hh * 32;
            const float qs = 0.125f * LOG2E;
            bf16x8 qv[4], kv[4], vv[4];
#pragma unroll
            for (int i = 0; i < 4; ++i) qv[i] = *(const bf16x8*)(zr + ZO_AQ + h * 64 + hh * 32 + i * 8);
#pragma unroll
            for (int ks = 0; ks < 4; ++ks) kv[ks] = *(const bf16x8*)(zr + ZO_AK + h * 64 + ks * 16 + 8 * hh);
#pragma unroll
            for (int s = 0; s < 2; ++s)
#pragma unroll
                for (int dvt = 0; dvt < 2; ++dvt) {
#pragma unroll
                    for (int j = 0; j < 8; ++j) { const int key = 16 * s + 8 * (j >> 2) + 4 * hh + (j & 3); vv[s * 2 + dvt][j] = (short)Z[(size_t)(kg * 32 + key) * ZLD + ZO_AV + h * 64 + dvt * 32 + n]; }
                }
#pragma unroll
            for (int i = 0; i < 4; ++i) *(bf16x8*)(Q + i * 8) = scale8(qv[i], qs);
            {
                bf16* Kf = (bf16*)(ws_ + R_KFNA) + ((size_t)(b * 8 + h) * KGPB + kgl) * 2048 + lane * 8;
                float n2 = 0.f;
#pragma unroll
                for (int ks = 0; ks < 4; ++ks) { n2 += sumsq8p(kv[ks]); *(bf16x8*)(Kf + ks * 512) = kv[ks]; }
                kmax_update(kmax + 0 * 16 + b * 8 + h, n2, tid);
                bf16* Vf = (bf16*)(ws_ + R_VFNA) + ((size_t)(b * 8 + h) * KGPB + kgl) * 2048 + lane * 8;
#pragma unroll
                for (int q = 0; q < 4; ++q) *(bf16x8*)(Vf + q * 512) = vv[q];
            }
        } else if (part == 1) {
            const float* rt = hh == 0 ? rope + ROPE_DROW + (size_t)gr * 32 : rope + ROPE_DCOL + (size_t)gc * 32;
            float* qn = (float*)(ws_ + WS_QN);
            { const int qk = (sub - 8) >> 2, sp = ((sub - 8) & 3) * 2;
                bf16x8 raw[2][4];
#pragma unroll
                for (int u = 0; u < 2; ++u)
#pragma unroll
                    for (int i = 0; i < 4; ++i) raw[u][i] = *(const bf16x8*)(zr + (qk ? ZO_DK : ZO_DQ) + (sp + u) * 64 + 32 * hh + i * 8);
                float rc[16], rs[16];
                if (lat) {
#pragma unroll
                    for (int i = 0; i < 16; ++i) { rc[i] = rt[i * 2]; rs[i] = rt[i * 2 + 1]; }
                }
#pragma unroll
                for (int u = 0; u < 2; ++u) { const int s = sp + u;
                    float f[32];
#pragma unroll
                    for (int i = 0; i < 4; ++i) { float t8[8]; unpack8(raw[u][i], t8);
#pragma unroll
                        for (int j = 0; j < 8; ++j) f[i * 8 + j] = t8[j]; }
                    if (lat) {
#pragma unroll
                        for (int i = 0; i < 16; ++i) { const float c = rc[i], sn = rs[i], a = f[i], bb = f[16 + i]; f[i] = a * c - bb * sn; f[16 + i] = a * sn + bb * c; }
                    }
                    float n2 = 0.f;
#pragma unroll
                    for (int i = 0; i < 32; ++i) { f[i] *= SQC_D; n2 += f[i] * f[i]; }
                    const u32x4 p0 = pk16_fp8(f), p1 = pk16_fp8(f + 16);
                    if (qk == 0) {
                        unsigned char* Q = ws_ + R_QD + (size_t)row * 512 + s * 64 + 32 * hh;
                        *(u32x4*)Q = p0; *(u32x4*)(Q + 16) = p1;
                        const float nt = n2 + __shfl_xor(n2, 32);
                        if (hh == 0) qn[(size_t)row * 8 + s] = sqrtf(nt);
                    } else {
                        unsigned char* Kf = ws_ + R_KFD + ((size_t)(b * 8 + s) * KGPB + kgl) * 2048 + lane * 16;
                        *(u32x4*)Kf = p0; *(u32x4*)(Kf + 1024) = p1;
                        kmax_update(kmax + 1 * 16 + b * 8 + s, n2, tid);
                    }
                } }
        } else if (part == 2) {
            const int kg2 = kg >> 1, kg2l = kgl >> 1;
            { const int hq = sub - 16;
                const int h4 = (kg & 1) * 2 + hq;
                unsigned char* Vf = ws_ + R_VFD + ((size_t)(b * 4 + h4) * (KGPB / 2) + kg2l) * 8192 + lane * 16;
#pragma unroll 1
                for (int dvt = 0; dvt < 4; ++dvt) {
                    float f[32];
#pragma unroll
                    for (int j = 0; j < 32; ++j) f[j] = bf2f(Z[(size_t)(kg2 * 64 + kappa(hh, j)) * ZLD + ZO_DV + h4 * 128 + dvt * 32 + n]);
                    *(u32x4*)(Vf + dvt * 2048) = pk16_fp8(f); *(u32x4*)(Vf + dvt * 2048 + 1024) = pk16_fp8(f + 16);
                }
            }
        } else {
            float sq = 0.f, sk = 0.f;
#pragma unroll
            for (int i = 0; i < 16; ++i) sq += sumsq8p(*(const bf16x8*)(zr + ZO_CQ + hh * 128 + i * 8));
#pragma unroll
            for (int i = 0; i < 8; ++i) sk += sumsq8p(*(const bf16x8*)(zr + ZO_CKV + hh * 64 + i * 8));
            sq += __shfl_xor(sq, 32); sk += __shfl_xor(sk, 32);
            float* ir = (float*)(ws_ + WS_INVRMS) + (size_t)row * 2;
            if (hh == 0) { ir[0] = rsqrtf(sq * (1.f / 256.f) + EPS); ir[1] = rsqrtf(sk * (1.f / 128.f) + EPS); }
            float x1[8], x2[8];
            unpack8(*(const bf16x8*)(zr + ZO_KR + hh * 16), x1); unpack8(*(const bf16x8*)(zr + ZO_KR + hh * 16 + 8), x2);
            if (lat) {
                const float* tb = hh == 0 ? rope + ROPE_MROW + (size_t)gr * 16 : rope + ROPE_MCOL + (size_t)gc * 16;
#pragma unroll
                for (int j = 0; j < 8; ++j) { const float c = tb[j * 2], s = tb[j * 2 + 1], a = x1[j], bb = x2[j]; x1[j] = a * c - bb * s; x2[j] = a * s + bb * c; }
            }
            float* kr = (float*)(ws_ + WS_KROPE) + (size_t)row * 32 + hh * 16;
#pragma unroll
            for (int j = 0; j < 8; ++j) { kr[j] = x1[j]; kr[8 + j] = x2[j]; }
        }
    }
}

DI void phase_prep2(const Params& p, int layer) {
    unsigned char* const ws_ = lws(p);
    const int tid = ltid();
    const int lane = tid & 63, n = lane & 31, hh = lane >> 5;
    const bf16* QR = (const bf16*)(ws_ + R_QRAW); const bf16* KV = (const bf16*)(ws_ + R_KVRAW);
    const float* IR = (const float*)(ws_ + WS_INVRMS); const float* KR = (const float*)(ws_ + WS_KROPE);
    unsigned* kmax = (unsigned*)(ws_ + WS_KMAX) + layer * 48 + 2 * 16;
    const float* rope = (const float*)(ws_ + WS_ROPE);
    for (int it = gwave(tid); it < NKG * 16; it += nwaves()) {
        const int kg = it >> 4, sub = it & 15, part = sub < 4 ? 0 : (sub < 12 ? 1 : 2);
        const int b = kg / KGPB, kgl = kg - b * KGPB;
        const int row = kg * 32 + n, t = kgl * 32 + n;
        const bool lat = t >= CTX; const int tl = t - CTX, gr = tl >> 6, gc = tl & 63;
        if (part == 0) {
            const float qs = IR[(size_t)row * 2] * SQC_M;
            const float* rr = rope + ROPE_MROW + (size_t)gr * 16; const float* rc = rope + ROPE_MCOL + (size_t)gc * 16;
            float* qn = (float*)(ws_ + WS_QN) + (size_t)MROWS * 8;
            { const int hq = sub;
                const int h = hh * 4 + hq;
                const bf16* src = QR + (size_t)row * 768 + h * 96; unsigned char* dst = ws_ + R_QMLA + (size_t)row * 1024 + h * 128;
                float f[96];
#pragma unroll
                for (int i = 0; i < 12; ++i) { float t8[8]; unpack8(*(const bf16x8*)(src + i * 8), t8);
#pragma unroll
                    for (int j = 0; j < 8; ++j) f[i * 8 + j] = t8[j]; }
                if (lat) {
#pragma unroll
                    for (int j = 0; j < 8; ++j) {
                        const float c0 = rr[j * 2], s0 = rr[j * 2 + 1], c1 = rc[j * 2], s1 = rc[j * 2 + 1];
                        const float a = f[64 + j], bb = f[72 + j], c = f[80 + j], d = f[88 + j];
                        f[64 + j] = a * c0 - bb * s0; f[72 + j] = a * s0 + bb * c0; f[80 + j] = c * c1 - d * s1; f[88 + j] = c * s1 + d * c1;
                    }
                }
                float n2 = 0.f;
#pragma unroll
                for (int i = 0; i < 96; ++i) { f[i] *= qs; n2 += f[i] * f[i]; }
#pragma unroll
                for (int i = 0; i < 6; ++i) *(u32x4*)(dst + i * 16) = pk16_fp8(f + i * 16);
                *(u32x4*)(dst + 96) = (u32x4){0u, 0u, 0u, 0u}; *(u32x4*)(dst + 112) = (u32x4){0u, 0u, 0u, 0u};
                qn[(size_t)row * 8 + h] = sqrtf(n2);
            }
        } else if (part == 1) {
            const float ks_ = IR[(size_t)row * 2 + 1] * SQC_M;
            float fr[32]; float nr = 0.f;
#pragma unroll
            for (int i = 0; i < 32; ++i) { fr[i] = hh == 0 ? KR[(size_t)row * 32 + i] * SQC_M : 0.f; nr += fr[i] * fr[i]; }
            const u32x4 r0 = pk16_fp8(fr), r1 = pk16_fp8(fr + 16);
            { const int h = sub - 4;
                unsigned char* Kf = ws_ + R_KFMLA + ((size_t)(b * 8 + h) * KGPB + kgl) * 4096 + lane * 16;
                float f[32]; float n2 = nr;
#pragma unroll
                for (int i = 0; i < 4; ++i) { float t8[8]; unpack8(*(const bf16x8*)(KV + (size_t)row * 1024 + h * 128 + 32 * hh + i * 8), t8);
#pragma unroll
                    for (int j = 0; j < 8; ++j) { f[i * 8 + j] = t8[j] * ks_; n2 += f[i * 8 + j] * f[i * 8 + j]; } }
                *(u32x4*)Kf = pk16_fp8(f); *(u32x4*)(Kf + 1024) = pk16_fp8(f + 16);
                *(u32x4*)(Kf + 2048) = r0; *(u32x4*)(Kf + 3072) = r1;
                kmax_update(kmax + b * 8 + h, n2, tid);
            }
        } else {
            const int kg2 = kg >> 1, kg2l = kgl >> 1;
            float sc[32];
#pragma unroll
            for (int j = 0; j < 32; ++j) sc[j] = IR[(size_t)(kg2 * 64 + kappa(hh, j)) * 2 + 1];
            { const int hq = sub - 12;
                const int h = (kg & 1) * 4 + hq;
                unsigned char* Vf = ws_ + R_VFMLA + ((size_t)(b * 8 + h) * (KGPB / 2) + kg2l) * 4096 + lane * 16;
#pragma unroll 1
                for (int dvt = 0; dvt < 2; ++dvt) {
                    float f[32];
#pragma unroll
                    for (int j = 0; j < 32; ++j) f[j] = bf2f(KV[(size_t)(kg2 * 64 + kappa(hh, j)) * 1024 + h * 128 + 64 + dvt * 32 + n]) * sc[j];
                    *(u32x4*)(Vf + dvt * 2048) = pk16_fp8(f); *(u32x4*)(Vf + dvt * 2048 + 1024) = pk16_fp8(f + 16);
                }
            }
        }
    }
}

template <int DQK, int DV, bool NA>
DI void attn_wave(const bf16* Q  , const bf16* Kf, const bf16* Vf, int kg0, int kg1, float kmax2,
                  bf16* O  ,
                  const float* bias  , float bmax, int gr, int qh) {
    const int tid = ltid();
    constexpr int NKS = DQK / 16, NDT = DV / 32, KSTR = NKS * 512, VSTR = 2 * NDT * 512;
    const int lane = tid & 63, hh = lane >> 5;
    bf16x8 qf[NKS]; float qn = 0.f;
#pragma unroll
    for (int ks = 0; ks < NKS; ++ks) { qf[ks] = *(const bf16x8*)(Q + ks * 16 + 8 * hh); qn += sumsq8p(qf[ks]); }
    qn += __shfl_xor(qn, 32);
    const float m = sqrtf(qn) * sqrtf(kmax2) * 1.0001f + (NA ? fmaxf(bmax, 0.f) : 0.f);
    f32x16 cinit;
#pragma unroll
    for (int i = 0; i < 16; ++i) cinit[i] = -m;
    f32x16 o[NDT];
#pragma unroll
    for (int d = 0; d < NDT; ++d)
#pragma unroll
        for (int i = 0; i < 16; ++i) o[d][i] = 0.f;
    float lsum = 0.f;
    int rs = 0;
    if (NA) { rs = gr - 4; rs = rs < 0 ? 0 : (rs > 248 ? 248 : rs); }
    const int nsteps = NA ? 24 : (kg1 - kg0);
    auto kg_of = [&](int st) -> int { if (!NA) return kg0 + st; return st < 8 ? st : 8 + (rs + ((st - 8) >> 1)) * 2 + ((st - 8) & 1); };
    bf16x8 kf[NKS], vf[2 * NDT];
    { const int kg = kg_of(0);
#pragma unroll
      for (int ks = 0; ks < NKS; ++ks) kf[ks] = *(const bf16x8*)(Kf + (size_t)kg * KSTR + ks * 512 + lane * 8);
#pragma unroll
      for (int i = 0; i < 2 * NDT; ++i) vf[i] = *(const bf16x8*)(Vf + (size_t)kg * VSTR + i * 512 + lane * 8); }
    f32x4 bc[4];
#pragma unroll
    for (int q = 0; q < 4; ++q) bc[q] = (f32x4){0.f, 0.f, 0.f, 0.f};
#pragma unroll 1
    for (int st = 0; st < nsteps; ++st) {
        bf16x8 kn[NKS], vn[2 * NDT]; f32x4 bn[4];
        { const int sn = st + 1 < nsteps ? st + 1 : st; const int kg = kg_of(sn);
#pragma unroll
          for (int ks = 0; ks < NKS; ++ks) kn[ks] = *(const bf16x8*)(Kf + (size_t)kg * KSTR + ks * 512 + lane * 8);
#pragma unroll
          for (int i = 0; i < 2 * NDT; ++i) vn[i] = *(const bf16x8*)(Vf + (size_t)kg * VSTR + i * 512 + lane * 8);
          if (NA && sn >= 8) {
              const int i = (sn - 8) >> 1, cg = (sn - 8) & 1, ro = rs + i - gr + 7;
              const float* bt = bias + ((size_t)(ro * 2 + qh) * 2 + cg) * 1024 + lane * 16;
#pragma unroll
              for (int q = 0; q < 4; ++q) bn[q] = *(const f32x4*)(bt + q * 4);
          } else {
#pragma unroll
              for (int q = 0; q < 4; ++q) bn[q] = (f32x4){0.f, 0.f, 0.f, 0.f};
          } }
        f32x16 s = cinit;
        if (NA && st >= 8) {
#pragma unroll
            for (int q = 0; q < 4; ++q) { s[4 * q] += bc[q][0]; s[4 * q + 1] += bc[q][1]; s[4 * q + 2] += bc[q][2]; s[4 * q + 3] += bc[q][3]; }
        }
#pragma unroll
        for (int ks = 0; ks < NKS; ++ks) s = MFMA32(kf[ks], qf[ks], s);
        unsigned pp[8];
#pragma unroll
        for (int i = 0; i < 8; ++i) { const float p0 = __builtin_amdgcn_exp2f(s[2 * i]), p1 = __builtin_amdgcn_exp2f(s[2 * i + 1]); lsum += p0 + p1; pp[i] = pk2(p0, p1); }
        const u32x4 u0 = {pp[0], pp[1], pp[2], pp[3]}, u1 = {pp[4], pp[5], pp[6], pp[7]};
        const bf16x8 pf0 = __builtin_bit_cast(bf16x8, u0), pf1 = __builtin_bit_cast(bf16x8, u1);
#pragma unroll
        for (int d = 0; d < NDT; ++d) { o[d] = MFMA32(vf[d], pf0, o[d]); o[d] = MFMA32(vf[NDT + d], pf1, o[d]); }
#pragma unroll
        for (int ks = 0; ks < NKS; ++ks) kf[ks] = kn[ks];
#pragma unroll
        for (int i = 0; i < 2 * NDT; ++i) vf[i] = vn[i];
#pragma unroll
        for (int q = 0; q < 4; ++q) bc[q] = bn[q];
    }
    lsum += __shfl_xor(lsum, 32);
    const float inv = 1.f / lsum;
#pragma unroll
    for (int d = 0; d < NDT; ++d)
#pragma unroll
        for (int g = 0; g < 4; ++g) {
            u32x2 w; w.x = pk2(o[d][4 * g] * inv, o[d][4 * g + 1] * inv); w.y = pk2(o[d][4 * g + 2] * inv, o[d][4 * g + 3] * inv);
            *(u32x2*)(O + d * 32 + 8 * g + 4 * hh) = w;
        }
}


#define LAS3 __attribute__((address_space(3)))
template <int DQK, int DV, int SKG>
DI void attn_block(LAS3 unsigned char* lds, const bf16* Q, const bf16* Kf, const bf16* Vf, int nst, float kmax2, bf16* O, int tid) {
    constexpr int NKS = DQK / 16, NDT = DV / 32, KCH = NKS, VCH = 2 * NDT, SCH = SKG * (KCH + VCH), CPW = SCH / 8, SBYTES = SCH * 1024;
    static_assert(SCH % 8 == 0 && 3 * SBYTES <= 131072, "stage geometry");
    const int lane = tid & 63, hh = lane >> 5, w = __builtin_amdgcn_readfirstlane(tid >> 6);
    bf16x8 qf[NKS]; float qn = 0.f;
#pragma unroll
    for (int ks = 0; ks < NKS; ++ks) { qf[ks] = *(const bf16x8*)(Q + ks * 16 + 8 * hh); qn += sumsq8p(qf[ks]); }
    qn += __shfl_xor(qn, 32);
    const float m = sqrtf(qn) * sqrtf(kmax2) * 1.0001f;
    f32x16 cinit;
#pragma unroll
    for (int i = 0; i < 16; ++i) cinit[i] = -m;
    f32x16 o[NDT];
#pragma unroll
    for (int d = 0; d < NDT; ++d)
#pragma unroll
        for (int i = 0; i < 16; ++i) o[d][i] = 0.f;
    float lsum = 0.f;
#define ATT_ISSUE(st_, buf_) do { _Pragma("unroll") for (int i_ = 0; i_ < CPW; ++i_) { const int c_ = w * CPW + i_; \
        const bf16* src_ = c_ < SKG * KCH ? Kf + ((size_t)(st_) * (SKG * KCH) + c_) * 512 : Vf + ((size_t)(st_) * (SKG * VCH) + (c_ - SKG * KCH)) * 512; \
        __builtin_amdgcn_global_load_lds((const unsigned*)(src_ + lane * 8), (LAS3 unsigned*)(lds + (buf_) * SBYTES + c_ * 1024), 16, 0, 0); } } while (0)
    ATT_ISSUE(0, 0);
    if (nst > 1) ATT_ISSUE(1, 1);
    int buf = 0;
    for (int st = 0; st < nst; ++st) {
        if (st + 1 < nst) { if (CPW == 5) asm volatile("s_waitcnt vmcnt(5)" ::: "memory"); else if (CPW == 3) asm volatile("s_waitcnt vmcnt(3)" ::: "memory"); else asm volatile("s_waitcnt vmcnt(2)" ::: "memory"); }
        else asm volatile("s_waitcnt vmcnt(0)" ::: "memory");
        __builtin_amdgcn_s_barrier();
        asm volatile("" ::: "memory");
        if (st + 2 < nst) { const int nb = buf >= 1 ? buf - 1 : 2; ATT_ISSUE(st + 2, nb); }
        LAS3 const unsigned char* sb = lds + buf * SBYTES + lane * 16;
        bf16x8 kf[NKS];
#pragma unroll
        for (int ks = 0; ks < NKS; ++ks) kf[ks] = *(LAS3 const bf16x8*)(sb + ks * 1024);
#pragma unroll
        for (int g = 0; g < SKG; ++g) {
            bf16x8 vf[VCH], kn[NKS];
#pragma unroll
            for (int i = 0; i < VCH; ++i) vf[i] = *(LAS3 const bf16x8*)(sb + (SKG * KCH + g * VCH + i) * 1024);
            if (g + 1 < SKG) {
#pragma unroll
                for (int ks = 0; ks < NKS; ++ks) kn[ks] = *(LAS3 const bf16x8*)(sb + ((g + 1) * KCH + ks) * 1024);
            }
            asm volatile("" ::: "memory");
            f32x16 s = cinit;
#pragma unroll
            for (int ks = 0; ks < NKS; ++ks) s = MFMA32(kf[ks], qf[ks], s);
            unsigned pp[8];
#pragma unroll
            for (int i = 0; i < 8; ++i) { const float p0 = __builtin_amdgcn_exp2f(s[2 * i]), p1 = __builtin_amdgcn_exp2f(s[2 * i + 1]); lsum += p0 + p1; pp[i] = pk2(p0, p1); }
            const u32x4 u0 = {pp[0], pp[1], pp[2], pp[3]}, u1 = {pp[4], pp[5], pp[6], pp[7]};
            const bf16x8 pf0 = __builtin_bit_cast(bf16x8, u0), pf1 = __builtin_bit_cast(bf16x8, u1);
#pragma unroll
            for (int d = 0; d < NDT; ++d) { o[d] = MFMA32(vf[d], pf0, o[d]); o[d] = MFMA32(vf[NDT + d], pf1, o[d]); }
            if (g + 1 < SKG) {
#pragma unroll
                for (int ks = 0; ks < NKS; ++ks) kf[ks] = kn[ks];
            }
        }
        buf = buf == 2 ? 0 : buf + 1;
    }
#undef ATT_ISSUE
    lsum += __shfl_xor(lsum, 32);
    const float inv = 1.f / lsum;
#pragma unroll
    for (int d = 0; d < NDT; ++d)
#pragma unroll
        for (int g = 0; g < 4; ++g) {
            u32x2 wv; wv.x = pk2(o[d][4 * g] * inv, o[d][4 * g + 1] * inv); wv.y = pk2(o[d][4 * g + 2] * inv, o[d][4 * g + 3] * inv);
            *(u32x2*)(O + d * 32 + 8 * g + 4 * hh) = wv;
        }
    asm volatile("" ::: "memory");
    __builtin_amdgcn_s_barrier();
    asm volatile("" ::: "memory");
}


template <int NC, int NDT, bool VARB = true, bool ROT = true>
DI void attn_block8(LAS3 unsigned char* lds, const unsigned char* Q  , float qnorm, const unsigned char* Kf, const unsigned char* Vf, int nst, float kmax2,
                    bf16* O, int tid) {
    constexpr int KSB = 4 * NC * 2048, VSB = 2 * NDT * 2048, SBYTES = KSB + VSB, SCH = SBYTES / 1024, CPW = SCH / 8;
    static_assert(SCH == 24 && CPW == 3, "stage geometry");
    const int lane = tid & 63, hh = lane >> 5, w = __builtin_amdgcn_readfirstlane(tid >> 6);
    i32x8 qf[NC];
#pragma unroll
    for (int c = 0; c < NC; ++c) { const u32x4 a = *(const u32x4*)(Q + c * 64 + 32 * hh), b = *(const u32x4*)(Q + c * 64 + 32 * hh + 16);
        qf[c] = (i32x8){(int)a[0], (int)a[1], (int)a[2], (int)a[3], (int)b[0], (int)b[1], (int)b[2], (int)b[3]}; }
    const float csb = qnorm * sqrtf(kmax2) * 1.13f + 0.2f;
    f32x16 cinit;
    f32x16 o[NDT];
#pragma unroll
    for (int d = 0; d < NDT; ++d)
#pragma unroll
        for (int i = 0; i < 16; ++i) o[d][i] = 0.f;
    f32x16 lacc;
#pragma unroll
    for (int i = 0; i < 16; ++i) lacc[i] = 0.f;
    i32x8 ones8;
    asm volatile("v_mov_b32 %0, 0x38383838\n\tv_mov_b32 %1, 0x38383838\n\tv_mov_b32 %2, 0x38383838\n\tv_mov_b32 %3, 0x38383838\n\tv_mov_b32 %4, 0x38383838\n\tv_mov_b32 %5, 0x38383838\n\tv_mov_b32 %6, 0x38383838\n\tv_mov_b32 %7, 0x38383838"
                 : "=v"(ones8[0]), "=v"(ones8[1]), "=v"(ones8[2]), "=v"(ones8[3]), "=v"(ones8[4]), "=v"(ones8[5]), "=v"(ones8[6]), "=v"(ones8[7]));
#define ATT_ISSUE8(st_, buf_) do { _Pragma("unroll") for (int i_ = 0; i_ < CPW; ++i_) { const int c_ = w * CPW + i_; \
        const unsigned char* src_ = c_ < KSB / 1024 ? Kf + (size_t)(st_) * KSB + c_ * 1024 : Vf + (size_t)(st_) * VSB + (c_ - KSB / 1024) * 1024; \
        __builtin_amdgcn_global_load_lds((const unsigned*)(src_ + lane * 16), (LAS3 unsigned*)(lds + (buf_) * SBYTES + c_ * 1024), 16, 0, 0); } } while (0)
#define LD_FRAG8(dst_, off_) do { const u32x4 a_ = *(LAS3 const u32x4*)(sb + (off_)), b_ = *(LAS3 const u32x4*)(sb + (off_) + 1024); \
        dst_ = (i32x8){(int)a_[0], (int)a_[1], (int)a_[2], (int)a_[3], (int)b_[0], (int)b_[1], (int)b_[2], (int)b_[3]}; } while (0)
#define ATT_QK8X(kf_, s0, s1) do { s0 = cinit; s1 = cinit; \
        _Pragma("unroll") for (int c = 0; c < NC; ++c) { s0 = MFMA8(kf_[0][c], qf[c], s0, 0, 0); s1 = MFMA8(kf_[1][c], qf[c], s1, 0, 0); } } while (0)
#define ATT_QK8(kf_) ATT_QK8X(kf_, s0, s1)
#define CL8(x_) __builtin_amdgcn_fmed3f((x_), 0.f, 123.f)
#define PK4_U8(a_, b_, c_, d_) __builtin_amdgcn_cvt_pk_u8_f32(CL8(d_), 3, __builtin_amdgcn_cvt_pk_u8_f32(CL8(c_), 2, __builtin_amdgcn_cvt_pk_u8_f32(CL8(b_), 1, __builtin_amdgcn_cvt_pk_u8_f32(CL8(a_), 0, 0u))))
#define ATT_PV8(vf_) ATT_PV8X(vf_, s0, s1)
#define ATT_PV8X(vf_, s0, s1) do { i32x8 pf; \
        _Pragma("unroll") for (int q = 0; q < 4; ++q) pf[q] = (int)PK4_U8(s0[4 * q], s0[4 * q + 1], s0[4 * q + 2], s0[4 * q + 3]); \
        _Pragma("unroll") for (int q = 0; q < 4; ++q) pf[4 + q] = (int)PK4_U8(s1[4 * q], s1[4 * q + 1], s1[4 * q + 2], s1[4 * q + 3]); \
        lacc = MFMA8(ones8, pf, lacc, 0, 1); \
        _Pragma("unroll") for (int d = 0; d < NDT; ++d) o[d] = MFMA8(vf_[d], pf, o[d], 0, 1); } while (0)
    ATT_ISSUE8(0, 0);
    if (nst > 1) ATT_ISSUE8(1, 1);
    {
        if (nst > 1) asm volatile("s_waitcnt vmcnt(3)" ::: "memory"); else asm volatile("s_waitcnt vmcnt(0)" ::: "memory");
        __builtin_amdgcn_s_barrier();
        asm volatile("" ::: "memory");
        LAS3 const unsigned char* sb = lds + lane * 16;
        float emax = -1e30f;
#pragma unroll
        for (int t = 0; t < 4; ++t) {
            f32x16 sz;
#pragma unroll
            for (int i = 0; i < 16; ++i) sz[i] = 0.f;
#pragma unroll
            for (int c = 0; c < NC; ++c) { i32x8 kf_; LD_FRAG8(kf_, (t * NC + c) * 2048); sz = MFMA8(kf_, qf[c], sz, 0, 0); }
#pragma unroll
            for (int i = 0; i < 16; ++i) emax = fmaxf(emax, sz[i]);
        }
        emax = fmaxf(emax, __shfl_xor(emax, 32));
        const float m = fminf(csb, emax + 64.f) - 118.f;
#pragma unroll
        for (int i = 0; i < 16; ++i) cinit[i] = -m;
    }
    int sl = 0;
    for (int st = 0; st < nst; st += 2) {
        asm volatile("s_waitcnt vmcnt(0)" ::: "memory");
        __builtin_amdgcn_s_barrier();
        asm volatile("" ::: "memory");
        if (st + 2 < nst) { ATT_ISSUE8(st + 2, (sl ^ 2)); ATT_ISSUE8(st + 3, (sl ^ 2) + 1); }
        if constexpr (ROT) {
            LAS3 const unsigned char* b0 = lds + sl * SBYTES + lane * 16; LAS3 const unsigned char* b1 = b0 + SBYTES;
#define LD_FRAGB(dst_, base_, off_) do { const u32x4 a_ = *(LAS3 const u32x4*)((base_) + (off_)), b_ = *(LAS3 const u32x4*)((base_) + (off_) + 1024); \
            dst_ = (i32x8){(int)a_[0], (int)a_[1], (int)a_[2], (int)a_[3], (int)b_[0], (int)b_[1], (int)b_[2], (int)b_[3]}; } while (0)
#define LDK_(dst_, base_, tp_) do { _Pragma("unroll") for (int t = 0; t < 2; ++t) _Pragma("unroll") for (int c = 0; c < NC; ++c) LD_FRAGB(dst_[t][c], base_, ((2 * (tp_) + t) * NC + c) * 2048); } while (0)
#define LDV_(dst_, base_, tp_) do { _Pragma("unroll") for (int d = 0; d < NDT; ++d) LD_FRAGB(dst_[d], base_, KSB + ((tp_) * NDT + d) * 2048); } while (0)
            i32x8 ka[2][NC], kb[2][NC], vx[NDT], vy[NDT];
            f32x16 s0, s1, t0, t1;
            LDK_(ka, b0, 0); LDV_(vx, b0, 0);
            asm volatile("" ::: "memory");
            ATT_QK8X(ka, s0, s1);
            LDK_(kb, b0, 1);
            asm volatile("" ::: "memory");
            ATT_QK8X(kb, t0, t1);
            if constexpr (NDT <= 2) { LDV_(vy, b0, 1); asm volatile("" ::: "memory"); }
            ATT_PV8X(vx, s0, s1);
            if constexpr (NDT > 2) { LDV_(vy, b0, 1); }
            LDK_(ka, b1, 0);
            asm volatile("" ::: "memory");
            ATT_QK8X(ka, s0, s1);
            ATT_PV8X(vy, t0, t1);
            LDK_(kb, b1, 1); LDV_(vx, b1, 0);
            asm volatile("" ::: "memory");
            ATT_QK8X(kb, t0, t1);
            ATT_PV8X(vx, s0, s1);
            LDV_(vy, b1, 1);
            asm volatile("" ::: "memory");
            ATT_PV8X(vy, t0, t1);
#undef LD_FRAGB
#undef LDK_
#undef LDV_
        } else {
#pragma unroll
        for (int half = 0; half < 2; ++half) {
        LAS3 const unsigned char* sb = lds + (sl + half) * SBYTES + lane * 16;
        i32x8 kA[2][NC], kB[2][NC], vA[NDT], vB[NDT];
        f32x16 s0, s1;
#pragma unroll
        for (int t = 0; t < 2; ++t)
#pragma unroll
            for (int c = 0; c < NC; ++c) LD_FRAG8(kA[t][c], (t * NC + c) * 2048);
#pragma unroll
        for (int d = 0; d < NDT; ++d) LD_FRAG8(vA[d], KSB + d * 2048);
        asm volatile("" ::: "memory");
        ATT_QK8(kA);
#pragma unroll
        for (int t = 0; t < 2; ++t)
#pragma unroll
            for (int c = 0; c < NC; ++c) LD_FRAG8(kB[t][c], ((2 + t) * NC + c) * 2048);
        asm volatile("" ::: "memory");
        if constexpr (NDT <= 2) {
            f32x16 t0, t1;
            ATT_QK8X(kB, t0, t1);
#pragma unroll
            for (int d = 0; d < NDT; ++d) LD_FRAG8(vB[d], KSB + (NDT + d) * 2048);
            asm volatile("" ::: "memory");
            ATT_PV8(vA);
            ATT_PV8X(vB, t0, t1);
        } else if constexpr (VARB) {
            f32x16 t0, t1;
            ATT_QK8X(kB, t0, t1);
            ATT_PV8(vA);
#pragma unroll
            for (int d = 0; d < NDT; ++d) LD_FRAG8(vB[d], KSB + (NDT + d) * 2048);
            asm volatile("" ::: "memory");
            ATT_PV8X(vB, t0, t1);
        } else {
        ATT_PV8(vA);
#pragma unroll
        for (int d = 0; d < NDT; ++d) LD_FRAG8(vB[d], KSB + (NDT + d) * 2048);
        asm volatile("" ::: "memory");
        ATT_QK8(kB);
        ATT_PV8(vB);
        }
        }
        }
        sl ^= 2;
    }
#undef ATT_ISSUE8
#undef LD_FRAG8
#undef ATT_QK8
#undef ATT_QK8X
#undef ATT_PV8X
#undef ATT_PV8
#undef PK4_U8
#undef CL8
    const float lsum_ = lacc[0];
    const bool bad_ = !(lsum_ > 0.f) || !(lsum_ < 3.0e38f);
    const float inv = bad_ ? 0.f : 1.f / lsum_;

#pragma unroll
    for (int d = 0; d < NDT; ++d)
#pragma unroll
        for (int g = 0; g < 4; ++g) {
            u32x2 wv; wv.x = pk2(o[d][4 * g] * inv, o[d][4 * g + 1] * inv); wv.y = pk2(o[d][4 * g + 2] * inv, o[d][4 * g + 3] * inv);
            *(u32x2*)(O + d * 32 + 8 * g + 4 * hh) = wv;
        }
    asm volatile("" ::: "memory");
    __builtin_amdgcn_s_barrier();
    asm volatile("" ::: "memory");
}

DI void phase_attn(const Params& p, int layer, unsigned char* ldsg) {
    LAS3 unsigned char* lds = (LAS3 unsigned char*)ldsg;
    {   unsigned char* const ws_ = lws(p); const int tid = ltid(); const int w = tid >> 6, n = tid & 31;
        const unsigned* kmax = (const unsigned*)(ws_ + WS_KMAX) + layer * 48; const float* qn = (const float*)(ws_ + WS_QN) + (size_t)MROWS * 8;
        for (int k = 0; k * (int)gridDim.x + (int)blockIdx.x < 1024; ++k) {
            const int it = k * gridDim.x + blockIdx.x; int combo = it >> 6, qt = it & 63;
            if (gridDim.x == 256) { const int x = blockIdx.x & 7, r = blockIdx.x >> 3; combo = x * 2 + (k >> 1); qt = (k & 1) * 32 + r; }
            const int b = combo >> 3, hd = combo & 7;
            const int row = b * TPB + CTX + qt * 256 + w * 32 + n;
            attn_block8<2, 2, true>(lds, ws_ + R_QMLA + (size_t)row * 1024 + hd * 128, qn[(size_t)row * 8 + hd],
                ws_ + R_KFMLA + (size_t)(b * 8 + hd) * KGPB * 4096, ws_ + R_VFMLA + (size_t)(b * 8 + hd) * (KGPB / 2) * 4096,
                KGPB / 4, __uint_as_float(kmax[32 + b * 8 + hd]), (bf16*)(ws_ + R_YA) + (size_t)row * 1536 + 512 + hd * 64, tid);
        }
        for (int it = blockIdx.x; it < 16; it += gridDim.x) {
            const int b = it >> 3, hd = it & 7; const int row = b * TPB + w * 32 + n;
            attn_block8<2, 2, true>(lds, ws_ + R_QMLA + (size_t)row * 1024 + hd * 128, qn[(size_t)row * 8 + hd],
                ws_ + R_KFMLA + (size_t)(b * 8 + hd) * KGPB * 4096, ws_ + R_VFMLA + (size_t)(b * 8 + hd) * (KGPB / 2) * 4096,
                2, __uint_as_float(kmax[32 + b * 8 + hd]), (bf16*)(ws_ + R_YA) + (size_t)row * 1536 + 512 + hd * 64, tid);
        }
    }
    {   unsigned char* const ws_ = lws(p); const int tid = ltid(); const int w = tid >> 6, n = tid & 31;
        const unsigned* kmax = (const unsigned*)(ws_ + WS_KMAX) + layer * 48; const float* qn = (const float*)(ws_ + WS_QN);
        for (int k = 0; k * (int)gridDim.x + (int)blockIdx.x < 1024; ++k) {
            const int it = k * gridDim.x + blockIdx.x; int combo = it >> 6, qt = it & 63;
            if (gridDim.x == 256) { const int x = blockIdx.x & 7, r = blockIdx.x >> 3; combo = x * 2 + (k >> 1); qt = (k & 1) * 32 + r; }
            const int b = combo >> 3, hd = combo & 7;
            const int row = b * TPB + CTX + qt * 256 + w * 32 + n;
            attn_block8<1, 4, true>(lds, ws_ + R_QD + (size_t)row * 512 + hd * 64, qn[(size_t)row * 8 + hd],
                ws_ + R_KFD + (size_t)(b * 8 + hd) * KGPB * 2048, ws_ + R_VFD + (size_t)(b * 4 + (hd >> 1)) * (KGPB / 2) * 8192,
                KGPB / 4, __uint_as_float(kmax[16 + b * 8 + hd]), (bf16*)(ws_ + R_OD) + (size_t)row * 1024 + hd * 128, tid);
        }
        for (int it = blockIdx.x; it < 16; it += gridDim.x) {
            const int b = it >> 3, hd = it & 7; const int row = b * TPB + w * 32 + n;
            attn_block8<1, 4, true>(lds, ws_ + R_QD + (size_t)row * 512 + hd * 64, qn[(size_t)row * 8 + hd],
                ws_ + R_KFD + (size_t)(b * 8 + hd) * KGPB * 2048, ws_ + R_VFD + (size_t)(b * 4 + (hd >> 1)) * (KGPB / 2) * 8192,
                2, __uint_as_float(kmax[16 + b * 8 + hd]), (bf16*)(ws_ + R_OD) + (size_t)row * 1024 + hd * 128, tid);
        }
    }
    {   unsigned char* const ws_ = lws(p); const int tid = ltid(); const int w = tid >> 6, n = tid & 31;
        const unsigned* kmax = (const unsigned*)(ws_ + WS_KMAX) + layer * 48; const float* lamv = (const float*)(ws_ + WS_LAM);
        unsigned* ctr = (unsigned*)(ws_ + WS_CTL) + 8 + layer;
        volatile LAS3 int* nxt = (volatile LAS3 int*)ldsg;
        int par = 0;
        for (int it = blockIdx.x; it < 1024; ) {
            unsigned got = 0u;
            if (tid == 0) got = __hip_atomic_fetch_add(ctr, 1u, __ATOMIC_RELAXED, __HIP_MEMORY_SCOPE_AGENT);
            const int b = it >> 9, hd = (it >> 6) & 7, qt = it & 63;
            const int gr = qt * 4 + (w >> 1), qh = w & 1;
            const int row = b * TPB + CTX + gr * 64 + qh * 32 + n;
            attn_wave<64, 64, true>((const bf16*)(ws_ + R_QNA) + (size_t)row * 512 + hd * 64,
                (const bf16*)(ws_ + R_KFNA) + (size_t)(b * 8 + hd) * KGPB * 2048, (const bf16*)(ws_ + R_VFNA) + (size_t)(b * 8 + hd) * KGPB * 2048,
                0, 0, __uint_as_float(kmax[b * 8 + hd]), (bf16*)(ws_ + R_YA) + (size_t)row * 1536 + hd * 64,
                (const float*)(ws_ + WS_BIAS) + (size_t)(layer * 8 + hd) * 15 * 4 * 1024, lamv[4 + layer * 8 + hd], gr, qh);
            if (tid == 0) nxt[par] = (int)gridDim.x + (int)got;
            __syncthreads();
            it = nxt[par];
            par ^= 1;
        }
    }
    {   unsigned char* const ws_ = lws(p); const int tid = ltid(); const int w = tid >> 6, n = tid & 31;
        const unsigned* kmax = (const unsigned*)(ws_ + WS_KMAX) + layer * 48;
        for (int it = blockIdx.x; it < 16; it += gridDim.x) {
            const int b = it >> 3, hd = it & 7; const int row = b * TPB + w * 32 + n;
            attn_wave<64, 64, false>((const bf16*)(ws_ + R_QNA) + (size_t)row * 512 + hd * 64,
                (const bf16*)(ws_ + R_KFNA) + (size_t)(b * 8 + hd) * KGPB * 2048, (const bf16*)(ws_ + R_VFNA) + (size_t)(b * 8 + hd) * KGPB * 2048,
                0, 8, __uint_as_float(kmax[b * 8 + hd]), (bf16*)(ws_ + R_YA) + (size_t)row * 1536 + hd * 64, nullptr, 0.f, 0, 0);
        }
    }
}

DI void phase_diffcomb(const Params& p, int layer) {
    unsigned char* const ws_ = lws(p);
    const int tid = ltid();
    const int lane = tid & 63;
    const float* lamv = (const float*)(ws_ + WS_LAM); const float lam = lamv[layer], li = lamv[2 + layer];
    const float* gsub = p.in[16] + layer * 128;
    const bf16* OD = (const bf16*)(ws_ + R_OD); bf16* YC = (bf16*)(ws_ + R_YA) + 1024;
    const int h4 = lane >> 4, d0 = (lane & 15) * 8;
    for (int row = gwave(tid); row < MROWS; row += nwaves()) {
        float a[8], b2[8], y[8];
        unpack8(*(const bf16x8*)(OD + (size_t)row * 1024 + (2 * h4) * 128 + d0), a);
        unpack8(*(const bf16x8*)(OD + (size_t)row * 1024 + (2 * h4 + 1) * 128 + d0), b2);
        float ss = 0.f;
#pragma unroll
        for (int j = 0; j < 8; ++j) { y[j] = a[j] - lam * b2[j]; ss += y[j] * y[j]; }
#pragma unroll
        for (int o = 8; o >= 1; o >>= 1) ss += __shfl_xor(ss, o);
        const float r = rsqrtf(ss * (1.f / 128.f) + EPS) * (1.f - li);
#pragma unroll
        for (int j = 0; j < 8; ++j) y[j] = y[j] * r * gsub[d0 + j];
        *(bf16x8*)(YC + (size_t)row * 1536 + h4 * 128 + d0) = pack8(y);
    }
}

DI void phase_ln1_router(const Params& p, int layer, float* lds  ) {
    unsigned char* const ws_ = lws(p);
    const int tid = ltid();
    const int lane = tid & 63;
    const float* wr = p.in[25] + (size_t)layer * 1024 * 16;
    for (int i = tid; i < 16384; i += NWG_THREADS) { const int k = i >> 4, e = i & 15; lds[e * 1024 + k] = wr[i]; }
    __syncthreads();
    const float* mod = (const float*)(ws_ + WS_MOD) + (size_t)layer * 3 * 6144;
    const float* g1 = p.in[23] + layer * 1024; const float* b1 = p.in[24] + layer * 1024;
    float* X = (float*)(ws_ + WS_X); bf16* H = (bf16*)(ws_ + WS_H);
    float* affL = (float*)(ws_ + WS_AFF); float* affC = affL + 2 * 16 * 16384;
    for (int row = gwave(tid); row < MROWS; row += nwaves()) {
        float* xr = X + (size_t)row * D;
        f32x4 v[4];
#pragma unroll
        for (int i = 0; i < 4; ++i) v[i] = *(const f32x4*)(xr + i * 256 + lane * 4);
        float mu, rstd; ln_stats16(v, mu, rstd);
#pragma unroll
        for (int i = 0; i < 4; ++i) { const int c = i * 256 + lane * 4; v[i] = (v[i] - mu) * rstd * *(const f32x4*)(g1 + c) + *(const f32x4*)(b1 + c); }
        ln_stats16(v, mu, rstd);
        const float* mr = mod + (size_t)mod_row_of(row) * 6144;
        float lg[16];
#pragma unroll
        for (int i = 0; i < 4; ++i) {
            const int c = i * 256 + lane * 4;
            const f32x4 sh = *(const f32x4*)(mr + 3072 + c), sc = *(const f32x4*)(mr + 4096 + c);
            const f32x4 y = (v[i] - mu) * rstd * (sc + 1.f) + sh;
            *(unsigned*)((unsigned char*)H + (size_t)row * D + c) = pk4_fp8(y[0], y[1], y[2], y[3]);
            v[i] = y;
        }
#pragma unroll
        for (int e = 0; e < 16; ++e) {
            float a = 0.f;
#pragma unroll
            for (int i = 0; i < 4; ++i) { const f32x4 w = *(const f32x4*)(lds + e * 1024 + i * 256 + lane * 4); a += (v[i][0] * w[0] + v[i][1] * w[1]) + (v[i][2] * w[2] + v[i][3] * w[3]); }
            lg[e] = a;
            asm volatile("" : "+v"(lg[e]));
        }
        float r8[8], r4[4], r2[2], r1;
        { const bool hi = (lane & 32) != 0;
#pragma unroll
          for (int j = 0; j < 8; ++j) { const float keep = hi ? lg[8 + j] : lg[j], send = hi ? lg[j] : lg[8 + j]; r8[j] = keep + __shfl_xor(send, 32); } }
        { const bool hi = (lane & 16) != 0;
#pragma unroll
          for (int j = 0; j < 4; ++j) { const float keep = hi ? r8[4 + j] : r8[j], send = hi ? r8[j] : r8[4 + j]; r4[j] = keep + __shfl_xor(send, 16); } }
        { const bool hi = (lane & 8) != 0;
#pragma unroll
          for (int j = 0; j < 2; ++j) { const float keep = hi ? r4[2 + j] : r4[j], send = hi ? r4[j] : r4[2 + j]; r2[j] = keep + __shfl_xor(send, 8); } }
        { const bool hi = (lane & 4) != 0; const float keep = hi ? r2[1] : r2[0], send = hi ? r2[0] : r2[1]; r1 = keep + __shfl_xor(send, 4); }
        r1 += __shfl_xor(r1, 2); r1 += __shfl_xor(r1, 1);
        float mx = r1;
        mx = fmaxf(mx, __shfl_xor(mx, 4)); mx = fmaxf(mx, __shfl_xor(mx, 8)); mx = fmaxf(mx, __shfl_xor(mx, 16)); mx = fmaxf(mx, __shfl_xor(mx, 32));
        const float pe = expf(r1 - mx);
        float se = pe;
        se += __shfl_xor(se, 4); se += __shfl_xor(se, 8); se += __shfl_xor(se, 16); se += __shfl_xor(se, 32);
        const float mine = pe / se;
        const int eidx = ((lane >> 5) & 1) * 8 + ((lane >> 4) & 1) * 4 + ((lane >> 3) & 1) * 2 + ((lane >> 2) & 1);
        const int b = row / TPB, t = row - b * TPB;
        if ((lane & 3) == 0) { if (t < CTX) affC[(size_t)(b * 16 + eidx) * 256 + t] = mine; else affL[(size_t)(b * 16 + eidx) * 16384 + (t - CTX)] = mine; }
    }
}

DI void phase_topk(const Params& p, unsigned* lds  ) {
    unsigned char* const ws_ = lws(p);
    const int tid = ltid(), lane = tid & 63, wv = tid >> 6;
    unsigned* vals = lds; unsigned* hist = lds + 16384 + 512; unsigned* misc = hist + 256; unsigned* wsum = misc + 32;
    const float* affL = (const float*)(ws_ + WS_AFF); const float* affC = affL + 2 * 16 * 16384;
    int* selrow = (int*)(ws_ + WS_SELROW); float* selw = (float*)(ws_ + WS_SELW); int* slotof = (int*)(ws_ + WS_SLOTOF);
#define VPAD(i_) ((i_) + ((i_) >> 5))
    for (int pr = blockIdx.x; pr < 64; pr += gridDim.x) {
        const bool isc = pr >= 32; const int q = pr & 31, b = q >> 4, e = q & 15;
        const int n = isc ? 256 : 16384, k = isc ? CAP_C : CAP_L;
        const float* src = isc ? affC + (size_t)q * 256 : affL + (size_t)q * 16384;
        const int slotbase = isc ? NSLOT_L + (e * 2 + b) * CAP_C : (e * 2 + b) * CAP_L;
        const int rowbase = b * TPB + (isc ? 0 : CTX);
        __syncthreads();
        for (int i = tid; i < n; i += NWG_THREADS) vals[VPAD(i)] = __float_as_uint(src[i]);
        unsigned prefix = 0, mask = 0; int kk = k;
        for (int pass = 3; pass >= 0; --pass) {
            if (tid < 256) hist[tid] = 0;
            __syncthreads();
            for (int i = tid; i < n; i += NWG_THREADS) { const unsigned v = vals[VPAD(i)]; if ((v & mask) == prefix) atomicAdd(&hist[(v >> (8 * pass)) & 255], 1u); }
            __syncthreads();
            if (wv == 0) {
                const int c0 = (int)hist[4 * lane], c1 = (int)hist[4 * lane + 1], c2 = (int)hist[4 * lane + 2], c3 = (int)hist[4 * lane + 3];
                const int sl = c0 + c1 + c2 + c3;
                int suf = sl;
#pragma unroll
                for (int o = 1; o < 64; o <<= 1) { const int y = __shfl_down(suf, o); if (lane + o < 64) suf += y; }
                const int above = suf - sl;
                if (above < kk && kk <= suf) {
                    int cum = above, bin = 4 * lane + 3;
                    if (cum + c3 < kk) { cum += c3; bin = 4 * lane + 2; if (cum + c2 < kk) { cum += c2; bin = 4 * lane + 1; if (cum + c1 < kk) { cum += c1; bin = 4 * lane; } } }
                    misc[0] = (unsigned)bin; misc[1] = (unsigned)(kk - cum);
                }
            }
            __syncthreads();
            prefix |= misc[0] << (8 * pass); mask |= 0xffu << (8 * pass); kk = (int)misc[1];
        }
        const unsigned T = prefix;
        const int i0 = tid * 32;
        int gt = 0, eq = 0;
        if (i0 < n) for (int i = 0; i < 32; ++i) { const unsigned v = vals[tid * 33 + i]; gt += v > T; eq += v == T; }
        int x = eq;
#pragma unroll
        for (int o = 1; o < 64; o <<= 1) { const int y = __shfl_up(x, o); if (lane >= o) x += y; }
        if (lane == 63) wsum[wv] = (unsigned)x;
        __syncthreads();
        int eqbase = x - eq; for (int w2 = 0; w2 < wv; ++w2) eqbase += (int)wsum[w2];
        int take = kk - eqbase; take = take < 0 ? 0 : (take > eq ? eq : take);
        const int sel = gt + take;
        x = sel;
#pragma unroll
        for (int o = 1; o < 64; o <<= 1) { const int y = __shfl_up(x, o); if (lane >= o) x += y; }
        if (lane == 63) wsum[8 + wv] = (unsigned)x;
        __syncthreads();
        int pos = x - sel; for (int w2 = 0; w2 < wv; ++w2) pos += (int)wsum[8 + w2];
        if (i0 < n) {
            int eqc = 0;
            int* so = slotof + (size_t)e * MROWS + rowbase + i0;
            for (int i = 0; i < 32; ++i) {
                const unsigned v = vals[tid * 33 + i]; bool s = v > T;
                if (v == T) { s = eqc < take; ++eqc; }
                if (s) { selrow[slotbase + pos] = rowbase + i0 + i; selw[slotbase + pos] = __uint_as_float(v); so[i] = slotbase + pos; ++pos; }
                else so[i] = -1;
            }
        }
    }
#undef VPAD
}

DI void phase_gather(const Params& p) {
    unsigned char* const ws_ = lws(p);
    const int tid = ltid();
    const int lane = tid & 63;
    const int* selrow = (const int*)(ws_ + WS_SELROW); const bf16* H = (const bf16*)(ws_ + WS_H); unsigned char* XS = ws_ + R_XSEL;
    for (int c = gwave(tid); c < NSLOT / 32; c += nwaves()) {
        const int myrow = selrow[c * 32 + (lane & 31)];
#pragma unroll 4
        for (int j = 0; j < 32; ++j) {
            const int row = __builtin_amdgcn_readlane(myrow, j);
            float f[16];
            { float t8[8]; unpack8(*(const bf16x8*)(H + (size_t)row * D + lane * 16), t8);
#pragma unroll
              for (int q = 0; q < 8; ++q) f[q] = t8[q];
              unpack8(*(const bf16x8*)(H + (size_t)row * D + lane * 16 + 8), t8);
#pragma unroll
              for (int q = 0; q < 8; ++q) f[8 + q] = t8[q]; }
            *(u32x4*)(XS + (size_t)(c * 32 + j) * D + lane * 16) = pk16_fp8(f);
        }
    }
}

DI void phase_combine_ln2(const Params& p, int layer, float* lds  ) {
    unsigned char* const ws_ = lws(p);
    const int tid = ltid();
    const int lane = tid & 63;
    {   const float* mod = (const float*)(ws_ + WS_MOD) + (size_t)layer * 3 * 6144;
        const float* g1 = p.in[23] + layer * 1024; const float* b1 = p.in[24] + layer * 1024;
        const float* g2w = p.in[29] + layer * 1024; const float* b2w = p.in[30] + layer * 1024;
        for (int i = tid; i < 1024; i += NWG_THREADS) {
            lds[i] = g1[i]; lds[1024 + i] = b1[i]; lds[2048 + i] = g2w[i]; lds[3072 + i] = b2w[i];
#pragma unroll
            for (int r = 0; r < 3; ++r) {
                lds[(4 + r) * 1024 + i] = mod[r * 6144 + 5120 + i];
                if (layer == 0) { lds[(7 + r) * 1024 + i] = mod[3 * 6144 + r * 6144 + i]; lds[(10 + r) * 1024 + i] = mod[3 * 6144 + r * 6144 + 1024 + i]; }
            }
        }
        __syncthreads();
    }
    float* X = (float*)(ws_ + WS_X); const bf16* Y = (const bf16*)(ws_ + R_XSEL); const int* slotof = (const int*)(ws_ + WS_SLOTOF);
    unsigned char* H8 = ws_ + WS_H;
    const int nw = nwaves();
#define C18_SIDX(r_) slotof[(size_t)(lane & 15) * MROWS + ((r_) < MROWS ? (r_) : MROWS - 1)]
    int ra = gwave(tid);
    int sa = C18_SIDX(ra), sb = C18_SIDX(ra + nw);
#pragma unroll 1
    for (; ra < MROWS; ra += 2 * nw) {
        const int rb = ra + nw;
        const int rbc = rb < MROWS ? rb : ra;
        unsigned ma = (unsigned)__builtin_amdgcn_ballot_w64(sa >= 0) & 0xFFFFu, mb = (unsigned)__builtin_amdgcn_ballot_w64(sb >= 0) & 0xFFFFu;
        int qa[4], qb[4]; float wa[4], wb[4];
#pragma unroll
        for (int j = 0; j < 4; ++j) {
            { const bool h = ma != 0u; const int e = h ? __builtin_ctz(ma) : 0; const int q = __builtin_amdgcn_readlane(sa, e); qa[j] = h ? q : 0; wa[j] = h ? 1.f : 0.f; ma &= ma - 1u; }
            { const bool h = mb != 0u; const int e = h ? __builtin_ctz(mb) : 0; const int q = __builtin_amdgcn_readlane(sb, e); qb[j] = h ? q : 0; wb[j] = h ? 1.f : 0.f; mb &= mb - 1u; }
        }
        u32x2 ua[4][4], ub[4][4]; f32x4 va[4], vb[4];
#pragma unroll
        for (int j = 0; j < 4; ++j)
#pragma unroll
            for (int i = 0; i < 4; ++i) { ua[j][i] = *(const u32x2*)(Y + (size_t)qa[j] * D + i * 256 + lane * 4); ub[j][i] = *(const u32x2*)(Y + (size_t)qb[j] * D + i * 256 + lane * 4); }
#pragma unroll
        for (int i = 0; i < 4; ++i) { va[i] = *(const f32x4*)(X + (size_t)ra * D + i * 256 + lane * 4); vb[i] = *(const f32x4*)(X + (size_t)rbc * D + i * 256 + lane * 4); }
        const int na = C18_SIDX(ra + 2 * nw), nb = C18_SIDX(rb + 2 * nw);
        f32x4 fa[4], fb[4];
#pragma unroll
        for (int i = 0; i < 4; ++i) { fa[i] = (f32x4){0.f, 0.f, 0.f, 0.f}; fb[i] = fa[i]; }
#pragma unroll
        for (int j = 0; j < 4; ++j)
#pragma unroll
            for (int i = 0; i < 4; ++i) {
                fa[i][0] += wa[j] * lo_f(ua[j][i].x); fa[i][1] += wa[j] * hi_f(ua[j][i].x); fa[i][2] += wa[j] * lo_f(ua[j][i].y); fa[i][3] += wa[j] * hi_f(ua[j][i].y);
                fb[i][0] += wb[j] * lo_f(ub[j][i].x); fb[i][1] += wb[j] * hi_f(ub[j][i].x); fb[i][2] += wb[j] * lo_f(ub[j][i].y); fb[i][3] += wb[j] * hi_f(ub[j][i].y);
            }
        while (ma) {
            const int s = __builtin_amdgcn_readlane(sa, __builtin_ctz(ma)); ma &= ma - 1u;
#pragma unroll
            for (int i = 0; i < 4; ++i) { const u32x2 u = *(const u32x2*)(Y + (size_t)s * D + i * 256 + lane * 4); fa[i][0] += lo_f(u.x); fa[i][1] += hi_f(u.x); fa[i][2] += lo_f(u.y); fa[i][3] += hi_f(u.y); }
        }
        while (mb) {
            const int s = __builtin_amdgcn_readlane(sb, __builtin_ctz(mb)); mb &= mb - 1u;
#pragma unroll
            for (int i = 0; i < 4; ++i) { const u32x2 u = *(const u32x2*)(Y + (size_t)s * D + i * 256 + lane * 4); fb[i][0] += lo_f(u.x); fb[i][1] += hi_f(u.x); fb[i][2] += lo_f(u.y); fb[i][3] += hi_f(u.y); }
        }
#define C18_TAIL(row_, v, f) do { \
            const int b_ = (row_) / TPB, t_ = (row_) - b_ * TPB; const int mrow_ = t_ < CTX ? 2 : b_; \
            if ((row_) < MROWS && !(layer == 1 && t_ < CTX)) {       \
                float mu, rstd; ln_stats16(v, mu, rstd); \
                _Pragma("unroll") for (int i = 0; i < 4; ++i) { const int c = i * 256 + lane * 4; \
                    const f32x4 x1 = (v[i] - mu) * rstd * *(const f32x4*)(lds + c) + *(const f32x4*)(lds + 1024 + c);        \
                    v[i] = x1 * ALPHA + *(const f32x4*)(lds + (4 + mrow_) * 1024 + c) * f[i]; } \
                ln_stats16(v, mu, rstd); \
                _Pragma("unroll") for (int i = 0; i < 4; ++i) { const int c = i * 256 + lane * 4; \
                    v[i] = (v[i] - mu) * rstd * *(const f32x4*)(lds + 2048 + c) + *(const f32x4*)(lds + 3072 + c); \
                    if (layer == 1) *(f32x4*)(p.out + ((size_t)b_ * SEQ + (t_ - CTX)) * D + c) = v[i]; \
                    else *(f32x4*)(X + (size_t)(row_) * D + c) = v[i]; } \
                if (layer == 0) {         \
                    ln_stats16(v, mu, rstd); \
                    _Pragma("unroll") for (int i = 0; i < 4; ++i) { const int c = i * 256 + lane * 4; \
                        const f32x4 sh = *(const f32x4*)(lds + (7 + mrow_) * 1024 + c), sc = *(const f32x4*)(lds + (10 + mrow_) * 1024 + c); \
                        const f32x4 y = (v[i] - mu) * rstd * (sc + 1.f) + sh; \
                        *(unsigned*)(H8 + (size_t)(row_) * D + c) = pk4_fp8(y[0], y[1], y[2], y[3]); } } } } while (0)
        C18_TAIL(ra, va, fa);
        C18_TAIL(rb, vb, fb);
#undef C18_TAIL
        sa = na; sb = nb;
    }
#undef C18_SIDX
    __syncthreads();
}


namespace pg8 {
#define PG8_LAS __attribute__((address_space(3)))
constexpr int BM = 256, BK = 64, HALF = 128, HTB = HALF * BK * 2, STAGE_BYTES = 8 * HTB, NXCD = 8, WGM = 8;
__host__ __device__ __forceinline__ int lds_byte(int r, int c) { const int st = (r >> 4) * 2 + (c >> 5), rr = r & 15, cc = c & 31, ob = rr * 64 + cc * 2; return st * 1024 + (ob ^ (((ob >> 9) & 1) << 5)); }
__host__ __device__ __forceinline__ void stage_rc(int b, int& R, int& C) { const int st = b / 1024, sb = b % 1024, swz = sb ^ (((sb >> 9) & 1) << 5); R = (st >> 1) * 16 + swz / 64; C = (st & 1) * 32 + (swz % 64) / 2; }
struct Unit { int pm, pn; };
struct Gemm { const bf16* A; const bf16* Bt; int lda, ldb, K; };
struct StaticOrder {
    int nM, nN, nwg, G, c;
    __device__ void init(int nM_, int nN_, int G_, int c_) { nM = nM_; nN = nN_; nwg = nM * nN; G = G_; c = c_; }
    __device__ bool next(int i, Unit& u) const {
        const long L = (long)i * G + c; if (L >= nwg) return false;
        int wgid = (int)L; { const int q = nwg / NXCD, r = nwg % NXCD, xcd = wgid % NXCD, off = wgid / NXCD; wgid = (xcd < r ? xcd * (q + 1) : r * (q + 1) + (xcd - r) * q) + off; }
        const int nig = WGM * nN, gid = wgid / nig, fm = gid * WGM, gsz = (nM - fm) < WGM ? (nM - fm) : WGM;
        u.pm = fm + ((wgid % nig) % gsz); u.pn = (wgid % nig) / gsz; return true;
    }
};
struct NoHook { static constexpr bool ENABLED = false; };
template <class Epi, class Sched, bool FP8 = false, class Hook = NoHook, bool GATHER = false>
__device__ __forceinline__ void gemm_phase(PG8_LAS unsigned char* lds, const Gemm g, const Sched& S, const Epi& E, int tid, const Hook& H = Hook(), const int* gidx = nullptr) {
    const int wid = __builtin_amdgcn_readfirstlane(tid >> 6), lane = tid & 63, wr = wid >> 2, wc = wid & 3, fr = lane & 15, fq = lane >> 4;
    const int K = g.K, nt = K / BK;
    unsigned voffA[2], voffB[2];
    int gR[2]; unsigned gC[2];
#pragma unroll
    for (int i = 0; i < 2; ++i) { int R, C; stage_rc(tid * 16 + i * 8192, R, C); voffA[i] = (unsigned)(R * g.lda + C) * 2u; voffB[i] = (unsigned)(R * g.ldb + C) * 2u; gR[i] = R; gC[i] = (unsigned)C * 2u; }
    const size_t kstep = (size_t)(BK * 2);
    const size_t hstepA = GATHER ? 0 : (size_t)HALF * g.lda * 2, hstepB = (size_t)HALF * g.ldb * 2, tstepA = 2 * hstepA, tstepB = 2 * hstepB;
    unsigned gvc[2][2], gvn[2][2], gv2[2][2];
    const int gsrc = ((lane >> 5) & 1) * HALF + (((wid + 8 * ((lane >> 4) & 1)) >> 1) * 16) + (lane & 15);
#define PG8_GDMA(pm_) __builtin_amdgcn_global_load_lds((const unsigned*)(gidx + (pm_) * BM + gsrc), (PG8_LAS unsigned*)(lds + STAGE_BYTES + ldsw / 4), 4, 0, 0)
#define PG8_GREAD(h_, i_) ((unsigned)*(const PG8_LAS int*)(lds + STAGE_BYTES + ldsw / 4 + (((h_) * 2 + (i_)) * 16 + (lane >> 2)) * 4) * (unsigned)(g.lda * 2) + gC[i_])
    const unsigned ldsw = (unsigned)wid * 1024u;
    const int aoff = lds_byte(wr * 64 + fr, fq * 8), boff = lds_byte(wc * 32 + fr, fq * 8);
#define PG8_SA(b, h) (((b) * 2 + (h)) * HTB)
#define PG8_SB(b, h) ((4 + (b) * 2 + (h)) * HTB)
#define PG8_STAGE(bufoff, gbase, voff) do { _Pragma("unroll") for (int _i = 0; _i < 2; ++_i) \
        __builtin_amdgcn_global_load_lds((const unsigned*)((const char*)(gbase) + (voff)[_i]), (PG8_LAS unsigned*)(lds + (bufoff) + ldsw + _i * 8192), 16, 0, 0); } while (0)
#define PG8_STAGE_A(bufoff, gbase, h_, NX) do { if constexpr (GATHER) { if (NX) PG8_STAGE(bufoff, gbase, gv2[h_]); else PG8_STAGE(bufoff, gbase, gvc[h_]); } \
        else PG8_STAGE(bufoff, (gbase) + (h_) * hstepA, voffA); } while (0)
#define PG8_LD2(dst_, off_) do { const u32x4 x_ = *(const PG8_LAS u32x4*)(lds + (off_)), y_ = *(const PG8_LAS u32x4*)(lds + (off_) + 1024); \
        dst_ = (i32x8){(int)x_[0], (int)x_[1], (int)x_[2], (int)x_[3], (int)y_[0], (int)y_[1], (int)y_[2], (int)y_[3]}; } while (0)
#define PG8_LDA(dst, b, h) do { if constexpr (FP8) { _Pragma("unroll") for (int m = 0; m < 4; ++m) PG8_LD2(dst##8[m], PG8_SA(b, h) + aoff + m * 2048); } \
        else { _Pragma("unroll") for (int m = 0; m < 4; ++m) _Pragma("unroll") for (int k = 0; k < 2; ++k) dst[m][k] = *(const PG8_LAS bf16x8*)(lds + PG8_SA(b, h) + aoff + m * 2048 + k * 1024); } } while (0)
#define PG8_LDB(dst, b, h) do { if constexpr (FP8) { _Pragma("unroll") for (int n = 0; n < 2; ++n) PG8_LD2(dst##8[n], PG8_SB(b, h) + boff + n * 2048); } \
        else { _Pragma("unroll") for (int n = 0; n < 2; ++n) _Pragma("unroll") for (int k = 0; k < 2; ++k) dst[n][k] = *(const PG8_LAS bf16x8*)(lds + PG8_SB(b, h) + boff + n * 2048 + k * 1024); } } while (0)
#define PG8_MMA(ai, bj, At, Bt) do { __builtin_amdgcn_s_setprio(1); _Pragma("unroll") for (int m = 0; m < 4; ++m) _Pragma("unroll") for (int n = 0; n < 2; ++n) { \
        if constexpr (FP8) asm volatile("v_mfma_scale_f32_16x16x128_f8f6f4 %0, %1, %2, %0, %3, %3 op_sel_hi:[0,0,0]" : "+v"(acc[ai][bj][m][n]) : "v"(Bt##8[n]), "v"(At##8[m]), "v"(sc1)); \
        else { _Pragma("unroll") for (int k = 0; k < 2; ++k) acc[ai][bj][m][n] = __builtin_amdgcn_mfma_f32_16x16x32_bf16(Bt[n][k], At[m][k], acc[ai][bj][m][n], 0, 0, 0); } } \
        __builtin_amdgcn_s_setprio(0); } while (0)
#define PG8_WAIT_V(n) asm volatile("s_waitcnt vmcnt(" #n ")" ::: "memory")
#define PG8_WAIT_L(n) asm volatile("s_waitcnt lgkmcnt(" #n ")" ::: "memory")
#define PG8_BAR __builtin_amdgcn_s_barrier()
#define PG8_SCHED __builtin_amdgcn_sched_barrier(0)
    Unit cur, nxt; int ui = 0;
    if (!S.next(0, cur)) return;
    int sc1 = 0x7f7f7f7f; asm volatile("" : "+v"(sc1));
    f32x4 acc[2][2][4][2];
#pragma unroll
    for (int a = 0; a < 2; ++a)
#pragma unroll
        for (int b = 0; b < 2; ++b)
#pragma unroll
            for (int m = 0; m < 4; ++m)
#pragma unroll
                for (int n = 0; n < 2; ++n) acc[a][b][m][n] = (f32x4){0.f, 0.f, 0.f, 0.f};
    bf16x8 At[4][2], B0[2][2], B1[2][2];
    i32x8 At8[4], B08[2], B18[2];
    const char* cA = (const char*)g.A + (size_t)cur.pm * tstepA; const char* cB = (const char*)g.Bt + (size_t)cur.pn * tstepB;
    if constexpr (GATHER) {
        PG8_GDMA(cur.pm); PG8_WAIT_V(0);
#pragma unroll
        for (int h = 0; h < 2; ++h)
#pragma unroll
            for (int i = 0; i < 2; ++i) { gvc[h][i] = PG8_GREAD(h, i); gvn[h][i] = gvc[h][i]; }
        PG8_WAIT_L(0);
    }
    PG8_STAGE(PG8_SB(0, 0), cB, voffB); PG8_STAGE_A(PG8_SA(0, 0), cA, 0, false); PG8_STAGE(PG8_SB(0, 1), cB + hstepB, voffB); PG8_STAGE_A(PG8_SA(0, 1), cA, 1, false);
    if (wr == 1) PG8_BAR;
    PG8_WAIT_V(4); PG8_BAR;
    PG8_STAGE(PG8_SB(1, 0), cB + kstep, voffB); PG8_STAGE_A(PG8_SA(1, 0), cA + kstep, 0, false); PG8_STAGE(PG8_SB(1, 1), cB + hstepB + kstep, voffB);
    PG8_WAIT_V(6); PG8_BAR;
    for (;;) {
        const bool has_next = S.next(ui + 1, nxt);
        if constexpr (GATHER) PG8_GDMA(has_next ? nxt.pm : cur.pm);
        const char* nA = has_next ? (const char*)g.A + (size_t)nxt.pm * tstepA : cA; const char* nB = has_next ? (const char*)g.Bt + (size_t)nxt.pn * tstepB : cB;
        for (int t = 0; t < nt; t += 2) {
            if constexpr (Hook::ENABLED) { if (t == 8 || t == 16) H(acc, cur, t >> 3, wr, wc, fr, fq); }
            const bool last = (t == nt - 2);
            const char* a1 = cA + (size_t)(t + 1) * kstep;
            const char* a2 = last ? nA : cA + (size_t)(t + 2) * kstep; const char* b2 = last ? nB : cB + (size_t)(t + 2) * kstep;
            const char* a3 = a2 + kstep; const char* b3 = b2 + kstep;
            if constexpr (GATHER) {
#pragma unroll
                for (int h = 0; h < 2; ++h)
#pragma unroll
                    for (int i = 0; i < 2; ++i) { gvn[h][i] = PG8_GREAD(h, i); gv2[h][i] = last ? gvn[h][i] : gvc[h][i]; }
            }
            PG8_LDB(B0, 0, 0); PG8_SCHED; PG8_LDA(At, 0, 0); PG8_STAGE_A(PG8_SA(1, 1), a1, 1, false);
            PG8_WAIT_L(8); PG8_BAR; PG8_WAIT_L(0); PG8_MMA(0, 0, At, B0); PG8_BAR; PG8_SCHED;
            PG8_LDB(B1, 0, 1); PG8_STAGE(PG8_SB(0, 0), b2, voffB);
            PG8_BAR; PG8_WAIT_L(0); PG8_MMA(0, 1, At, B1); PG8_BAR;
            PG8_LDA(At, 0, 1); PG8_STAGE_A(PG8_SA(0, 0), a2, 0, true);
            PG8_BAR; PG8_WAIT_L(0); PG8_MMA(1, 0, At, B0); PG8_BAR; PG8_SCHED;
            PG8_STAGE(PG8_SB(0, 1), b2 + hstepB, voffB);
            PG8_WAIT_V(6); PG8_BAR; PG8_MMA(1, 1, At, B1); PG8_BAR;
            PG8_LDB(B0, 1, 0); PG8_SCHED; PG8_LDA(At, 1, 0); PG8_STAGE_A(PG8_SA(0, 1), a2, 1, true);
            PG8_WAIT_L(8); PG8_BAR; PG8_WAIT_L(0); PG8_MMA(0, 0, At, B0); PG8_BAR; PG8_SCHED;
            PG8_LDB(B1, 1, 1); PG8_STAGE(PG8_SB(1, 0), b3, voffB);
            PG8_BAR; PG8_WAIT_L(0); PG8_MMA(0, 1, At, B1); PG8_BAR;
            PG8_LDA(At, 1, 1); PG8_STAGE_A(PG8_SA(1, 0), a3, 0, true);
            PG8_BAR; PG8_WAIT_L(0); PG8_MMA(1, 0, At, B0); PG8_BAR; PG8_SCHED;
            PG8_STAGE(PG8_SB(1, 1), b3 + hstepB, voffB);
            PG8_WAIT_V(6); PG8_BAR; PG8_MMA(1, 1, At, B1); PG8_BAR;
        }
        if constexpr (FP8) asm volatile("s_nop 15\n\ts_nop 15" ::: "memory");
        E(acc, cur, wr, wc, fr, fq);
        if (!has_next) break;
#pragma unroll
        for (int a = 0; a < 2; ++a)
#pragma unroll
            for (int b = 0; b < 2; ++b)
#pragma unroll
                for (int m = 0; m < 4; ++m)
#pragma unroll
                    for (int n = 0; n < 2; ++n) acc[a][b][m][n] = (f32x4){0.f, 0.f, 0.f, 0.f};
        cur = nxt; cA = nA; cB = nB; ++ui;
        if constexpr (GATHER) {
#pragma unroll
            for (int h = 0; h < 2; ++h)
#pragma unroll
                for (int i = 0; i < 2; ++i) gvc[h][i] = gvn[h][i];
        }
    }
    PG8_WAIT_V(0);
    if (wr == 0) PG8_BAR;
    PG8_BAR;
#undef PG8_SA
#undef PG8_SB
#undef PG8_STAGE
#undef PG8_STAGE_A
#undef PG8_GDMA
#undef PG8_GREAD
#undef PG8_LDA
#undef PG8_LD2
#undef PG8_LDB
#undef PG8_MMA
#undef PG8_WAIT_V
#undef PG8_WAIT_L
#undef PG8_BAR
#undef PG8_SCHED
}
struct LatOrder : StaticOrder { __device__ bool next(int i, Unit& u) const { if (!StaticOrder::next(i, u)) return false; u.pm += 1 + (u.pm >= 64 ? 1 : 0); return true; } };
struct MoeOrder : StaticOrder { __device__ bool next(int i, Unit& u) const { if (!StaticOrder::next(i, u)) return false; u.pn += (u.pm >> 4) * nN; return true; } };
template <class F> struct EpiAdapt { F f; int nN_local;
    __device__ __forceinline__ void operator()(const f32x4 (&acc)[2][2][4][2], const Unit& u, int wr, int wc, int fr, int fq) const {
        const int pnl = nN_local > 0 ? u.pn % nN_local : u.pn;
        const int row0 = u.pm * BM + wr * 64 + fr, col0 = pnl * BM + wc * 32 + 4 * fq;
        if constexpr (F::BATCH) {
#pragma unroll
            for (int ai = 0; ai < 2; ++ai)
#pragma unroll
                for (int mp = 0; mp < 2; ++mp) {
                    typename F::Pre pre[2][2][2];
#pragma unroll
                    for (int mm = 0; mm < 2; ++mm)
#pragma unroll
                        for (int bj = 0; bj < 2; ++bj)
#pragma unroll
                            for (int n = 0; n < 2; ++n) pre[mm][bj][n] = f.load(row0 + ai * HALF + (2 * mp + mm) * 16, col0 + bj * HALF + n * 16);
#pragma unroll
                    for (int mm = 0; mm < 2; ++mm)
#pragma unroll
                        for (int bj = 0; bj < 2; ++bj)
#pragma unroll
                            for (int n = 0; n < 2; ++n) f.apply(row0 + ai * HALF + (2 * mp + mm) * 16, col0 + bj * HALF + n * 16, acc[ai][bj][2 * mp + mm][n], pre[mm][bj][n]);
                }
        } else {
#pragma unroll
        for (int ai = 0; ai < 2; ++ai)
#pragma unroll
            for (int m = 0; m < 4; ++m)
#pragma unroll
                for (int bj = 0; bj < 2; ++bj)
#pragma unroll
                    for (int n = 0; n < 2; ++n) f.store4(row0 + ai * HALF + m * 16, col0 + bj * HALF + n * 16, acc[ai][bj][m][n]);
        }
    }
};
template <class F> struct EpiAdaptPair { F f; int nN_local;
    __device__ __forceinline__ void operator()(const f32x4 (&acc)[2][2][4][2], const Unit& u, int wr, int wc, int fr, int fq) const {
        const int pnl = u.pn % nN_local;
        const int row0 = u.pm * BM + wr * 64 + fr;
#pragma unroll
        for (int ai = 0; ai < 2; ++ai)
#pragma unroll
            for (int m = 0; m < 4; ++m)
#pragma unroll
                for (int bj = 0; bj < 2; ++bj) f.store_pair(row0 + ai * HALF + m * 16, (pnl * 8 + bj * 4 + wc) * 16 + 4 * fq, acc[ai][bj][m][0], acc[ai][bj][m][1]);
    }
};
}

DI f32x4 gate4(u32x2 g) { const float t = 9.094947e-13f; return (f32x4){fmaxf(lo_f(g.x), t), fmaxf(hi_f(g.x), t), fmaxf(lo_f(g.y), t), fmaxf(hi_f(g.y), t)}; }
struct MergeHook { static constexpr bool ENABLED = true; const bf16* G;
    DI void operator()(f32x4 (&acc)[2][2][4][2], const pg8::Unit& u, int seg, int wr, int wc, int fr, int fq) const {
        const int row0 = u.pm * 256 + wr * 64 + fr, col0 = u.pn * 256 + wc * 32 + 4 * fq;
#pragma unroll
        for (int ai = 0; ai < 2; ++ai)
#pragma unroll
            for (int mp = 0; mp < 2; ++mp) {
                u32x2 ga[2][2][2], gb[2][2][2];
#pragma unroll
                for (int mm = 0; mm < 2; ++mm)
#pragma unroll
                    for (int bj = 0; bj < 2; ++bj)
#pragma unroll
                        for (int n = 0; n < 2; ++n) { const bf16* gp = G + (size_t)(row0 + ai * 128 + (2 * mp + mm) * 16) * 3072 + (seg - 1) * 1024 + col0 + bj * 128 + n * 16;
                            ga[mm][bj][n] = *(const u32x2*)gp; gb[mm][bj][n] = *(const u32x2*)(gp + 1024); }
#pragma unroll
                for (int mm = 0; mm < 2; ++mm)
#pragma unroll
                    for (int bj = 0; bj < 2; ++bj)
#pragma unroll
                        for (int n = 0; n < 2; ++n) { const f32x4 a = gate4(ga[mm][bj][n]), b = gate4(gb[mm][bj][n]);
                            const f32x4 r = {a[0] * __builtin_amdgcn_rcpf(b[0]), a[1] * __builtin_amdgcn_rcpf(b[1]), a[2] * __builtin_amdgcn_rcpf(b[2]), a[3] * __builtin_amdgcn_rcpf(b[3])};
                            acc[ai][bj][2 * mp + mm][n] *= r; }
            }
    }
};
struct EpiMergeFinal { static constexpr bool PAIR = false, BATCH = true; const bf16* G; bf16* Mb;
    struct Pre { u32x2 g; };
    DI Pre load(int r, int c) const { Pre p; p.g = *(const u32x2*)(G + (size_t)r * 3072 + 2048 + c); return p; }
    DI void apply(int r, int c, f32x4 v, const Pre& p) const { const f32x4 m = v * gate4(p.g); u32x2 o; o.x = pk2(m[0], m[1]); o.y = pk2(m[2], m[3]); *(u32x2*)(Mb + (size_t)r * D + c) = o; }
    DI void store4(int r, int c, f32x4 v) const { apply(r, c, v, load(r, c)); } };

template <bool FP8 = false, class F>
DI void dense_gemm(const bf16* A, int lda, const bf16* Bt, int ldb, int N, int K, const F& f, unsigned char* lds, bool do_ctx = true) {
    const int tid = ltid();
    if (do_ctx) sgemm_phase<F, BSelNone, RowMapCtx, FP8>(A, lda, Bt, ldb, 512, N, K, f, BSelNone(), RowMapCtx());
    pg8::Gemm g{A, Bt, lda, ldb, K}; pg8::LatOrder S; S.init(128, N / 256, (int)gridDim.x, (int)blockIdx.x);
    pg8::EpiAdapt<F> E{f, 0};
    pg8::gemm_phase<pg8::EpiAdapt<F>, pg8::LatOrder, FP8>((PG8_LAS unsigned char*)lds, g, S, E, tid);
}

#define XB_TMO      128
#define XB_XCNT(j)  (256  + 64 * (j))
#define XB_XSUB(j)  (1280 + 64 * (j))
#define XB_XGEN(j)  (2304 + 64 * (j))
#define XB_TOP      3328
#define XB_TOPGEN   3392
#define XCD_BAR_WORDS 3456
#define XB_SPIN_CAP (1u << 18)
#define LAS __attribute__((address_space(3)))

__device__ __forceinline__ unsigned xb_ld(unsigned* p)              { return __hip_atomic_load(p, __ATOMIC_RELAXED, __HIP_MEMORY_SCOPE_AGENT); }
__device__ __forceinline__ unsigned xb_add(unsigned* p, unsigned v) { return __hip_atomic_fetch_add(p, v, __ATOMIC_RELAXED, __HIP_MEMORY_SCOPE_AGENT); }
__device__ __forceinline__ unsigned xb_xcc_id() { return (unsigned)__builtin_amdgcn_s_getreg((3 << 11) | 20) & 0xFu; }
#define XB_SPIN(cond, bar) do { unsigned _sp = 0; while (cond) { __builtin_amdgcn_s_sleep(1); \
    if ((++_sp & 255u) == 0u) { if (xb_ld(&(bar)[XB_TMO])) break; if (_sp > XB_SPIN_CAP) { atomicAdd(&(bar)[XB_TMO], 1u); break; } } } } while (0)

struct XcdBarrier {
    unsigned* bar; unsigned x;
    volatile LAS unsigned* st;
};

__device__ __forceinline__ XcdBarrier xcd_barrier_post(unsigned* bar, volatile LAS unsigned* st) {
    XcdBarrier b; b.bar = bar; b.x = xb_xcc_id(); b.st = st;
    if (threadIdx.x == 0) (void)xb_add(&bar[XB_XCNT(b.x)], 1u);
    return b;
}
__device__ __forceinline__ void xcd_barrier_complete(unsigned* bar, unsigned x, unsigned& nloc, unsigned& nx) {
    const unsigned G = gridDim.x * gridDim.y * gridDim.z;
    unsigned sum, cnt, mine, sp = 0u;
    for (;;) {
        sum = 0u; cnt = 0u; mine = 0u;
#pragma unroll
        for (unsigned j = 0; j < 16; ++j) { const unsigned c = xb_ld(&bar[XB_XCNT(j)]); sum += c; cnt += (c > 0u) ? 1u : 0u; mine = (j == x) ? c : mine; }
        if (sum == G) break;
        __builtin_amdgcn_s_sleep(1);
        if ((++sp & 255u) == 0u) { if (xb_ld(&bar[XB_TMO])) break; if (sp > XB_SPIN_CAP) { atomicAdd(&bar[XB_TMO], 1u); break; } }
    }
    nloc = mine > 0u ? mine : 1u; nx = cnt > 0u ? cnt : 1u;
}

__device__ __forceinline__ void xcd_barrier(const XcdBarrier& b) {
    asm volatile("s_waitcnt vmcnt(0)" ::: "memory");
    __syncthreads();
    if (threadIdx.x == 0) {
        unsigned* bar = b.bar;
        __builtin_amdgcn_s_waitcnt(0);
        unsigned nloc = b.st[0], nx = b.st[1];
        if (nloc == 0u) { xcd_barrier_complete(bar, b.x, nloc, nx); b.st[0] = nloc; b.st[1] = nx; }
        const unsigned old = xb_add(&bar[XB_XSUB(b.x)], 1u);
        const unsigned gen = old / nloc;
        if (old + 1u == (gen + 1u) * nloc) {
            __builtin_amdgcn_fence(__ATOMIC_RELEASE, "agent");
            asm volatile("s_waitcnt vmcnt(0)" ::: "memory");
            const unsigned og = xb_add(&bar[XB_TOP], 1u);
            const unsigned tg = og / nx;
            if (og + 1u == (tg + 1u) * nx) xb_add(&bar[XB_TOPGEN], 1u);
            else XB_SPIN(xb_ld(&bar[XB_TOPGEN]) == tg, bar);
            __builtin_amdgcn_fence(__ATOMIC_ACQUIRE, "agent");
            xb_add(&bar[XB_XGEN(b.x)], 1u);
            asm volatile("s_waitcnt vmcnt(0)" ::: "memory");
        } else {
            XB_SPIN(xb_ld(&bar[XB_XGEN(b.x)]) == gen, bar);
            __builtin_amdgcn_fence(__ATOMIC_ACQUIRE, "agent");
            asm volatile("s_waitcnt vmcnt(0)" ::: "memory");
        }
    }
    __syncthreads();
}


__device__ __forceinline__ void xcd_barrier_fill(const XcdBarrier& b, const Params& p, unsigned char* ldsb, int flayer) {
    asm volatile("s_waitcnt vmcnt(0)" ::: "memory");
    __syncthreads();
    unsigned gen = 0u;
    if (threadIdx.x == 0) {
        unsigned* bar = b.bar;
        __builtin_amdgcn_s_waitcnt(0);
        unsigned nloc = b.st[0], nx = b.st[1];
        if (nloc == 0u) { xcd_barrier_complete(bar, b.x, nloc, nx); b.st[0] = nloc; b.st[1] = nx; }
        const unsigned old = xb_add(&bar[XB_XSUB(b.x)], 1u);
        gen = old / nloc;
        if (old + 1u == (gen + 1u) * nloc) {
            __builtin_amdgcn_fence(__ATOMIC_RELEASE, "agent");
            asm volatile("s_waitcnt vmcnt(0)" ::: "memory");
            const unsigned og = xb_add(&bar[XB_TOP], 1u);
            const unsigned tg = og / nx;
            if (og + 1u == (tg + 1u) * nx) xb_add(&bar[XB_TOPGEN], 1u);
            else XB_SPIN(xb_ld(&bar[XB_TOPGEN]) == tg, bar);
            __builtin_amdgcn_fence(__ATOMIC_ACQUIRE, "agent");
            xb_add(&bar[XB_XGEN(b.x)], 1u);
            asm volatile("s_waitcnt vmcnt(0)" ::: "memory");
            b.st[2] = 0u;
        } else {
            b.st[2] = (old - gen * nloc) * 2u < nloc ? 2u : 1u;
        }
    }
    __syncthreads();
    const unsigned mode = b.st[2];
    if (mode == 2u) {
        unsigned char* ws_ = lws(p); unsigned* cctr = (unsigned*)(ws_ + WS_CTL) + 10 + flayer;
        const int tid = ltid();
        for (;;) {
            __syncthreads();
            if (threadIdx.x == 0) {
                unsigned* bar = b.bar; const unsigned nloc = b.st[0];
                const bool rel = xb_ld(&bar[XB_XGEN(b.x)]) != gen;
                const bool allhere = xb_ld(&bar[XB_XSUB(b.x)]) >= (gen + 1u) * nloc;
                int g = -1;
                if (!rel && !allhere) g = (int)__hip_atomic_fetch_add(cctr, 8u, __ATOMIC_RELAXED, __HIP_MEMORY_SCOPE_AGENT);
                b.st[3] = (unsigned)g;
            }
            __syncthreads();
            const int g0 = (int)b.st[3];
            if (g0 < 0 || g0 >= MOE_TILES) break;
            cvt_moe_tile(p, ws_, flayer, g0 + (tid >> 6), (float*)ldsb, tid);
        }
    }
    if (threadIdx.x == 0 && mode != 0u) {
        unsigned* bar = b.bar;
        XB_SPIN(xb_ld(&bar[XB_XGEN(b.x)]) == gen, bar);
        __builtin_amdgcn_fence(__ATOMIC_ACQUIRE, "agent");
        asm volatile("s_waitcnt vmcnt(0)" ::: "memory");
    }
    __syncthreads();
}

template <int PH> DI void run_phase(const Params& p, int layer, unsigned char* lds) {
    unsigned char* const ws_ = lws(p);
    const bf16* H = (const bf16*)(ws_ + WS_H);
    if constexpr (PH == 0) { phase_cvt(p, (float*)lds, 0, 8, blockIdx.x * 8, gridDim.x * 8, true); phase_cvt(p, (float*)lds, 56, 64, blockIdx.x * 8, gridDim.x * 8, false); }
    if constexpr (PH == 1) { phase_mod(p, (float*)lds); }
    if constexpr (PH == 2) { phase_tables(p); }
    if constexpr (PH == 3) { if (layer == 0) phase_lnmod1(p, layer); }
    if constexpr (PH == 4) {
        if (FP8_INPROJ) { EpiStoreBf16 E{(bf16*)(ws_ + R_Z), ZLD, 1.f / WD_SCALE}; dense_gemm<true>(H, 512, (const bf16*)(ws_ + WS_BT_IN + (size_t)layer * ZLD * 1024), 512, ZLD, 512, E, lds); }
        else { EpiStoreBf16 E{(bf16*)(ws_ + R_Z), ZLD, 1.f}; dense_gemm(H, D, (const bf16*)(ws_ + WS_BT_IN) + (size_t)layer * ZLD * 1024, 1024, ZLD, 1024, E, lds); } }
    if constexpr (PH == 5) { phase_prep1(p, layer); }
    if constexpr (PH == 6) { EpiStoreBf16 E{(bf16*)(ws_ + R_QRAW), 768, 1.f}; dense_gemm((const bf16*)(ws_ + R_Z) + ZO_CQ, ZLD, (const bf16*)(ws_ + WS_BT_UQ) + (size_t)layer * 768 * 256, 256, 768, 256, E, lds);
              EpiStoreBf16 E2{(bf16*)(ws_ + R_KVRAW), 1024, 1.f}; dense_gemm((const bf16*)(ws_ + R_Z) + ZO_CKV, ZLD, (const bf16*)(ws_ + WS_BT_UKV) + (size_t)layer * 1024 * 256, 256, 1024, 256, E2, lds); }
    if constexpr (PH == 7) { phase_prep2(p, layer); }
    if constexpr (PH == 8) { phase_attn(p, layer, lds); }
    if constexpr (PH == 9) { phase_diffcomb(p, layer);
        if (FP8_GATE) { EpiGate E{(bf16*)(ws_ + R_G), p.in[21] + layer * 3072, 1.f / WD_SCALE}; dense_gemm<true>(H, 512, (const bf16*)(ws_ + WS_BT_GATE + (size_t)layer * 3072 * 1024), 512, 3072, 512, E, lds, layer == 0); }
        else { EpiGate E{(bf16*)(ws_ + R_G), p.in[21] + layer * 3072, 1.f}; dense_gemm(H, D, (const bf16*)(ws_ + WS_BT_GATE) + (size_t)layer * 3072 * 1024, 1024, 3072, 1024, E, lds, layer == 0); } }
    if constexpr (PH == 11) { const bf16* G = (const bf16*)(ws_ + R_G); bf16* Mp = (bf16*)(ws_ + R_M32); bf16* Mb = (bf16*)(ws_ + R_M);
               const bf16* Y = (const bf16*)(ws_ + R_YA); const bf16* Bb = (const bf16*)(ws_ + WS_BT_BR) + (size_t)layer * 1024 * 1536;
               if (layer == 0) {
                   { EpiMerge<0> E{G, Mp, Mb}; sgemm_phase(Y, 1536, Bb, 1536, 512, 1024, 512, E, BSelNone(), RowMapCtx()); }
                   { EpiMerge<1> E{G, Mp, Mb}; sgemm_phase(Y + 512, 1536, Bb + 512, 1536, 512, 1024, 512, E, BSelNone(), RowMapCtx()); }
                   { EpiMerge<2> E{G, Mp, Mb}; sgemm_phase(Y + 1024, 1536, Bb + 1024, 1536, 512, 1024, 512, E, BSelNone(), RowMapCtx()); } }
               const int tid = ltid(); pg8::Gemm g{Y, Bb, 1536, 1536, 1536}; pg8::LatOrder S; S.init(128, 4, (int)gridDim.x, (int)blockIdx.x);
               EpiMergeFinal EF{G, Mb}; pg8::EpiAdapt<EpiMergeFinal> E{EF, 0}; MergeHook H{G};
               pg8::gemm_phase<pg8::EpiAdapt<EpiMergeFinal>, pg8::LatOrder, false, MergeHook>((PG8_LAS unsigned char*)lds, g, S, E, tid, H); }
    if constexpr (PH == 12) { EpiOut E{p.in[0], p.in[2], layer, (const float*)(ws_ + WS_MOD) + (size_t)layer * 3 * 6144, (float*)(ws_ + WS_X)};
               dense_gemm((const bf16*)(ws_ + R_M), D, (const bf16*)(ws_ + WS_BT_OUT) + (size_t)layer * 1024 * 1024, 1024, 1024, 1024, E, lds, layer == 0); }
    if constexpr (PH == 13) { phase_ln1_router(p, layer, (float*)lds); }
    if constexpr (PH == 14) {
        phase_topk(p, (unsigned*)lds); __syncthreads();
        {
            unsigned* cctr = (unsigned*)(ws_ + WS_CTL) + 10 + layer; const int tid = ltid();
            volatile LAS unsigned* slot = (volatile LAS unsigned*)(lds + 8 * 64 * 65 * 4  ) + 2;
            unsigned pend = 0u; if (tid == 0) pend = __hip_atomic_fetch_add(cctr, 8u, __ATOMIC_RELAXED, __HIP_MEMORY_SCOPE_AGENT);
            int par = 0;
            for (;;) {
                unsigned nxt = 0u;
                if (tid == 0) { slot[par] = pend; nxt = __hip_atomic_fetch_add(cctr, 8u, __ATOMIC_RELAXED, __HIP_MEMORY_SCOPE_AGENT); }
                __syncthreads();
                const int g0 = (int)slot[par]; par ^= 1;
                if (g0 >= MOE_TILES) break;
                cvt_moe_tile(p, ws_, layer, g0 + (tid >> 6), (float*)lds, tid);
                pend = nxt;
            }
            __syncthreads();
        } }
    if constexpr (PH == 15) { phase_gather(p); }
    if constexpr (PH == 16) { EpiAct E{ws_ + R_ACT}; BSelMoe bs{(size_t)5632 * 512};
               const bf16* A = (const bf16*)(ws_ + WS_H); const bf16* Bt = (const bf16*)(ws_ + WS_BT_M1 + (size_t)layer * NE * 5632 * 1024); const int* selrow = (const int*)(ws_ + WS_SELROW);
               if (layer == 0) sgemm_phase<EpiAct, BSelMoe, RowMapOff, true>(A, 512, Bt, 512, NSLOT - NSLOT_L, 5632, 512, E, bs, RowMapOff{NSLOT_L}, selrow);
               const int tid = ltid(); pg8::Gemm g{A, Bt, 512, 512, 512}; pg8::MoeOrder S; S.init(256, 22, (int)gridDim.x, (int)blockIdx.x); pg8::EpiAdaptPair<EpiAct> EA{E, 22};
               pg8::gemm_phase<pg8::EpiAdaptPair<EpiAct>, pg8::MoeOrder, true, pg8::NoHook, true>((PG8_LAS unsigned char*)lds, g, S, EA, tid, pg8::NoHook(), selrow); }
    if constexpr (PH == 17) { EpiDown E{(bf16*)(ws_ + R_XSEL), (const float*)(ws_ + WS_SELW)}; BSelMoe bs{(size_t)1024 * (FF / 2)};
               const bf16* A = (const bf16*)(ws_ + R_ACT); const bf16* Bt = (const bf16*)(ws_ + WS_BT_M2 + (size_t)layer * NE * 1024 * FF);
               if (layer == 0) sgemm_phase<EpiDown, BSelMoe, RowMapOff, true>(A, FF / 2, Bt, FF / 2, NSLOT - NSLOT_L, 1024, FF / 2, E, bs, RowMapOff{NSLOT_L});
               const int tid = ltid(); pg8::Gemm g{A, Bt, FF / 2, FF / 2, FF / 2}; pg8::MoeOrder S; S.init(256, 4, (int)gridDim.x, (int)blockIdx.x); pg8::EpiAdapt<EpiDown> EA{E, 4};
               pg8::gemm_phase<pg8::EpiAdapt<EpiDown>, pg8::MoeOrder, true>((PG8_LAS unsigned char*)lds, g, S, EA, tid); }
    if constexpr (PH == 18) { phase_combine_ln2(p, layer, (float*)lds); }
}

#define GRID_BAR() do { unsigned char* w_ = lws(p); XcdBarrier b_; b_.bar = (unsigned*)(w_ + WS_CTL); b_.x = xb_xcc_id(); b_.st = xbw; xcd_barrier(b_); } while (0)
#define GRID_BAR_F(fl) do { unsigned char* w_ = lws(p); XcdBarrier b_; b_.bar = (unsigned*)(w_ + WS_CTL); b_.x = xb_xcc_id(); b_.st = xbw; xcd_barrier_fill(b_, p, lds, fl); } while (0)
constexpr int LDS_MAIN = 8 * 64 * 65 * 4  , LDS_BYTES = LDS_MAIN + 16;
__global__ void __launch_bounds__(NWG_THREADS, 2) k_mega(Params p) {
    extern __shared__ __attribute__((aligned(16))) unsigned char lds[];
    volatile LAS unsigned* xbw = (volatile LAS unsigned*)(lds + LDS_MAIN);
    if (threadIdx.x == 0) { xbw[0] = 0u; xbw[1] = 0u; xbw[2] = 0u; xbw[3] = 0u; }
    __syncthreads();
    (void)xcd_barrier_post((unsigned*)(p.ws + WS_CTL), xbw);
    run_phase<0>(p, 0, lds); run_phase<1>(p, 0, lds); run_phase<2>(p, 0, lds);
    GRID_BAR();
#define LAYER_BODY(l) do { \
        run_phase<3>(p, l, lds); GRID_BAR(); \
        run_phase<4>(p, l, lds); GRID_BAR_F(l); \
        run_phase<5>(p, l, lds); \
        run_phase<6>(p, l, lds); GRID_BAR_F(l); \
        run_phase<7>(p, l, lds); GRID_BAR(); \
        run_phase<8>(p, l, lds); GRID_BAR_F(l); \
        run_phase<9>(p, l, lds); GRID_BAR_F(l); \
        run_phase<11>(p, l, lds); GRID_BAR_F(l); \
        run_phase<12>(p, l, lds); GRID_BAR_F(l); \
        run_phase<13>(p, l, lds); GRID_BAR_F(l); \
        run_phase<14>(p, l, lds); GRID_BAR(); \
        run_phase<16>(p, l, lds); if ((l) == 0) GRID_BAR_F(1); else GRID_BAR(); \
        run_phase<17>(p, l, lds); if ((l) == 0) GRID_BAR_F(1); else GRID_BAR(); \
        run_phase<18>(p, l, lds); \
    } while (0)
    LAYER_BODY(0);
    LAYER_BODY(1);
#undef LAYER_BODY
}

extern "C" void kernel_launch(void* const* d_in, const int* in_sizes, int n_in, void* d_out, int out_size, void* d_ws, size_t ws_size, hipStream_t stream) {
    if (n_in != 31 || ws_size < WS_TOTAL) { fprintf(stderr, "kernel_launch: need 31 inputs and %zu bytes of workspace (got %d, %zu)\n", (size_t)WS_TOTAL, n_in, ws_size); return; }
    static int grid = 0;
    if (!grid) {
        int dev = 0, cus = 0, per_cu = 0;
        (void)hipGetDevice(&dev);
        (void)hipDeviceGetAttribute(&cus, hipDeviceAttributeMultiprocessorCount, dev);
        (void)hipFuncSetAttribute((const void*)k_mega, hipFuncAttributeMaxDynamicSharedMemorySize, LDS_BYTES);
        (void)hipOccupancyMaxActiveBlocksPerMultiprocessor(&per_cu, (const void*)k_mega, NWG_THREADS, LDS_BYTES);
        if (per_cu < 1) { fprintf(stderr, "kernel_launch: occupancy query reports %d blocks per CU\n", per_cu); per_cu = 1; }
        grid = cus * 1;
        if (grid <= 0) grid = 256;
    }
    Params p; memset(&p, 0, sizeof(p));
    for (int i = 0; i < 31; ++i) p.in[i] = (const float*)d_in[i];
    p.out = (float*)d_out; p.ws = (unsigned char*)d_ws;
    (void)hipMemsetAsync(d_ws, 0, 65536, stream);
    hipLaunchKernelGGL(k_mega, dim3(grid), dim3(NWG_THREADS), LDS_BYTES, stream, p);
}
```
